# Optimizing an MI355X kernel written in HIP

```python
import jax, jax.numpy as jnp
from jax import lax
import numpy as np

D_MODEL = 1024
BATCH = 16
SEQ = 2048
DEPTH = 2

N_EVEN = (DEPTH + 1) // 2
N_ODD = DEPTH // 2
CHUNK = 128

M_HEAD_DIM = 64
M_HEADS = D_MODEL // M_HEAD_DIM
M_INNER = M_HEADS * M_HEAD_DIM
M_GROUPS = 2
M_STATE = 128
M_CONV = 4
M_CONV_DIM = M_INNER + 2 * M_GROUPS * M_STATE

R_HEAD_DIM = 64
R_HEADS = D_MODEL // R_HEAD_DIM
R_INNER = R_HEADS * R_HEAD_DIM
R_DECAY_LORA = 64
R_AAA_LORA = 64
R_GATE_LORA = 160
R_SHIFT_DIM = 3 * R_INNER + R_DECAY_LORA + R_AAA_LORA + R_GATE_LORA
R_LN_EPS = 64e-5

EVEN_IN = M_INNER + M_CONV_DIM + M_HEADS + R_SHIFT_DIM
EVEN_MIX = M_INNER + R_INNER

RET_QK_HEAD = 256
RET_V_HEAD = 512
RET_HEADS = D_MODEL // RET_QK_HEAD
RET_QK = RET_HEADS * RET_QK_HEAD
RET_V = RET_HEADS * RET_V_HEAD
ODD_IN = 2 * RET_QK + 2 * RET_V

D_FF = 7 * D_MODEL // 2
N_EXPERTS = 8
TOP_K = 2

ALPHA = (2.0 * DEPTH) ** 0.25
BETA = (8.0 * DEPTH) ** -0.25
LN_EPS = 1e-5

kernel_name = "hybrid_ssd_rwkv7_retention_moe_deepnorm"


def layer_norm(x, g, b, eps=LN_EPS):
    xf = x.astype(jnp.float32)
    mu = jnp.mean(xf, -1, keepdims=True)
    var = jnp.mean(jnp.square(xf - mu), -1, keepdims=True)
    return (xf - mu) * lax.rsqrt(var + eps) * g + b


def deepnorm(x, sub, g, b):
    return layer_norm(ALPHA * x + sub, g, b).astype(x.dtype)


def head_norm(y, eps):
    yf = y.astype(jnp.float32)
    mu = jnp.mean(yf, -1, keepdims=True)
    var = jnp.mean(jnp.square(yf - mu), -1, keepdims=True)
    return (yf - mu) * lax.rsqrt(var + eps)


def causal_depthwise_conv(u, w, bias):
    k = w.shape[0]
    out = lax.conv_general_dilated(u, w[:, None, :].astype(u.dtype), window_strides=(1,),
                                   padding=[(k - 1, 0)], dimension_numbers=('NWC', 'WIO', 'NWC'),
                                   feature_group_count=u.shape[-1])
    return out + bias


def to_chunks(a):
    b, t = a.shape[:2]
    return jnp.moveaxis(a.reshape(b, t // CHUNK, CHUNK, *a.shape[2:]), 1, 0)


def from_chunks(a):
    nc, b, l = a.shape[:3]
    return jnp.moveaxis(a, 0, 1).reshape(b, nc * l, *a.shape[3:])


def ssd_chunked(xs, dt, a, bm, cm):
    bsz, t, h, p = xs.shape
    g, n = bm.shape[2], bm.shape[3]
    hpg = h // g
    f32 = jnp.float32
    x_g = xs.astype(f32).reshape(bsz, t, g, hpg, p)
    dt_g = dt.astype(f32).reshape(bsz, t, g, hpg)
    da_g = (dt * a).astype(f32).reshape(bsz, t, g, hpg)
    causal = jnp.tril(jnp.ones((CHUNK, CHUNK), bool))[None, :, :, None, None]

    def step(state, inp):
        x_c, dt_c, da_c, b_c, c_c = inp
        acs = jnp.cumsum(da_c, axis=1)
        seg = acs[:, :, None] - acs[:, None, :]
        decay = jnp.exp(jnp.where(causal, seg, -jnp.inf))
        cb = jnp.einsum('bign,bjgn->bijg', c_c, b_c)
        m = cb[..., None] * decay * dt_c[:, None]
        y = jnp.einsum('bijgh,bjghp->bighp', m, x_c)
        y = y + jnp.einsum('bign,bghpn->bighp', c_c, state) * jnp.exp(acs)[..., None]
        w_end = jnp.exp(acs[:, -1:] - acs) * dt_c
        state = (state * jnp.exp(acs[:, -1])[..., None, None]
                 + jnp.einsum('bjgn,bjgh,bjghp->bghpn', b_c, w_end, x_c))
        return state, y

    inputs = (to_chunks(x_g), to_chunks(dt_g), to_chunks(da_g),
              to_chunks(bm.astype(f32)), to_chunks(cm.astype(f32)))
    _, ys = lax.scan(step, jnp.zeros((bsz, g, hpg, p, n), f32), inputs)
    return from_chunks(ys).reshape(bsz, t, h, p)


def rwkv7_scan(r, decay, k, v, a, b):
    bsz, t, h, n = r.shape

    def step(s, inp):
        r_t, w_t, k_t, v_t, a_t, b_t = inp
        sa = jnp.einsum('bhvk,bhk->bhv', s, a_t)
        s = s * w_t[:, :, None, :] + sa[..., None] * b_t[:, :, None, :] + v_t[..., None] * k_t[:, :, None, :]
        return s, jnp.einsum('bhvk,bhk->bhv', s, r_t)

    seq_first = tuple(jnp.moveaxis(u.astype(jnp.float32), 1, 0) for u in (r, decay, k, v, a, b))
    _, y = lax.scan(step, jnp.zeros((bsz, h, n, n), jnp.float32), seq_first)
    return jnp.moveaxis(y, 0, 1)


def xpos_rotate(u, positions):
    d = u.shape[-1]
    inv_freq = 1.0 / (10000.0 ** jnp.linspace(0.0, 1.0, d // 2, dtype=jnp.float32))
    ang = positions.astype(jnp.float32)[..., None] * inv_freq
    cos = jnp.repeat(jnp.cos(ang), 2, axis=-1)[:, :, None]
    sin = jnp.repeat(jnp.sin(ang), 2, axis=-1)[:, :, None]
    rot = jnp.stack([-u[..., 1::2], u[..., 0::2]], axis=-1).reshape(u.shape)
    return u * cos + rot * sin


def retention_chunkwise(q, k, v):
    f32 = jnp.float32
    log_gamma = jnp.log(1.0 - 2.0 ** (-5.0 - jnp.arange(RET_HEADS, dtype=f32)))
    idx = jnp.arange(CHUNK, dtype=f32)
    rel = idx[:, None] - idx[None, :]
    causal = rel >= 0
    intra = jnp.where(causal[None], jnp.exp(log_gamma[:, None, None] * jnp.where(causal, rel, 0.0)[None]), 0.0)
    q_decay = jnp.exp(log_gamma[None, :] * (idx + 1.0)[:, None])
    k_decay = jnp.exp(log_gamma[None, :] * (CHUNK - 1.0 - idx)[:, None])
    chunk_decay = jnp.exp(log_gamma * CHUNK)

    def step(state, inp):
        q_c, k_c, v_c = inp
        s = jnp.einsum('bihd,bjhd->bhij', q_c, k_c) * intra
        y = jnp.einsum('bhij,bjhv->bihv', s, v_c)
        y = y + jnp.einsum('bihd,bhdv->bihv', q_c, state) * q_decay[None, :, :, None]
        state = state * chunk_decay[None, :, None, None] + jnp.einsum('bjhd,jh,bjhv->bhdv', k_c, k_decay, v_c)
        return state, y

    bsz, _, h, dk = q.shape
    dv = v.shape[-1]
    inputs = (to_chunks(q.astype(f32)), to_chunks(k.astype(f32)), to_chunks(v.astype(f32)))
    _, ys = lax.scan(step, jnp.zeros((bsz, h, dk, dv), f32), inputs)
    return from_chunks(ys)


def swiglu(x, wg, wu, wd):
    return (jax.nn.silu(x @ wg) * (x @ wu)) @ wd


def moe_swiglu(x, w_router, wg, wu, wd):
    logits = (x @ w_router).astype(jnp.float32)
    top_val, top_idx = lax.top_k(logits, TOP_K)
    probs = jax.nn.softmax(top_val, axis=-1)
    gates = jnp.sum(jax.nn.one_hot(top_idx, N_EXPERTS, dtype=jnp.float32) * probs[..., None], axis=-2)
    out = gates[..., 0:1] * swiglu(x, wg[0], wu[0], wd[0])
    for e in range(1, N_EXPERTS):
        out = out + gates[..., e:e + 1] * swiglu(x, wg[e], wu[e], wd[e])
    return out


def even_mixer(x, w_in, conv_w, conv_b, dt_bias, a_log, d_skip, m_norm, mu_shift, w0, w_up, a0, a_up,
               g_up, k_k, k_a, r_k, rln_w, rln_b, w_out):
    bsz, t, _ = x.shape
    f32 = jnp.float32
    proj = x @ w_in
    z, xbc, dt_raw, rw = jnp.split(proj, [M_INNER, M_INNER + M_CONV_DIM, M_INNER + M_CONV_DIM + M_HEADS], axis=-1)

    xbc = jax.nn.silu(causal_depthwise_conv(xbc, conv_w, conv_b))
    xs, bm, cm = jnp.split(xbc, [M_INNER, M_INNER + M_GROUPS * M_STATE], axis=-1)
    xs = xs.reshape(bsz, t, M_HEADS, M_HEAD_DIM)
    dt = jax.nn.softplus((dt_raw + dt_bias).astype(f32))
    y = ssd_chunked(xs, dt, -jnp.exp(a_log.astype(f32)),
                    bm.reshape(bsz, t, M_GROUPS, M_STATE), cm.reshape(bsz, t, M_GROUPS, M_STATE))
    y = (y + d_skip[:, None] * xs) * jax.nn.silu(z).reshape(bsz, t, M_HEADS, M_HEAD_DIM)
    y = y.reshape(bsz, t, M_GROUPS, M_INNER // M_GROUPS).astype(f32)
    y_ssd = (y * lax.rsqrt(jnp.mean(jnp.square(y), -1, keepdims=True) + LN_EPS)).reshape(bsz, t, M_INNER) * m_norm

    prev = jnp.pad(rw, ((0, 0), (1, 0), (0, 0)))[:, :-1]
    rw = rw + (prev - rw) * mu_shift
    r, k, v, wd, ad, gd = jnp.split(rw, [R_INNER, 2 * R_INNER, 3 * R_INNER, 3 * R_INNER + R_DECAY_LORA,
                                         3 * R_INNER + R_DECAY_LORA + R_AAA_LORA], axis=-1)
    w = (w0 + jnp.tanh(wd) @ w_up).astype(f32)
    decay = jnp.exp(-jnp.exp(-jax.nn.softplus(-w) - 0.5))
    iclr = jax.nn.sigmoid(a0 + ad @ a_up)
    gate = jax.nn.sigmoid(gd) @ g_up

    def heads(u):
        return u.reshape(bsz, t, R_HEADS, R_HEAD_DIM).astype(f32)

    kk = heads(k * k_k)
    kk = kk / jnp.maximum(jnp.sqrt(jnp.sum(kk * kk, -1, keepdims=True)), 1e-12)
    k = k * (1.0 + (iclr - 1.0) * k_a)
    r_h, k_h, v_h, a_h = heads(r), heads(k), heads(v), heads(iclr)
    y = rwkv7_scan(r_h, heads(decay), k_h, v_h, -kk, kk * a_h)
    y = head_norm(y, R_LN_EPS).reshape(bsz, t, R_INNER) * rln_w + rln_b
    bonus = jnp.sum(r_h * k_h * r_k, -1, keepdims=True) * v_h
    y_rwkv = (y + bonus.reshape(bsz, t, R_INNER)) * gate

    return jnp.concatenate([y_ssd, y_rwkv.astype(y_ssd.dtype)], axis=-1) @ w_out


def odd_mixer(x, positions, w_in, w_out):
    bsz, t, _ = x.shape
    q, k, v, g = jnp.split(x @ w_in, [RET_QK, 2 * RET_QK, 2 * RET_QK + RET_V], axis=-1)
    q = xpos_rotate(q.reshape(bsz, t, RET_HEADS, RET_QK_HEAD), positions)
    k = xpos_rotate(k.reshape(bsz, t, RET_HEADS, RET_QK_HEAD), positions) * RET_QK_HEAD ** -0.5
    y = retention_chunkwise(q, k, v.reshape(bsz, t, RET_HEADS, RET_V_HEAD))
    y = head_norm(y, LN_EPS).reshape(bsz, t, RET_V)
    return (jax.nn.silu(g) * y) @ w_out


def setup_inputs(seed: int = 0) -> dict:
    key = jax.random.key(seed)
    ks = iter(jax.random.split(key, 64))
    f32 = jnp.float32
    E, O = N_EVEN, N_ODD

    def nrm(shape, scale):
        return jax.random.normal(next(ks), shape, f32) * scale

    def gain(shape):
        return 1.0 + nrm(shape, 0.02)

    x = nrm((BATCH, SEQ, D_MODEL), 1.0)
    offsets = jax.random.randint(next(ks), (BATCH, 1), 0, 1024, dtype=jnp.int32)
    positions = offsets + jnp.arange(SEQ, dtype=jnp.int32)[None, :]
    dt0 = jnp.exp(jax.random.uniform(next(ks), (E, M_HEADS), f32, float(np.log(1e-3)), float(np.log(1e-1))))
    dt_bias = dt0 + jnp.log(-jnp.expm1(-dt0))
    a_log = jnp.log(jax.random.uniform(next(ks), (E, M_HEADS), f32, 1.0, 16.0))
    ramp = jnp.arange(R_INNER, dtype=f32) / (R_INNER - 1)
    w0 = -7.0 + 5.0 * ramp ** 0.85 + 0.5 + nrm((E, R_INNER), 0.02)
    return {
        "x": x,
        "positions": positions,
        "ev_w_in": nrm((E, D_MODEL, EVEN_IN), D_MODEL ** -0.5),
        "ev_conv_w": nrm((E, M_CONV, M_CONV_DIM), M_CONV ** -0.5),
        "ev_conv_b": nrm((E, M_CONV_DIM), 0.02),
        "ev_dt_bias": dt_bias,
        "ev_a_log": a_log,
        "ev_d_skip": 1.0 + nrm((E, M_HEADS), 0.1),
        "ev_m_norm": gain((E, M_INNER)),
        "ev_mu_shift": jax.random.uniform(next(ks), (E, R_SHIFT_DIM), f32),
        "ev_w0": w0,
        "ev_w_up": nrm((E, R_DECAY_LORA, R_INNER), 0.1 * R_DECAY_LORA ** -0.5),
        "ev_a0": nrm((E, R_INNER), 0.1),
        "ev_a_up": nrm((E, R_AAA_LORA, R_INNER), R_AAA_LORA ** -0.5),
        "ev_g_up": nrm((E, R_GATE_LORA, R_INNER), R_GATE_LORA ** -0.5),
        "ev_k_k": 0.85 + nrm((E, R_INNER), 0.05),
        "ev_k_a": 1.0 + nrm((E, R_INNER), 0.05),
        "ev_r_k": nrm((E, R_HEADS, R_HEAD_DIM), 0.1),
        "ev_rln_w": gain((E, R_INNER)),
        "ev_rln_b": nrm((E, R_INNER), 0.02),
        "ev_w_out": nrm((E, EVEN_MIX, D_MODEL), BETA * EVEN_MIX ** -0.5),
        "ev_ln1_g": gain((E, D_MODEL)),
        "ev_ln1_b": nrm((E, D_MODEL), 0.02),
        "ev_ffn_wg": nrm((E, D_MODEL, D_FF), D_MODEL ** -0.5),
        "ev_ffn_wu": nrm((E, D_MODEL, D_FF), D_MODEL ** -0.5),
        "ev_ffn_wd": nrm((E, D_FF, D_MODEL), BETA * D_FF ** -0.5),
        "ev_ln2_g": gain((E, D_MODEL)),
        "ev_ln2_b": nrm((E, D_MODEL), 0.02),
        "od_w_in": nrm((O, D_MODEL, ODD_IN), D_MODEL ** -0.5),
        "od_w_out": nrm((O, RET_V, D_MODEL), BETA * RET_V ** -0.5),
        "od_ln1_g": gain((O, D_MODEL)),
        "od_ln1_b": nrm((O, D_MODEL), 0.02),
        "od_router": nrm((O, D_MODEL, N_EXPERTS), D_MODEL ** -0.5),
        "od_moe_wg": nrm((O, N_EXPERTS, D_MODEL, D_FF), D_MODEL ** -0.5),
        "od_moe_wu": nrm((O, N_EXPERTS, D_MODEL, D_FF), D_MODEL ** -0.5),
        "od_moe_wd": nrm((O, N_EXPERTS, D_FF, D_MODEL), BETA * D_FF ** -0.5),
        "od_ln2_g": gain((O, D_MODEL)),
        "od_ln2_b": nrm((O, D_MODEL), 0.02),
    }


def reference(x, positions, ev_w_in, ev_conv_w, ev_conv_b, ev_dt_bias, ev_a_log, ev_d_skip, ev_m_norm,
              ev_mu_shift, ev_w0, ev_w_up, ev_a0, ev_a_up, ev_g_up, ev_k_k, ev_k_a, ev_r_k, ev_rln_w,
              ev_rln_b, ev_w_out, ev_ln1_g, ev_ln1_b, ev_ffn_wg, ev_ffn_wu, ev_ffn_wd, ev_ln2_g, ev_ln2_b,
              od_w_in, od_w_out, od_ln1_g, od_ln1_b, od_router, od_moe_wg, od_moe_wu, od_moe_wd,
              od_ln2_g, od_ln2_b):
    for layer in range(DEPTH):
        i = layer // 2
        if layer % 2 == 0:
            h = even_mixer(x, ev_w_in[i], ev_conv_w[i], ev_conv_b[i], ev_dt_bias[i], ev_a_log[i], ev_d_skip[i],
                           ev_m_norm[i], ev_mu_shift[i], ev_w0[i], ev_w_up[i], ev_a0[i], ev_a_up[i], ev_g_up[i],
                           ev_k_k[i], ev_k_a[i], ev_r_k[i], ev_rln_w[i], ev_rln_b[i], ev_w_out[i])
            x = deepnorm(x, h, ev_ln1_g[i], ev_ln1_b[i])
            x = deepnorm(x, swiglu(x, ev_ffn_wg[i], ev_ffn_wu[i], ev_ffn_wd[i]), ev_ln2_g[i], ev_ln2_b[i])
        else:
            h = odd_mixer(x, positions, od_w_in[i], od_w_out[i])
            x = deepnorm(x, h, od_ln1_g[i], od_ln1_b[i])
            x = deepnorm(x, moe_swiglu(x, od_router[i], od_moe_wg[i], od_moe_wu[i], od_moe_wd[i]),
                         od_ln2_g[i], od_ln2_b[i])
    return x
```

```cpp
#include <hip/hip_runtime.h>
#include <cstdio>
#include <cstdint>

#ifndef MK_ONE_LAUNCH
#define MK_ONE_LAUNCH 1
#endif

namespace pg8 {
#define PG8_LAS __attribute__((address_space(3)))
typedef unsigned short bf16_t;
typedef short bf16x8 __attribute__((ext_vector_type(8)));
typedef float f32x4 __attribute__((ext_vector_type(4)));
typedef unsigned u32x4 __attribute__((ext_vector_type(4)));
constexpr int BM = 256, BK = 64, HALF = 128, HTB = HALF * BK * 2, STAGE_BYTES = 8 * HTB, NXCD = 8, WGM = 4;

__host__ __device__ __forceinline__ int lds_byte(int r, int c) { const int st = (r >> 4) * 2 + (c >> 5), rr = r & 15, cc = c & 31, ob = rr * 64 + cc * 2; return st * 1024 + (ob ^ (((ob >> 9) & 1) << 5)); }
__host__ __device__ __forceinline__ void stage_rc(int b, int& R, int& C) { const int st = b / 1024, sb = b % 1024, swz = sb ^ (((sb >> 9) & 1) << 5); R = (st >> 1) * 16 + swz / 64; C = (st & 1) * 32 + (swz % 64) / 2; }
__host__ __device__ __forceinline__ int perm32(int rho) { const int n = rho >> 4, i = rho & 15; return 8 * (i >> 2) + 4 * n + (i & 3); }

struct Unit { int pm, pn; };

struct StaticOrder {
    int nM, nN, nwg, G, c; const char* Bt; size_t tstepB;
    __device__ void init(int M, int N, int G_, int c_, const bf16_t* Bt_, int ldb) { nM = M / BM; nN = N / BM; nwg = nM * nN; G = G_; c = c_; Bt = (const char*)Bt_; tstepB = (size_t)BM * ldb * 2; }
    __device__ bool next(int i, Unit& u) const {
        const long L = (long)i * G + c; if (L >= nwg) return false;
        int wgid = (int)L; { const int q = nwg / NXCD, r = nwg % NXCD, xcd = wgid % NXCD, off = wgid / NXCD; wgid = (xcd < r ? xcd * (q + 1) : r * (q + 1) + (xcd - r) * q) + off; }
        const int nig = WGM * nN, gid = wgid / nig, fm = gid * WGM, gsz = (nM - fm) < WGM ? (nM - fm) : WGM;
        u.pm = fm + ((wgid % nig) % gsz); u.pn = (wgid % nig) / gsz; return true;
    }
    __device__ __forceinline__ const char* b_base(const Unit& u) const { return Bt + (size_t)u.pn * tstepB; }
    __device__ __forceinline__ const int* a_rows(const Unit&) const { return nullptr; }
};

__device__ __forceinline__ unsigned cvt_pk_bf16(float lo, float hi) { unsigned r; asm volatile("v_cvt_pk_bf16_f32 %0, %1, %2" : "=v"(r) : "v"(lo), "v"(hi)); return r; }
__device__ __forceinline__ float silu_f(float x) { return x * __builtin_amdgcn_rcpf(1.0f + __expf(-x)); }

struct EpiStore {
    static constexpr bool PERM = true, AFTER_DRAIN = false;
    bf16_t* O; int ldc;
    __device__ __forceinline__ void operator()(const f32x4 (&acc)[2][2][4][2], const Unit& u, int wr, int wc, int fr, int fq) const {
        const int row0 = u.pm * BM + wr * 64 + fr, col0 = u.pn * BM + wc * 32 + 8 * fq;
#pragma unroll
        for (int ai = 0; ai < 2; ++ai)
#pragma unroll
            for (int m = 0; m < 4; ++m) { bf16_t* rowp = O + (size_t)(row0 + ai * HALF + m * 16) * ldc + col0;
#pragma unroll
                for (int bj = 0; bj < 2; ++bj) { const f32x4 v0 = acc[ai][bj][m][0], v1 = acc[ai][bj][m][1];
                    u32x4 w; w.x = cvt_pk_bf16(v0[0], v0[1]); w.y = cvt_pk_bf16(v0[2], v0[3]); w.z = cvt_pk_bf16(v1[0], v1[1]); w.w = cvt_pk_bf16(v1[2], v1[3]);
                    *(u32x4*)(rowp + bj * HALF) = w; } }
    }
};
struct EpiStoreRot {
    static constexpr bool PERM = true, AFTER_DRAIN = false;
    bf16_t* O; int ldc; const float* cs;
    __device__ __forceinline__ void operator()(const f32x4 (&acc)[2][2][4][2], const Unit& u, int wr, int wc, int fr, int fq) const {
        const int row0 = u.pm * BM + wr * 64 + fr, col0 = u.pn * BM + wc * 32 + 8 * fq;
        const bool rot = u.pn < 8; const float sc = u.pn >= 4 ? 0.0625f : 1.0f;
#pragma unroll
        for (int ai = 0; ai < 2; ++ai)
#pragma unroll
            for (int m = 0; m < 4; ++m) { const int row = row0 + ai * HALF + m * 16; bf16_t* rowp = O + (size_t)row * ldc + col0;
#pragma unroll
                for (int bj = 0; bj < 2; ++bj) { f32x4 v0 = acc[ai][bj][m][0], v1 = acc[ai][bj][m][1];
                    if (rot) { const int i0 = ((col0 + bj * HALF) & 255) >> 1; const float* cp = cs + ((size_t)row * 128 + i0) * 2;
                        const f32x4 c01 = *(const f32x4*)cp, c23 = *(const f32x4*)(cp + 4);
                        const f32x4 r0 = (f32x4){v0[0] * c01[0] - v0[1] * c01[1], v0[1] * c01[0] + v0[0] * c01[1], v0[2] * c01[2] - v0[3] * c01[3], v0[3] * c01[2] + v0[2] * c01[3]};
                        const f32x4 r1 = (f32x4){v1[0] * c23[0] - v1[1] * c23[1], v1[1] * c23[0] + v1[0] * c23[1], v1[2] * c23[2] - v1[3] * c23[3], v1[3] * c23[2] + v1[2] * c23[3]};
                        v0 = r0 * sc; v1 = r1 * sc; }
                    u32x4 w; w.x = cvt_pk_bf16(v0[0], v0[1]); w.y = cvt_pk_bf16(v0[2], v0[3]); w.z = cvt_pk_bf16(v1[0], v1[1]); w.w = cvt_pk_bf16(v1[2], v1[3]);
                    *(u32x4*)(rowp + bj * HALF) = w; } }
    }
};
struct EpiRoute0 {
    static constexpr bool PERM = true, AFTER_DRAIN = false;
    bf16_t* base; size_t o_xbc, o_rkvh, o_smb;
    __device__ __forceinline__ void operator()(const f32x4 (&acc)[2][2][4][2], const Unit& u, int wr, int wc, int fr, int fq) const {
        const int row0 = u.pm * BM + wr * 64 + fr, col0 = u.pn * BM + wc * 32 + 8 * fq, pn = u.pn;
#pragma unroll
        for (int ai = 0; ai < 2; ++ai)
#pragma unroll
            for (int m = 0; m < 4; ++m) { const int row = row0 + ai * HALF + m * 16, b = row >> 11, t = row & 2047;
#pragma unroll
                for (int bj = 0; bj < 2; ++bj) { const int col = col0 + bj * HALF; bf16_t* dst; bool ok = true;
                    if (pn < 4) dst = base + ((size_t)(b * 16 + (col >> 6)) * 2048 + t) * 64 + (col & 63);
                    else if (pn < 10) dst = base + o_xbc + (size_t)row * 1536 + (col - 1024);
                    else if (pn < 22) { const int cc = col - 2560; dst = base + o_rkvh + ((size_t)(b * 16 + ((cc & 1023) >> 6)) * 2048 + t) * 192 + (cc >> 10) * 64 + (cc & 63); }
                    else { const int cc = col - 5632; ok = cc < 320; dst = base + o_smb + (size_t)row * 320 + cc; }
                    const f32x4 v0 = acc[ai][bj][m][0], v1 = acc[ai][bj][m][1];
                    u32x4 w; w.x = cvt_pk_bf16(v0[0], v0[1]); w.y = cvt_pk_bf16(v0[2], v0[3]); w.z = cvt_pk_bf16(v1[0], v1[1]); w.w = cvt_pk_bf16(v1[2], v1[3]);
                    if (ok) *(u32x4*)dst = w; } }
    }
};
struct EpiRoute1 {
    static constexpr bool PERM = true, AFTER_DRAIN = false;
    bf16_t* base; size_t o_vh, o_gb; const int* pos;
    __device__ __forceinline__ void operator()(const f32x4 (&acc)[2][2][4][2], const Unit& u, int wr, int wc, int fr, int fq) const {
        const int row0 = u.pm * BM + wr * 64 + fr, col0 = u.pn * BM + wc * 32 + 8 * fq, pn = u.pn;
        const bool rot = pn < 8; const float sc = pn >= 4 ? 0.0625f : 1.0f;
        float frq[2][4];
#pragma unroll
        for (int bj = 0; bj < 2; ++bj)
#pragma unroll
            for (int q = 0; q < 4; ++q) frq[bj][q] = __builtin_amdgcn_exp2f((float)((((col0 + bj * HALF) & 255) >> 1) + q) * (-13.287712379549449f / 127.0f)) * 0.15915494309189535f;
#pragma unroll
        for (int ai = 0; ai < 2; ++ai)
#pragma unroll
            for (int m = 0; m < 4; ++m) { const int row = row0 + ai * HALF + m * 16, b = row >> 11, t = row & 2047; const float ps = rot ? (float)pos[row] : 0.f;
#pragma unroll
                for (int bj = 0; bj < 2; ++bj) { const int col = col0 + bj * HALF; f32x4 v0 = acc[ai][bj][m][0], v1 = acc[ai][bj][m][1]; bf16_t* dst;
                    if (rot) { const int cc = col & 1023;
                        float cs_[8];
#pragma unroll
                        for (int q = 0; q < 4; ++q) { const float rev = __builtin_amdgcn_fractf(ps * frq[bj][q]); cs_[2 * q] = __builtin_amdgcn_cosf(rev); cs_[2 * q + 1] = __builtin_amdgcn_sinf(rev); }
                        const f32x4 c01 = (f32x4){cs_[0], cs_[1], cs_[2], cs_[3]}, c23 = (f32x4){cs_[4], cs_[5], cs_[6], cs_[7]};
                        const f32x4 r0 = (f32x4){v0[0] * c01[0] - v0[1] * c01[1], v0[1] * c01[0] + v0[0] * c01[1], v0[2] * c01[2] - v0[3] * c01[3], v0[3] * c01[2] + v0[2] * c01[3]};
                        const f32x4 r1 = (f32x4){v1[0] * c23[0] - v1[1] * c23[1], v1[1] * c23[0] + v1[0] * c23[1], v1[2] * c23[2] - v1[3] * c23[3], v1[3] * c23[2] + v1[2] * c23[3]};
                        v0 = r0 * sc; v1 = r1 * sc;
                        dst = base + ((size_t)(b * 4 + (cc >> 8)) * 2048 + t) * 512 + (pn >> 2) * 256 + (cc & 255); }
                    else if (pn < 16) { const int cc = col - 2048; dst = base + o_vh + ((size_t)((b * 4 + (cc >> 9)) * 4 + ((cc & 511) >> 7)) * 2048 + t) * 128 + (cc & 127); }
                    else dst = base + o_gb + (size_t)row * 2048 + (col - 4096);
                    u32x4 w; w.x = cvt_pk_bf16(v0[0], v0[1]); w.y = cvt_pk_bf16(v0[2], v0[3]); w.z = cvt_pk_bf16(v1[0], v1[1]); w.w = cvt_pk_bf16(v1[2], v1[3]);
                    *(u32x4*)dst = w; } }
    }
};
struct EpiSwiGLU {
    static constexpr bool PERM = true, AFTER_DRAIN = false;
    bf16_t* H; int ldc;
    __device__ __forceinline__ void operator()(const f32x4 (&acc)[2][2][4][2], const Unit& u, int wr, int wc, int fr, int fq) const {
        const int row0 = u.pm * BM + wr * 64 + fr, col0 = u.pn * HALF + wc * 32 + 8 * fq;
#pragma unroll
        for (int ai = 0; ai < 2; ++ai)
#pragma unroll
            for (int m = 0; m < 4; ++m) { bf16_t* rowp = H + (size_t)(row0 + ai * HALF + m * 16) * ldc + col0;
                float o[8];
#pragma unroll
                for (int n = 0; n < 2; ++n)
#pragma unroll
                    for (int j = 0; j < 4; ++j) o[n * 4 + j] = silu_f(acc[ai][0][m][n][j]) * acc[ai][1][m][n][j];
                u32x4 w; w.x = cvt_pk_bf16(o[0], o[1]); w.y = cvt_pk_bf16(o[2], o[3]); w.z = cvt_pk_bf16(o[4], o[5]); w.w = cvt_pk_bf16(o[6], o[7]);
                __builtin_nontemporal_store(w, (u32x4*)rowp); }
    }
};
struct EpiMoeOut {
    static constexpr bool PERM = true, AFTER_DRAIN = false;
    bf16_t* Y0; bf16_t* Y1; int ldc; int nhalf; const int* rowdst; const float* rowp;
    __device__ __forceinline__ void operator()(const f32x4 (&acc)[2][2][4][2], const Unit& u, int wr, int wc, int fr, int fq) const {
        const int row0 = u.pm * BM + wr * 64 + fr, col0 = u.pn * BM + wc * 32 + 8 * fq;
#pragma unroll
        for (int ai = 0; ai < 2; ++ai)
#pragma unroll
            for (int m = 0; m < 4; ++m) { const int slot = row0 + ai * HALF + m * 16; const int dst = rowdst[slot]; const float p = rowp[slot];
                if (dst >= 0) { bf16_t* rowpt = (dst >= nhalf ? Y1 + (size_t)(dst - nhalf) * ldc : Y0 + (size_t)dst * ldc) + col0;
#pragma unroll
                    for (int bj = 0; bj < 2; ++bj) { const f32x4 v0 = acc[ai][bj][m][0] * p, v1 = acc[ai][bj][m][1] * p;
                        u32x4 w; w.x = cvt_pk_bf16(v0[0], v0[1]); w.y = cvt_pk_bf16(v0[2], v0[3]); w.z = cvt_pk_bf16(v1[0], v1[1]); w.w = cvt_pk_bf16(v1[2], v1[3]);
                        *(u32x4*)(rowpt + bj * HALF) = w; } }
                asm volatile("" ::: "memory"); }
    }
};

template <class Epi, class Sched, bool ALIGN_EPI, bool GATHER>
__device__ __forceinline__ void gemm_phase(PG8_LAS unsigned char* lds, const bf16_t* Abase, int lda, int ldb, int K, const Sched& S, const Epi& E) {
    const int tid = threadIdx.x, wid = __builtin_amdgcn_readfirstlane(tid >> 6), lane = tid & 63, wr = wid >> 2, wc = wid & 3, fr = lane & 15, fq = lane >> 4;
    const int nt = K / BK;
    int RA[2], CA[2]; unsigned voffB[2];
#pragma unroll
    for (int i = 0; i < 2; ++i) { int R, C; stage_rc(tid * 16 + i * 8192, R, C); const int Rb = Epi::PERM ? ((R & ~31) + perm32(R & 31)) : R;
        RA[i] = R; CA[i] = C; voffB[i] = (unsigned)(Rb * ldb + C) * 2u; }
    const size_t kstep = (size_t)(BK * 2);
    const size_t hstepB = (size_t)HALF * ldb * 2;
    const size_t tstepA = (size_t)BM * lda * 2;
    const unsigned ldsw = (unsigned)wid * 1024u;
    const int aoff = lds_byte(wr * 64 + fr, fq * 8), boff = lds_byte(wc * 32 + fr, fq * 8);
#define PG8_SA(b, h) (((b) * 2 + (h)) * HTB)
#define PG8_SB(b, h) ((4 + (b) * 2 + (h)) * HTB)
#define PG8_STAGE(bufoff, gbase, voff) do { _Pragma("unroll") for (int _i = 0; _i < 2; ++_i) \
        __builtin_amdgcn_global_load_lds((const unsigned*)((const char*)(gbase) + (voff)[_i]), (PG8_LAS unsigned*)(lds + (bufoff) + ldsw + _i * 8192), 16, 0, 0); } while (0)
#define PG8_LDA(dst, b, h) do { _Pragma("unroll") for (int m = 0; m < 4; ++m) _Pragma("unroll") for (int k = 0; k < 2; ++k) dst[m][k] = *(const PG8_LAS bf16x8*)(lds + PG8_SA(b, h) + aoff + m * 2048 + k * 1024); } while (0)
#define PG8_LDB(dst, b, h) do { _Pragma("unroll") for (int n = 0; n < 2; ++n) _Pragma("unroll") for (int k = 0; k < 2; ++k) dst[n][k] = *(const PG8_LAS bf16x8*)(lds + PG8_SB(b, h) + boff + n * 2048 + k * 1024); } while (0)
#define PG8_MMA(ai, bj, At, Bt) do { __builtin_amdgcn_s_setprio(1); _Pragma("unroll") for (int m = 0; m < 4; ++m) _Pragma("unroll") for (int n = 0; n < 2; ++n) _Pragma("unroll") for (int k = 0; k < 2; ++k) \
        acc[ai][bj][m][n] = __builtin_amdgcn_mfma_f32_16x16x32_bf16(Bt[n][k], At[m][k], acc[ai][bj][m][n], 0, 0, 0); __builtin_amdgcn_s_setprio(0); } while (0)
#define PG8_WAIT_V(n) asm volatile("s_waitcnt vmcnt(" #n ")" ::: "memory")
#define PG8_WAIT_L(n) asm volatile("s_waitcnt lgkmcnt(" #n ")" ::: "memory")
#define PG8_BAR __builtin_amdgcn_s_barrier()
#define PG8_SCHED __builtin_amdgcn_sched_barrier(0)
    Unit cur, nxt; int ui = 0;
    if (!S.next(0, cur)) return;
    f32x4 acc[2][2][4][2];
#pragma unroll
    for (int a = 0; a < 2; ++a)
#pragma unroll
        for (int b = 0; b < 2; ++b)
#pragma unroll
            for (int m = 0; m < 4; ++m)
#pragma unroll
                for (int n = 0; n < 2; ++n) acc[a][b][m][n] = (f32x4){0.f, 0.f, 0.f, 0.f};
    bf16x8 At[4][2], B0[2][2], B1[2][2];
    unsigned vA[2][2];
    const char* cA; const char* cB = S.b_base(cur);
    PG8_LAS int* const rowslot = (PG8_LAS int*)(lds + STAGE_BYTES + 4096);
#define PG8_ROWS_DMA(slot, rows) do { if (wid < 4) __builtin_amdgcn_global_load_lds((const unsigned*)((rows) + tid), (PG8_LAS unsigned*)(rowslot + (slot) * 256 + wid * 64), 4, 0, 0); } while (0)
#define PG8_GOFF(dst, slot) do { _Pragma("unroll") for (int _h = 0; _h < 2; ++_h) _Pragma("unroll") for (int _i = 0; _i < 2; ++_i) dst[_h][_i] = (unsigned)(rowslot[(slot) * 256 + _h * HALF + RA[_i]] * lda + CA[_i]) * 2u; } while (0)
    if constexpr (GATHER) { cA = (const char*)Abase; PG8_ROWS_DMA(0, S.a_rows(cur)); PG8_WAIT_V(0); PG8_BAR; PG8_GOFF(vA, 0); }
    else { cA = (const char*)Abase + (size_t)cur.pm * tstepA;
#pragma unroll
        for (int h = 0; h < 2; ++h)
#pragma unroll
            for (int i = 0; i < 2; ++i) vA[h][i] = (unsigned)((h * HALF + RA[i]) * lda + CA[i]) * 2u;
    }
    PG8_STAGE(PG8_SB(0, 0), cB, voffB); PG8_STAGE(PG8_SB(0, 1), cB + hstepB, voffB); PG8_STAGE(PG8_SA(0, 0), cA, vA[0]); PG8_STAGE(PG8_SA(0, 1), cA, vA[1]);
    if (wr == 1) PG8_BAR;
    PG8_WAIT_V(2); PG8_BAR;
    PG8_STAGE(PG8_SB(1, 0), cB + kstep, voffB); PG8_STAGE(PG8_SA(1, 0), cA + kstep, vA[0]); PG8_STAGE(PG8_SB(1, 1), cB + hstepB + kstep, voffB);
    PG8_WAIT_V(6); PG8_BAR;
    for (;;) {
        const bool has_next = S.next(ui + 1, nxt);
        const char* nA; const char* nB = has_next ? S.b_base(nxt) : cB;
        if constexpr (GATHER) { nA = cA; if (has_next) PG8_ROWS_DMA((ui + 1) & 1, S.a_rows(nxt)); }
        else nA = has_next ? (const char*)Abase + (size_t)nxt.pm * tstepA : cA;
        for (int t = 0; t < nt; t += 2) {
            const bool last = (t == nt - 2);
            const char* a1 = cA + (size_t)(t + 1) * kstep;
            const char* a2 = last ? nA : cA + (size_t)(t + 2) * kstep; const char* b2 = last ? nB : cB + (size_t)(t + 2) * kstep;
            const char* a3 = a2 + kstep; const char* b3 = b2 + kstep;
            unsigned v2[2][2];
            if constexpr (GATHER) { if (last && has_next) PG8_GOFF(v2, (ui + 1) & 1); else PG8_GOFF(v2, ui & 1); PG8_GOFF(vA, ui & 1); }
            else {
#pragma unroll
                for (int h = 0; h < 2; ++h)
#pragma unroll
                    for (int i = 0; i < 2; ++i) v2[h][i] = vA[h][i];
            }
            PG8_LDB(B0, 0, 0); PG8_LDB(B1, 0, 1); PG8_SCHED; PG8_LDA(At, 0, 0); PG8_STAGE(PG8_SA(1, 1), a1, vA[1]);
            PG8_WAIT_V(8); PG8_WAIT_L(0); PG8_BAR; PG8_MMA(0, 0, At, B0); PG8_MMA(0, 1, At, B1); PG8_BAR; PG8_SCHED;
            PG8_LDA(At, 0, 1); PG8_STAGE(PG8_SB(0, 0), b2, voffB); PG8_STAGE(PG8_SB(0, 1), b2 + hstepB, voffB); PG8_STAGE(PG8_SA(0, 0), a2, v2[0]);
            PG8_WAIT_V(8); PG8_WAIT_L(0); PG8_BAR; PG8_MMA(1, 0, At, B0); PG8_MMA(1, 1, At, B1); PG8_BAR; PG8_SCHED;
            PG8_LDB(B0, 1, 0); PG8_LDB(B1, 1, 1); PG8_SCHED; PG8_LDA(At, 1, 0); PG8_STAGE(PG8_SA(0, 1), a2, v2[1]);
            PG8_WAIT_V(8); PG8_WAIT_L(0); PG8_BAR; PG8_MMA(0, 0, At, B0); PG8_MMA(0, 1, At, B1); PG8_BAR; PG8_SCHED;
            PG8_LDA(At, 1, 1); PG8_STAGE(PG8_SB(1, 0), b3, voffB); PG8_STAGE(PG8_SB(1, 1), b3 + hstepB, voffB); PG8_STAGE(PG8_SA(1, 0), a3, v2[0]);
            PG8_WAIT_V(8); PG8_WAIT_L(0); PG8_BAR; PG8_MMA(1, 0, At, B0); PG8_MMA(1, 1, At, B1); PG8_BAR; PG8_SCHED;
        }
        if constexpr (ALIGN_EPI) { if (wr == 0) PG8_BAR; }
        E(acc, cur, wr, wc, fr, fq);
        if (!has_next) break;
#pragma unroll
        for (int a = 0; a < 2; ++a)
#pragma unroll
            for (int b = 0; b < 2; ++b)
#pragma unroll
                for (int m = 0; m < 4; ++m)
#pragma unroll
                    for (int n = 0; n < 2; ++n) acc[a][b][m][n] = (f32x4){0.f, 0.f, 0.f, 0.f};
        cur = nxt; cA = nA; cB = nB; ++ui;
        if constexpr (ALIGN_EPI) { if (wr == 1) PG8_BAR; }
    }
    PG8_WAIT_V(0);
    if constexpr (!ALIGN_EPI) { if (wr == 0) PG8_BAR; }
    PG8_BAR;
#undef PG8_SA
#undef PG8_SB
#undef PG8_STAGE
#undef PG8_LDA
#undef PG8_LDB
#undef PG8_MMA
#undef PG8_WAIT_V
#undef PG8_WAIT_L
#undef PG8_BAR
#undef PG8_SCHED
#undef PG8_ROWS_DMA
#undef PG8_GOFF
}
}

constexpr int NWAVES = 8, NTHR = 512;
constexpr int BATCH = 16, SEQ = 2048, DM = 1024, MTOK = BATCH * SEQ;
constexpr int PW = 6144;
constexpr int DFF = 3584, NEXP = 8;
constexpr int MOE_P1 = 128, MOE_ROWS = (MTOK * 2 / 256 - MOE_P1 + NEXP) * 256, MOE_SLOTS = MTOK * 2 + NEXP * 256;
constexpr float ALPHA = 1.4142135623730951f;
constexpr float LN_EPS = 1e-5f;
constexpr int PC_Z = 0, PC_XBC = 1024, PC_RKV = 2560, PC_SM = 5632, PC_DT = 5920;
constexpr size_t L0_ZH = 0, L0_XBC = (size_t)MTOK * 1024, L0_RKVH = (size_t)MTOK * 2560, L0_SMB = (size_t)MTOK * 5632;
constexpr size_t L1_QKH = 0, L1_VH = (size_t)MTOK * 2048, L1_GB = (size_t)MTOK * 4096;

constexpr size_t MiB = 1u << 20;
constexpr size_t WS_CTL = 0, CTL_ZERO_BYTES = 1 * MiB;
constexpr size_t WS_W0IN = 1 * MiB, WS_W0OUT = 13 * MiB, WS_W0GU = 17 * MiB, WS_W0D = 31 * MiB, WS_W1IN = 38 * MiB, WS_W1OUT = 50 * MiB;
constexpr size_t WS_XB = 54 * MiB;
constexpr size_t WS_P = 118 * MiB;
constexpr size_t WS_X1 = 118 * MiB;
constexpr size_t WS_HID = 246 * MiB;
constexpr size_t WS_H = 502 * MiB;
constexpr size_t WS_MOED = 118 * MiB;
constexpr size_t WS_Y0 = 174 * MiB, WS_Y1 = 238 * MiB, WS_MHID = 302 * MiB;
constexpr size_t WS_CS = 1 * MiB;
constexpr size_t WS_TAB = 34 * MiB;
constexpr size_t TAB_E = 0, TAB_P = 128 * 1024, TAB_POS = 256 * 1024, TAB_ROWTOK = 512 * 1024, TAB_ROWDST = 1024 * 1024, TAB_ROWP = 1536 * 1024;
constexpr size_t WS_END = 566 * MiB;
constexpr int CW_TMO = 0, CW_BAR = 4096, CW_CNT = 8192;

constexpr int RING_BYTES = 131072, MISC_OFF = RING_BYTES + 320, LCNT_OFF = RING_BYTES + 512, PEXP_OFF = RING_BYTES + 1024, LDS_BYTES = 147456;

#define GAS __attribute__((address_space(1)))
#define LAS __attribute__((address_space(3)))
typedef unsigned short bf16;
typedef unsigned v4u __attribute__((ext_vector_type(4)));
typedef unsigned v2u __attribute__((ext_vector_type(2)));
typedef float f32x4 __attribute__((ext_vector_type(4)));
typedef GAS unsigned gu32;
#define RLX_AGENT __ATOMIC_RELAXED, __HIP_MEMORY_SCOPE_AGENT
#define LDS_WAIT() asm volatile("s_waitcnt lgkmcnt(0)" ::: "memory")
__device__ __forceinline__ unsigned f2bf(float f) { unsigned u = __builtin_bit_cast(unsigned, f); return (u + 0x7fffu + ((u >> 16) & 1u)) >> 16; }
__device__ __forceinline__ unsigned pk2(float lo, float hi) { return f2bf(lo) | (f2bf(hi) << 16); }
__device__ __forceinline__ float bf2f(bf16 v) { return __builtin_bit_cast(float, (unsigned)v << 16); }
__device__ __forceinline__ float bflo(unsigned w) { return __builtin_bit_cast(float, w << 16); }
__device__ __forceinline__ float bfhi(unsigned w) { return __builtin_bit_cast(float, w & 0xffff0000u); }
__device__ __forceinline__ float sigmoid_f(float x) { return 1.0f / (1.0f + __expf(-x)); }
__device__ __forceinline__ float silu_f(float x) { return x / (1.0f + __expf(-x)); }
__device__ __forceinline__ float softplus_f(float x) { return x > 20.f ? x : log1pf(__expf(x)); }
__device__ __forceinline__ float wave_sum(float v) {
    v += __builtin_bit_cast(float, __builtin_amdgcn_update_dpp(0, __builtin_bit_cast(int, v), 0x128, 0xf, 0xf, true));
    v += __builtin_bit_cast(float, __builtin_amdgcn_update_dpp(0, __builtin_bit_cast(int, v), 0x124, 0xf, 0xf, true));
    v += __builtin_bit_cast(float, __builtin_amdgcn_update_dpp(0, __builtin_bit_cast(int, v), 0x122, 0xf, 0xf, true));
    v += __builtin_bit_cast(float, __builtin_amdgcn_update_dpp(0, __builtin_bit_cast(int, v), 0x121, 0xf, 0xf, true));
    const float r0 = __builtin_bit_cast(float, __builtin_amdgcn_readlane(__builtin_bit_cast(int, v), 0)), r1 = __builtin_bit_cast(float, __builtin_amdgcn_readlane(__builtin_bit_cast(int, v), 16));
    const float r2 = __builtin_bit_cast(float, __builtin_amdgcn_readlane(__builtin_bit_cast(int, v), 32)), r3 = __builtin_bit_cast(float, __builtin_amdgcn_readlane(__builtin_bit_cast(int, v), 48));
    return (r0 + r1) + (r2 + r3);
}

#define LDS_BARRIER() asm volatile("s_waitcnt lgkmcnt(0)\n\ts_barrier" ::: "memory")
#define XB_TMO      128
#define XB_XCNT(j)  (256  + 64 * (j))
#define XB_XSUB(j)  (1280 + 64 * (j))
#define XB_XGEN(j)  (2304 + 64 * (j))
#define XB_TOP      3328
#define XB_TOPGEN   3392
#define XCD_BAR_WORDS 3456
#define XB_SPIN_CAP (1u << 18)
__device__ __forceinline__ unsigned xb_ld(unsigned* p)              { return __hip_atomic_load(p, __ATOMIC_RELAXED, __HIP_MEMORY_SCOPE_AGENT); }
__device__ __forceinline__ unsigned xb_add(unsigned* p, unsigned v) { return __hip_atomic_fetch_add(p, v, __ATOMIC_RELAXED, __HIP_MEMORY_SCOPE_AGENT); }
__device__ __forceinline__ unsigned xb_xcc_id() { return (unsigned)__builtin_amdgcn_s_getreg((3 << 11) | 20) & 0xFu; }
#define XB_SPIN(cond, bar) do { unsigned _sp = 0; while (cond) { __builtin_amdgcn_s_sleep(1); \
    if ((++_sp & 255u) == 0u) { if (xb_ld(&(bar)[XB_TMO])) break; if (_sp > XB_SPIN_CAP) { atomicAdd(&(bar)[XB_TMO], 1u); break; } } } } while (0)
struct XcdBarrier { unsigned* bar; unsigned x; volatile LAS unsigned* st; };
__device__ __forceinline__ XcdBarrier xcd_barrier_post(unsigned* bar, volatile LAS unsigned* st) {
    XcdBarrier b; b.bar = bar; b.x = xb_xcc_id(); b.st = st;
    if (threadIdx.x == 0) (void)xb_add(&bar[XB_XCNT(b.x)], 1u);
    return b;
}
__device__ __forceinline__ void xcd_barrier_complete(unsigned* bar, unsigned x, unsigned& nloc, unsigned& nx) {
    const unsigned G = gridDim.x * gridDim.y * gridDim.z;
    unsigned sum, cnt, mine, sp = 0u;
    for (;;) {
        sum = 0u; cnt = 0u; mine = 0u;
#pragma unroll
        for (unsigned j = 0; j < 16; ++j) { const unsigned c = xb_ld(&bar[XB_XCNT(j)]); sum += c; cnt += (c > 0u) ? 1u : 0u; mine = (j == x) ? c : mine; }
        if (sum == G) break;
        __builtin_amdgcn_s_sleep(1);
        if ((++sp & 255u) == 0u) { if (xb_ld(&bar[XB_TMO])) break; if (sp > XB_SPIN_CAP) { atomicAdd(&bar[XB_TMO], 1u); break; } }
    }
    nloc = mine > 0u ? mine : 1u; nx = cnt > 0u ? cnt : 1u;
}
__device__ __forceinline__ void xcd_barrier(const XcdBarrier& b) {
    asm volatile("s_waitcnt vmcnt(0)" ::: "memory");
    __syncthreads();
    if (threadIdx.x == 0) {
        unsigned* bar = b.bar;
        __builtin_amdgcn_s_waitcnt(0);
        unsigned nloc = b.st[0], nx = b.st[1];
        if (nloc == 0u) { xcd_barrier_complete(bar, b.x, nloc, nx); b.st[0] = nloc; b.st[1] = nx; }
        const unsigned old = xb_add(&bar[XB_XSUB(b.x)], 1u);
        const unsigned gen = old / nloc;
        if (old + 1u == (gen + 1u) * nloc) {
            __builtin_amdgcn_fence(__ATOMIC_RELEASE, "agent");
            asm volatile("s_waitcnt vmcnt(0)" ::: "memory");
            const unsigned og = xb_add(&bar[XB_TOP], 1u);
            const unsigned tg = og / nx;
            if (og + 1u == (tg + 1u) * nx) xb_add(&bar[XB_TOPGEN], 1u);
            else XB_SPIN(xb_ld(&bar[XB_TOPGEN]) == tg, bar);
            __builtin_amdgcn_fence(__ATOMIC_ACQUIRE, "agent");
            xb_add(&bar[XB_XGEN(b.x)], 1u);
            asm volatile("s_waitcnt vmcnt(0)" ::: "memory");
        } else {
            XB_SPIN(xb_ld(&bar[XB_XGEN(b.x)]) == gen, bar);
            __builtin_amdgcn_fence(__ATOMIC_ACQUIRE, "agent");
            asm volatile("s_waitcnt vmcnt(0)" ::: "memory");
        }
    }
    __syncthreads();
}

struct Args { const void* in[38]; float* out; unsigned char* ws; int ph_lo, ph_hi; };
enum { I_X = 0, I_POS, I_EV_WIN, I_CONVW, I_CONVB, I_DTB, I_ALOG, I_DSKIP, I_MNORM, I_MU, I_W0, I_WUP, I_A0, I_AUP, I_GUP, I_KK, I_KA, I_RK, I_RLNW, I_RLNB, I_EV_WOUT,
       I_EV_LN1G, I_EV_LN1B, I_FFN_WG, I_FFN_WU, I_FFN_WD, I_EV_LN2G, I_EV_LN2B, I_OD_WIN, I_OD_WOUT, I_OD_LN1G, I_OD_LN1B, I_ROUTER, I_MOE_WG, I_MOE_WU, I_MOE_WD, I_OD_LN2G, I_OD_LN2B };

struct Frame {
    LAS unsigned char* lds;
    int tid, lane, wave, G, bid;
};

template <int TYPE>
__device__ __forceinline__ void transpose_job(const float* W, const float* W2, int ldw, int K, bf16* WT, int nrows, LAS float* scr_f, int gw, int NGW, int lane) {
    LAS unsigned char* scr = (LAS unsigned char*)scr_f;
    const int nblk = nrows / 64, nitems = (K / 64) * nblk;
    const int l16 = lane & 15, lq = lane >> 4;
    for (int item = gw; item < nitems; item += NGW) {
        const int kb = item / nblk, nb = item % nblk, k0 = 64 * kb, n0 = 64 * nb;
        const int np = n0 + 4 * l16;
        const float* src = W; int col = np;
        if (TYPE == 1) { if (np < 2560) col = np; else if (np < 5920) col = np + 16; else if (np < 5936) col = 2560 + (np - 5920); else col = -1; }
        if (TYPE == 2) { const int pn = np >> 8, j = np & 255; if (j < 128) col = 128 * pn + j; else { src = W2; col = 128 * pn + j - 128; } }
#pragma unroll
        for (int i = 0; i < 8; ++i) { const int kk = 8 * i + 2 * lq;
            f32x4 va = (f32x4){0.f, 0.f, 0.f, 0.f}, vb = va;
            if (col >= 0) { va = __builtin_nontemporal_load((const f32x4*)(src + (size_t)(k0 + kk) * ldw + col)); vb = __builtin_nontemporal_load((const f32x4*)(src + (size_t)(k0 + kk + 1) * ldw + col)); }
#pragma unroll
            for (int j = 0; j < 4; ++j) *(LAS unsigned*)(scr + (4 * l16 + j) * 136 + kk * 2) = pk2(va[j], vb[j]); }
        LDS_WAIT(); asm volatile("" ::: "memory");
#pragma unroll
        for (int j = 0; j < 8; ++j) { const int ch = lane + 64 * j, n = ch >> 3, kc = ch & 7;
            const v2u lo = *(const LAS v2u*)(scr + n * 136 + kc * 16), hi = *(const LAS v2u*)(scr + n * 136 + kc * 16 + 8);
            *(v4u*)(WT + (size_t)(n0 + n) * K + k0 + 8 * kc) = (v4u){lo.x, lo.y, hi.x, hi.y}; }
        LDS_WAIT(); asm volatile("" ::: "memory");
    }
}

template <bool ROUTER, bool MOE_COMBINE, bool CSTAB = false>
__device__ __forceinline__ void ln_rows(const Frame& F, const float* xi, const bf16* xib, const bf16* hb, const bf16* hb2, const float* gam, const float* bet, float* xo, bf16* xbo,
                                        int row_lo, int row_hi, const float* wr, unsigned* cnt, int* tok_e, float* tok_p, int* tok_pos, const int* positions = nullptr, float* cstab = nullptr) {
    const int gw = F.bid * NWAVES + F.wave, NGW = F.G * NWAVES, lane = F.lane;
    float invf0 = 0.f, invf1 = 0.f;
    if (CSTAB) { invf0 = (float)pow(10000.0, -(double)lane / 127.0); invf1 = (float)pow(10000.0, -(double)(lane + 64) / 127.0); }
    f32x4 gv[4], bv[4];
#pragma unroll
    for (int j = 0; j < 4; ++j) { gv[j] = *(const f32x4*)(gam + 4 * lane + 256 * j); bv[j] = *(const f32x4*)(bet + 4 * lane + 256 * j); }
    float mylg[8] = {0.f, 0.f, 0.f, 0.f, 0.f, 0.f, 0.f, 0.f};
    f32x4 rw0[16], rw1[16];
    if (ROUTER) {
#pragma unroll
        for (int j = 0; j < 4; ++j)
#pragma unroll
            for (int q = 0; q < 4; ++q) { const int c = 4 * lane + 256 * j + q; rw0[4 * j + q] = *(const f32x4*)(wr + c * 8); rw1[4 * j + q] = *(const f32x4*)(wr + c * 8 + 4); }
    }
    for (int row = row_lo + gw; row < row_hi; row += NGW) {
        f32x4 v[4]; float s = 0.f;
#pragma unroll
        for (int j = 0; j < 4; ++j) {
            f32x4 x;
            if (xi) x = *(const f32x4*)(xi + (size_t)row * DM + 4 * lane + 256 * j);
            else { const v2u xw = *(const v2u*)(xib + (size_t)row * DM + 4 * lane + 256 * j); x = (f32x4){bflo(xw.x), bfhi(xw.x), bflo(xw.y), bfhi(xw.y)}; }
            const size_t hrow = MOE_COMBINE ? (size_t)(row - row_lo) : (size_t)row;
            const v2u hw = *(const v2u*)(hb + hrow * DM + 4 * lane + 256 * j);
            f32x4 h = (f32x4){bflo(hw.x), bfhi(hw.x), bflo(hw.y), bfhi(hw.y)};
            if (MOE_COMBINE) { const v2u h2 = *(const v2u*)(hb2 + hrow * DM + 4 * lane + 256 * j); h += (f32x4){bflo(h2.x), bfhi(h2.x), bflo(h2.y), bfhi(h2.y)}; }
            v[j] = x * ALPHA + h; s += (v[j].x + v[j].y) + (v[j].z + v[j].w);
        }
        const float mean = wave_sum(s) * (1.f / DM); float s2 = 0.f;
#pragma unroll
        for (int j = 0; j < 4; ++j) { v[j] = v[j] - mean; s2 += (v[j].x * v[j].x + v[j].y * v[j].y) + (v[j].z * v[j].z + v[j].w * v[j].w); }
        const float rstd = 1.f / sqrtf(wave_sum(s2) * (1.f / DM) + LN_EPS);
#pragma unroll
        for (int j = 0; j < 4; ++j) { v[j] = v[j] * rstd * gv[j] + bv[j];
            if (xo) *(f32x4*)(xo + (size_t)row * DM + 4 * lane + 256 * j) = v[j];
            if (xbo) { v2u w; w.x = pk2(v[j].x, v[j].y); w.y = pk2(v[j].z, v[j].w); *(v2u*)(xbo + (size_t)row * DM + 4 * lane + 256 * j) = w; } }
        if (CSTAB) { const float pos = (float)positions[row]; float sn, cs_; typedef float f32x2v __attribute__((ext_vector_type(2)));
            sincosf(pos * invf0, &sn, &cs_); *(f32x2v*)(cstab + ((size_t)row * 128 + lane) * 2) = (f32x2v){cs_, sn};
            sincosf(pos * invf1, &sn, &cs_); *(f32x2v*)(cstab + ((size_t)row * 128 + lane + 64) * 2) = (f32x2v){cs_, sn}; }
        if (ROUTER) {
            float lg[8];
#pragma unroll
            for (int e = 0; e < 8; ++e) lg[e] = 0.f;
#pragma unroll
            for (int j = 0; j < 4; ++j)
#pragma unroll
                for (int q = 0; q < 4; ++q) { const f32x4 w0 = rw0[4 * j + q], w1 = rw1[4 * j + q]; const float xv = v[j][q];
                    lg[0] += xv * w0.x; lg[1] += xv * w0.y; lg[2] += xv * w0.z; lg[3] += xv * w0.w; lg[4] += xv * w1.x; lg[5] += xv * w1.y; lg[6] += xv * w1.z; lg[7] += xv * w1.w; }
            {
                float a4[4];
#pragma unroll
                for (int e = 0; e < 4; ++e) { const float mine = (lane & 32) ? lg[4 + e] : lg[e], send = (lane & 32) ? lg[e] : lg[4 + e]; a4[e] = mine + __shfl_xor(send, 32); }
                float a2[2];
#pragma unroll
                for (int e = 0; e < 2; ++e) { const float mine = (lane & 16) ? a4[2 + e] : a4[e], send = (lane & 16) ? a4[e] : a4[2 + e]; a2[e] = mine + __shfl_xor(send, 16); }
                float a1; { const float mine = (lane & 8) ? a2[1] : a2[0], send = (lane & 8) ? a2[0] : a2[1]; a1 = mine + __shfl_xor(send, 8); }
                a1 += __shfl_xor(a1, 4); a1 += __shfl_xor(a1, 2); a1 += __shfl_xor(a1, 1);
#pragma unroll
                for (int e = 0; e < 8; ++e) lg[e] = __shfl(a1, ((e >> 2) & 1) * 32 + ((e >> 1) & 1) * 16 + (e & 1) * 8);
            }
            const int it_ = (row - row_lo - gw) / NGW;
#pragma unroll
            for (int e = 0; e < 8; ++e) mylg[e] = (lane == it_) ? lg[e] : mylg[e];
        }
    }
    if (ROUTER) {
        LAS unsigned* lc = (LAS unsigned*)(F.lds + LCNT_OFF);
        const int row = row_lo + gw + lane * NGW; const bool act = row < row_hi;
        int i0 = 0, i1 = -1, pos0 = 0, pos1 = 0;
        if (act) { float v0 = mylg[0];
#pragma unroll
            for (int e = 1; e < 8; ++e) if (mylg[e] > v0) { v0 = mylg[e]; i0 = e; }
            float v1 = -3.0e38f;
#pragma unroll
            for (int e = 0; e < 8; ++e) if (e != i0 && mylg[e] > v1) { v1 = mylg[e]; i1 = e; }
            pos0 = (int)__hip_atomic_fetch_add(lc + i0, 1u, __ATOMIC_RELAXED, __HIP_MEMORY_SCOPE_WORKGROUP); pos1 = (int)__hip_atomic_fetch_add(lc + i1, 1u, __ATOMIC_RELAXED, __HIP_MEMORY_SCOPE_WORKGROUP);
            tok_e[row] = i0 | (i1 << 8); tok_p[row] = 1.f / (1.f + __expf(v1 - v0)); }
        __syncthreads();
        if (F.tid < 8) lc[16 + F.tid] = __hip_atomic_fetch_add(cnt + F.tid, lc[F.tid], RLX_AGENT);
        __syncthreads();
        if (act) { tok_pos[2 * row] = pos0 + (int)lc[16 + i0]; tok_pos[2 * row + 1] = pos1 + (int)lc[16 + i1]; }
    }
}

typedef short bf16x8 __attribute__((ext_vector_type(8)));
typedef short s16x4 __attribute__((ext_vector_type(4)));
typedef __attribute__((address_space(3))) const unsigned char* lds_cptr;
__device__ __forceinline__ s16x4 lds_tr(lds_cptr p) { return __builtin_bit_cast(s16x4, __builtin_amdgcn_ds_read_tr16_b64_v4i16((LAS s16x4*)p)); }
__device__ __forceinline__ bf16x8 cat8(s16x4 lo, s16x4 hi) { return (bf16x8){lo[0], lo[1], lo[2], lo[3], hi[0], hi[1], hi[2], hi[3]}; }
typedef float f32x2_t __attribute__((ext_vector_type(2))); typedef __bf16 bf16x2_t __attribute__((ext_vector_type(2)));
__device__ __forceinline__ unsigned cvtpk(float lo, float hi) { f32x2_t v = {lo, hi}; bf16x2_t b = __builtin_convertvector(v, bf16x2_t); return __builtin_bit_cast(unsigned, b); }
__device__ __forceinline__ bf16x8 pack8(f32x4 a, f32x4 b) { v4u w; w.x = cvtpk(a[0], a[1]); w.y = cvtpk(a[2], a[3]); w.z = cvtpk(b[0], b[1]); w.w = cvtpk(b[2], b[3]); return __builtin_bit_cast(bf16x8, w); }
#define MFMA16(a, b, c) __builtin_amdgcn_mfma_f32_16x16x32_bf16(a, b, c, 0, 0, 0)
__device__ __forceinline__ void conv_prepass(const Frame& F, const bf16* P, const float* convw, const float* convb, bf16* XA, bf16* BCA) {
    constexpr int CR = 16;
    const int gt = F.bid * NTHR + F.tid, NGT = F.G * NTHR;
    for (int task = gt; task < (MTOK / CR) * 192; task += NGT) {
        const int cg = task % 192, rb = task / 192, ch = cg * 8, row0 = rb * CR, t0 = row0 & (SEQ - 1);
        float wk[4][8], bias[8], x0[8], x1[8], x2[8];
#pragma unroll
        for (int k = 0; k < 4; ++k) { const f32x4 a = *(const f32x4*)(convw + k * 1536 + ch), b = *(const f32x4*)(convw + k * 1536 + ch + 4);
#pragma unroll
            for (int j = 0; j < 4; ++j) { wk[k][j] = a[j]; wk[k][4 + j] = b[j]; } }
        { const f32x4 a = *(const f32x4*)(convb + ch), b = *(const f32x4*)(convb + ch + 4);
#pragma unroll
            for (int j = 0; j < 4; ++j) { bias[j] = a[j]; bias[4 + j] = b[j]; } }
        const bf16* src = P + L0_XBC + (size_t)row0 * 1536 + ch; const int bb_ = row0 >> 11;
#define CONV_LD(dst, ptr) do { const v4u r_ = *(const v4u*)(ptr); dst[0] = bflo(r_.x); dst[1] = bfhi(r_.x); dst[2] = bflo(r_.y); dst[3] = bfhi(r_.y); dst[4] = bflo(r_.z); dst[5] = bfhi(r_.z); dst[6] = bflo(r_.w); dst[7] = bfhi(r_.w); } while (0)
        if (t0 > 0) { CONV_LD(x0, src - 3 * 1536); CONV_LD(x1, src - 2 * 1536); CONV_LD(x2, src - 1536); }
        else {
#pragma unroll
            for (int j = 0; j < 8; ++j) { x0[j] = 0.f; x1[j] = 0.f; x2[j] = 0.f; } }
        const int cc_ = ch - 1024;
        bf16* dst = ch < 1024 ? XA + ((size_t)(bb_ * 16 + (ch >> 6)) * 2048 + t0) * 64 + (ch & 63) : BCA + ((size_t)(bb_ * 2 + ((cc_ & 255) >> 7)) * 2048 + t0) * 256 + (cc_ >> 8) * 128 + (cc_ & 127);
        const int dpitch = ch < 1024 ? 64 : 256;
#pragma unroll 4
        for (int r = 0; r < CR; ++r) {
            float cur[8], o[8]; CONV_LD(cur, src + (size_t)r * 1536);
#pragma unroll
            for (int j = 0; j < 8; ++j) { o[j] = silu_f(bias[j] + wk[0][j] * x0[j] + wk[1][j] * x1[j] + wk[2][j] * x2[j] + wk[3][j] * cur[j]); x0[j] = x1[j]; x1[j] = x2[j]; x2[j] = cur[j]; }
            v4u ow; ow.x = pk2(o[0], o[1]); ow.y = pk2(o[2], o[3]); ow.z = pk2(o[4], o[5]); ow.w = pk2(o[6], o[7]);
            *(v4u*)(dst + (size_t)r * dpitch) = ow;
        }
#undef CONV_LD
    }
}

__device__ __forceinline__ void small_prepass(const Frame& F, const bf16* SMBp, const float* mu, bf16* SMS) {
    const int gt = F.bid * NTHR + F.tid, NGT = F.G * NTHR;
    for (int idx = gt; idx < MTOK * 36; idx += NGT) {
        const int row = idx / 36, j = idx % 36; const bf16* src = SMBp + (size_t)row * 320 + j * 8;
        const v4u cw = *(const v4u*)src; const v4u pw = (row & (SEQ - 1)) ? *(const v4u*)(src - 320) : (v4u){0u, 0u, 0u, 0u};
        const f32x4 m0 = *(const f32x4*)(mu + 3072 + j * 8), m1 = *(const f32x4*)(mu + 3072 + j * 8 + 4);
        const float c_[8] = {bflo(cw.x), bfhi(cw.x), bflo(cw.y), bfhi(cw.y), bflo(cw.z), bfhi(cw.z), bflo(cw.w), bfhi(cw.w)};
        const float p_[8] = {bflo(pw.x), bfhi(pw.x), bflo(pw.y), bfhi(pw.y), bflo(pw.z), bfhi(pw.z), bflo(pw.w), bfhi(pw.w)};
        float v[8];
#pragma unroll
        for (int q = 0; q < 8; ++q) { const float x = c_[q] + (p_[q] - c_[q]) * (q < 4 ? m0[q & 3] : m1[q & 3]);
            v[q] = j < 8 ? 1.f - 2.f * __builtin_amdgcn_rcpf(1.f + __expf(2.f * x)) : (j < 16 ? x : __builtin_amdgcn_rcpf(1.f + __expf(-x))); }
        v4u o; o.x = pk2(v[0], v[1]); o.y = pk2(v[2], v[3]); o.z = pk2(v[4], v[5]); o.w = pk2(v[6], v[7]);
        *(v4u*)(SMS + (size_t)row * 320 + j * 8) = o;
    }
}

__device__ __forceinline__ float wave_scan_incl(float v, int lane) {
#pragma unroll
    for (int o = 1; o < 64; o <<= 1) { const float t = __shfl_up(v, o); if (lane >= o) v += t; }
    return v;
}
__device__ __forceinline__ void ssd_mfma(const Frame& F, const bf16* P, const bf16* XA, const bf16* BCA, const float* dtb, const float* alog, const float* dskip, bf16* mix) {
    constexpr int XST = 144, BST = 272;
    constexpr int XOFF = 0, XWOFF = 128 * XST, BOFF = 2 * 128 * XST, COFF = BOFF + 128 * BST, SOFF = COFF + 128 * BST, DTOFF = SOFF + 64 * BST, ACSOFF = DTOFF + 512;
    static_assert(ACSOFF + 512 <= RING_BYTES, "SSD LDS map");
    LAS unsigned char* const L = F.lds;
    LAS float* const DT = (LAS float*)(L + DTOFF); LAS float* const ACS = (LAS float*)(L + ACSOFF);
    const int tid = F.tid, lane = F.lane, w = F.wave, g = lane >> 4, lr = lane & 15, q4 = lr >> 2, p4 = lane & 3;
    for (int item = F.bid; item < BATCH * 16; item += F.G) {
        const int b = item >> 4, h = item & 15, grp = h >> 3;
        const float A_h = -__expf(alog[h]), dtbias = dtb[h], dsk = dskip[h];
        const bf16* xg = XA + (size_t)(b * 16 + h) * 2048 * 64;
        const bf16* bg = BCA + (size_t)(b * 2 + grp) * 2048 * 256;
        const bf16* cg = bg + 128;
        const bf16* dg = P + L0_SMB + (size_t)(b * SEQ) * 320 + 288 + h;
        const bf16* zg = P + L0_ZH + (size_t)(b * 16 + h) * 2048 * 64;
        bf16* og = mix + (size_t)(b * SEQ) * 2048 + h * 64;
        f32x4 stT[4];
#pragma unroll
        for (int pt = 0; pt < 4; ++pt) stT[pt] = (f32x4){0.f, 0.f, 0.f, 0.f};
        __syncthreads();
        for (int i = tid; i < 64 * BST / 16; i += NTHR) *(LAS v4u*)(L + SOFF + i * 16) = (v4u){0u, 0u, 0u, 0u};
        v4u xp[2], bp[4], cp[4]; float raw0 = 0.f, raw1 = 0.f;
#define SSD_LOAD(c) do { const size_t r0_ = (size_t)(128 * (c)); \
            _Pragma("unroll") for (int i_ = 0; i_ < 2; ++i_) { const int p_ = tid + NTHR * i_; xp[i_] = *(const v4u*)(xg + (r0_ + (p_ >> 3)) * 64 + (p_ & 7) * 8); } \
            _Pragma("unroll") for (int i_ = 0; i_ < 4; ++i_) { const int p_ = tid + NTHR * i_; bp[i_] = *(const v4u*)(bg + (r0_ + (p_ >> 4)) * 256 + (p_ & 15) * 8); cp[i_] = *(const v4u*)(cg + (r0_ + (p_ >> 4)) * 256 + (p_ & 15) * 8); } \
            if (w < 2) { raw0 = bf2f(dg[(r0_ + lane) * 320]); raw1 = bf2f(dg[(r0_ + 64 + lane) * 320]); } } while (0)
        SSD_LOAD(0);
        for (int c = 0; c < SEQ / 128; ++c) {
#pragma unroll
            for (int i = 0; i < 2; ++i) { const int p = tid + NTHR * i; *(LAS v4u*)(L + XOFF + (p >> 3) * XST + (p & 7) * 16) = xp[i]; }
#pragma unroll
            for (int i = 0; i < 4; ++i) { const int p = tid + NTHR * i; *(LAS v4u*)(L + BOFF + (p >> 4) * BST + (p & 15) * 16) = bp[i]; *(LAS v4u*)(L + COFF + (p >> 4) * BST + (p & 15) * 16) = cp[i]; }
            if (w < 2) {
                const float d0 = softplus_f(raw0 + dtbias), d1 = softplus_f(raw1 + dtbias);
                const float s0 = wave_scan_incl(d0 * A_h, lane); const float tot0 = __shfl(s0, 63); const float s1 = wave_scan_incl(d1 * A_h, lane) + tot0;
                if (w == 0) { DT[lane] = d0; ACS[lane] = s0; } else { DT[64 + lane] = d1; ACS[64 + lane] = s1; }
            }
            __syncthreads();
            const float acs_end = ACS[127];
#pragma unroll
            for (int i = 0; i < 2; ++i) { const int p = tid + NTHR * i, j = p >> 3; const float f = __expf(acs_end - ACS[j]) * DT[j]; const v4u x = xp[i]; v4u o;
                o.x = cvtpk(bflo(x.x) * f, bfhi(x.x) * f); o.y = cvtpk(bflo(x.y) * f, bfhi(x.y) * f); o.z = cvtpk(bflo(x.z) * f, bfhi(x.z) * f); o.w = cvtpk(bflo(x.w) * f, bfhi(x.w) * f);
                *(LAS v4u*)(L + XWOFF + j * XST + (p & 7) * 16) = o; }
            if (c + 1 < SEQ / 128) SSD_LOAD(c + 1);
            bf16x8 cf[4];
#pragma unroll
            for (int ks = 0; ks < 4; ++ks) cf[ks] = *(const LAS bf16x8*)(L + COFF + (16 * w + lr) * BST + (32 * ks + 8 * g) * 2);
            const float acs_i = ACS[16 * w + lr];
            bf16x8 mf[4];
#pragma unroll
            for (int s2 = 0; s2 < 4; ++s2) { f32x4 mm[2];
#pragma unroll
                for (int e = 0; e < 2; ++e) { const int jt = 2 * s2 + e; mm[e] = (f32x4){0.f, 0.f, 0.f, 0.f};
                    if (jt <= w) {
#pragma unroll
                        for (int ks = 0; ks < 4; ++ks) { const bf16x8 a = *(const LAS bf16x8*)(L + BOFF + (16 * jt + lr) * BST + (32 * ks + 8 * g) * 2); mm[e] = MFMA16(a, cf[ks], mm[e]); }
                        const f32x4 aj = *(const LAS f32x4*)(ACS + 16 * jt + 4 * g), dj = *(const LAS f32x4*)(DT + 16 * jt + 4 * g);
#pragma unroll
                        for (int r = 0; r < 4; ++r) { const float v = mm[e][r] * __expf(acs_i - aj[r]) * dj[r]; mm[e][r] = (jt < w || 4 * g + r <= lr) ? v : 0.f; }
                    } }
                mf[s2] = pack8(mm[0], mm[1]); }
            __builtin_amdgcn_sched_barrier(0);
            const float e_i = __expf(acs_i);
#pragma unroll
            for (int pt = 0; pt < 4; ++pt) { f32x4 y = (f32x4){0.f, 0.f, 0.f, 0.f};
#pragma unroll
                for (int ks = 0; ks < 4; ++ks) { const bf16x8 a = *(const LAS bf16x8*)(L + SOFF + (16 * pt + lr) * BST + (32 * ks + 8 * g) * 2); y = MFMA16(a, cf[ks], y); }
                y = y * e_i;
#pragma unroll
                for (int s2 = 0; s2 < 4; ++s2) if (2 * s2 <= w) {
                    const s16x4 lo = lds_tr(L + XOFF + (32 * s2 + 4 * g + q4) * XST + (16 * pt + 4 * p4) * 2), hi = lds_tr(L + XOFF + (32 * s2 + 16 + 4 * g + q4) * XST + (16 * pt + 4 * p4) * 2);
                    y = MFMA16(cat8(lo, hi), mf[s2], y); }
                const int tok = 128 * c + 16 * w + lr, p0 = 16 * pt + 4 * g;
                const v2u xw = *(const LAS v2u*)(L + XOFF + (16 * w + lr) * XST + p0 * 2); const v2u zw = *(const v2u*)(zg + (size_t)tok * 64 + p0);
                const float o0 = (y[0] + dsk * bflo(xw.x)) * silu_f(bflo(zw.x)), o1 = (y[1] + dsk * bfhi(xw.x)) * silu_f(bfhi(zw.x)), o2 = (y[2] + dsk * bflo(xw.y)) * silu_f(bflo(zw.y)), o3 = (y[3] + dsk * bfhi(xw.y)) * silu_f(bfhi(zw.y));
                v2u o; o.x = cvtpk(o0, o1); o.y = cvtpk(o2, o3); *(v2u*)(og + (size_t)tok * 2048 + p0) = o; }
            __syncthreads();
            { const float e_end = __expf(acs_end);
#pragma unroll
              for (int pt = 0; pt < 4; ++pt) stT[pt] = stT[pt] * e_end; }
#pragma unroll
            for (int s2 = 0; s2 < 4; ++s2) {
                const s16x4 lo = lds_tr(L + BOFF + (32 * s2 + 8 * g + q4) * BST + (16 * w + 4 * p4) * 2), hi = lds_tr(L + BOFF + (32 * s2 + 8 * g + 4 + q4) * BST + (16 * w + 4 * p4) * 2); const bf16x8 a = cat8(lo, hi);
#pragma unroll
                for (int pt = 0; pt < 4; ++pt) { const s16x4 xl = lds_tr(L + XWOFF + (32 * s2 + 8 * g + q4) * XST + (16 * pt + 4 * p4) * 2), xh = lds_tr(L + XWOFF + (32 * s2 + 8 * g + 4 + q4) * XST + (16 * pt + 4 * p4) * 2);
                    stT[pt] = MFMA16(a, cat8(xl, xh), stT[pt]); } }
#pragma unroll
            for (int pt = 0; pt < 4; ++pt) { v2u o; o.x = cvtpk(stT[pt][0], stT[pt][1]); o.y = cvtpk(stT[pt][2], stT[pt][3]); *(LAS v2u*)(L + SOFF + (16 * pt + lr) * BST + (16 * w + 4 * g) * 2) = o; }
            __syncthreads();
        }
#undef SSD_LOAD
    }
}

__device__ __forceinline__ void ssd_norm(const Frame& F, bf16* mix, const float* mnorm) {
    const int gw = F.bid * NWAVES + F.wave, NGW = F.G * NWAVES, lane = F.lane;
    for (int it = gw; it < MTOK * 2; it += NGW) {
        const int row = it >> 1, g = it & 1; bf16* p = mix + (size_t)row * 2048 + g * 512 + 8 * lane;
        const v4u w = *(const v4u*)p; float v[8] = {bflo(w.x), bfhi(w.x), bflo(w.y), bfhi(w.y), bflo(w.z), bfhi(w.z), bflo(w.w), bfhi(w.w)};
        float s = 0.f;
#pragma unroll
        for (int j = 0; j < 8; ++j) s += v[j] * v[j];
        const float r = 1.f / sqrtf(wave_sum(s) * (1.f / 512.f) + LN_EPS);
        const f32x4 m0 = *(const f32x4*)(mnorm + g * 512 + 8 * lane), m1 = *(const f32x4*)(mnorm + g * 512 + 8 * lane + 4);
        v4u o; o.x = pk2(v[0] * r * m0.x, v[1] * r * m0.y); o.y = pk2(v[2] * r * m0.z, v[3] * r * m0.w); o.z = pk2(v[4] * r * m1.x, v[5] * r * m1.y); o.w = pk2(v[6] * r * m1.z, v[7] * r * m1.w);
        *(v4u*)p = o;
    }
}

struct RwkvW { const float *mu, *w0, *wup, *a0, *aup, *gup, *kk, *ka, *rk, *rlnw, *rlnb; };
typedef float f32x2 __attribute__((ext_vector_type(2)));
#define MFMA16K(a, b, c) __builtin_amdgcn_mfma_f32_16x16x32_bf16(cat8(a, (s16x4){0, 0, 0, 0}), cat8(b, (s16x4){0, 0, 0, 0}), c, 0, 0, 0)
__device__ __forceinline__ s16x4 pack4(f32x4 a) { v2u w; w.x = cvtpk(a[0], a[1]); w.y = cvtpk(a[2], a[3]); return __builtin_bit_cast(s16x4, w); }
__device__ __forceinline__ float fast_sigmoid(float x) { return __builtin_amdgcn_rcpf(1.f + __expf(-x)); }
__device__ __forceinline__ float fast_tanh(float x) { return 1.f - 2.f * __builtin_amdgcn_rcpf(1.f + __expf(2.f * x)); }
__device__ __forceinline__ bf16x8 pack8f(const float* v) { v4u w; w.x = cvtpk(v[0], v[1]); w.y = cvtpk(v[2], v[3]); w.z = cvtpk(v[4], v[5]); w.w = cvtpk(v[6], v[7]); return __builtin_bit_cast(bf16x8, w); }
__device__ __forceinline__ void rwkv_items(const Frame& F, const bf16* P, const bf16* SMS, const RwkvW W, bf16* mix) {
    constexpr int TC = 32, TST = 144, GST = 336, FST = 272, FSZ = TC * FST;
    constexpr int RS = 0, KS = FSZ, VB = 2 * FSZ, OPS = VB + 2 * TC * TST;
    constexpr int AT = OPS, RT = OPS + 4608, BH = OPS + 9216, KH = OPS + 13824, BBAR = OPS + 18432, KBAR = OPS + 23040;
    constexpr int TWD = OPS, SAD = OPS + 4608, SGD = OPS + 9216;
    constexpr int LW = OPS + 27648, ICL = LW + FSZ, GT = ICL + FSZ, AAF = GT + FSZ, SM = AAF + FSZ, MABF = SM + 4096, PCO = MABF + 2048, BON = PCO + 512, N2 = BON + 1024, YR = N2 + 128, MU = YR + FSZ;
    static_assert(SGD + TC * GST <= LW && MU + 1920 <= RING_BYTES, "RWKV LDS map");
    LAS unsigned char* const L = F.lds;
    const int tid0 = F.tid, wave = F.wave;
#define RW_LANES() int tid = tid0; asm volatile("" : "+v"(tid)); const int lane = tid & 63, g = lane >> 4, lr = lane & 15, q4 = lr >> 2, p4 = lane & 3; (void)g; (void)lr; (void)q4; (void)p4
    for (int item = F.bid; item < BATCH * 16; item += F.G) {
        RW_LANES();
        const int b = item >> 4, h = item & 15, hc = h * 64 + lane;
        const bf16* Pr = P + L0_RKVH + (size_t)(b * 16 + h) * 2048 * 192;
        const bf16* Ps = SMS + (size_t)(b * SEQ) * 320;
        const int ct = wave & 3, c0 = h * 64 + 16 * ct + 4 * g;
        __syncthreads();
        if (tid < 480) { const int pc = tid >> 3, q = tid & 7; *(LAS float*)(L + MU + tid * 4) = W.mu[pc < 24 ? (pc >> 3) * 1024 + h * 64 + (pc & 7) * 8 + q : 3072 + (pc - 24) * 8 + q]; }
        bf16x8 wf[5];
        if (wave < 4) {
#pragma unroll
            for (int ks = 0; ks < 2; ++ks) { float t0_[8], t1_[8];
#pragma unroll
                for (int jj = 0; jj < 8; ++jj) { const size_t o = (size_t)(32 * ks + 8 * g + jj) * 1024 + h * 64 + 16 * ct + lr; t0_[jj] = W.wup[o]; t1_[jj] = W.aup[o]; }
                wf[ks] = pack8f(t0_); wf[2 + ks] = pack8f(t1_); asm volatile("" ::: "memory"); }
            wf[4] = wf[0];
        } else {
#pragma unroll
            for (int ks = 0; ks < 5; ++ks) { float t0_[8];
#pragma unroll
                for (int jj = 0; jj < 8; ++jj) t0_[jj] = W.gup[(size_t)(32 * ks + 8 * g + jj) * 1024 + h * 64 + 16 * ct + lr];
                wf[ks] = pack8f(t0_); asm volatile("" ::: "memory"); }
        }
        const float rlw = W.rlnw[hc], rlb = W.rlnb[hc];
        const f32x4 w0v = *(const f32x4*)(W.w0 + c0), a0v = *(const f32x4*)(W.a0 + c0), kk4 = *(const f32x4*)(W.kk + c0), ka4 = *(const f32x4*)(W.ka + c0), rk4 = *(const f32x4*)(W.rk + c0);
        const f32x4 kkp0 = *(const f32x4*)(W.kk + h * 64 + (tid & 7) * 8), kkp1 = *(const f32x4*)(W.kk + h * 64 + (tid & 7) * 8 + 4);
        f32x4 sT[4];
#pragma unroll
        for (int kt = 0; kt < 4; ++kt) sT[kt] = (f32x4){0.f, 0.f, 0.f, 0.f};
        v4u cur[4], prv[4];
#define RW_SLOTS() const int u8 = tid & 255, tt1 = u8 >> 3, pc1 = u8 & 7, ix2 = 256 + tid, tt2g = ix2 / 20, pc2g = ix2 % 20, tt3 = tid / 20, pc3 = tid % 20; \
        const int mu0 = tid & 15, mu1 = wave < 4 ? 16 + pc1 : 24 + pc1, mu2 = wave < 4 ? 32 + pc1 : 40 + pc2g, mu3 = 40 + pc3, ttb2 = wave < 4 ? tt1 : tt2g; \
        const int off0 = ((tid >> 3) & 1) * 64 + (tid & 7) * 8, off1 = wave < 4 ? 128 + pc1 * 8 : pc1 * 8, off2 = wave < 4 ? 64 + pc1 * 8 : 128 + pc2g * 8, off3 = 128 + pc3 * 8; (void)mu0; (void)mu1; (void)mu2; (void)mu3
#define RW_LD1(i_, tt_, base_, pitch_, off_) do { const int t_ = t0n_ + (tt_); cur[i_] = *(const v4u*)((base_) + (size_t)t_ * (pitch_) + (off_)); prv[i_] = t_ > 0 ? *(const v4u*)((base_) + (size_t)(t_ - 1) * (pitch_) + (off_)) : (v4u){0u, 0u, 0u, 0u}; } while (0)
#define RW_LD0(i_, tt_, off_) do { cur[i_] = *(const v4u*)(Ps + (size_t)(t0n_ + (tt_)) * 320 + (off_)); } while (0)
#define RW_LOAD(t0_) do { RW_LANES(); RW_SLOTS(); const int t0n_ = (t0_); RW_LD1(0, tid >> 4, Pr, 192, off0); if (wave < 4) RW_LD1(1, tt1, Pr, 192, off1); else RW_LD0(1, tt1, off1); if (wave < 6) RW_LD0(2, ttb2, off2); RW_LD0(3, tt3, off3); } while (0)
#define RW_SHIFT(v_, i_, mu_) do { const f32x4 m0_ = *(const LAS f32x4*)(L + MU + (mu_) * 32), m1_ = *(const LAS f32x4*)(L + MU + (mu_) * 32 + 16); const v4u cw_ = cur[i_], pw_ = prv[i_]; \
            const float c_[8] = {bflo(cw_.x), bfhi(cw_.x), bflo(cw_.y), bfhi(cw_.y), bflo(cw_.z), bfhi(cw_.z), bflo(cw_.w), bfhi(cw_.w)}; \
            const float p_[8] = {bflo(pw_.x), bfhi(pw_.x), bflo(pw_.y), bfhi(pw_.y), bflo(pw_.z), bfhi(pw_.z), bflo(pw_.w), bfhi(pw_.w)}; \
            _Pragma("unroll") for (int q_ = 0; q_ < 8; ++q_) v_[q_] = c_[q_] + (p_[q_] - c_[q_]) * (q_ < 4 ? m0_[q_ & 3] : m1_[q_ & 3]); } while (0)
#define RW_PASS_E(te_, par_) do { _Pragma("unroll") for (int rep = 0; rep < TC / NWAVES; ++rep) { const int tt = wave + NWAVES * rep, o = tt * FST + lane * 4; const size_t row = (size_t)(b * SEQ + (te_) + tt); \
                const float y = *(LAS float*)(L + YR + o); const float mu = wave_sum(y) * (1.f / 64.f); const float d = y - mu; const float var = wave_sum(d * d) * (1.f / 64.f); \
                const float yn = d * (1.f / sqrtf(var + 64e-5f)) * rlw + rlb; \
                const LAS float* bp_ = (const LAS float*)(L + BON + (par_) * 512 + tt * 4); const float bonus = ((bp_[0] + bp_[32]) + (bp_[64] + bp_[96])) * bf2f(*(LAS bf16*)(L + VB + (par_) * TC * TST + tt * TST + lane * 2)); \
                mix[row * 2048 + 1024 + hc] = (bf16)f2bf((yn + bonus) * *(LAS float*)(L + GT + o)); } } while (0)
        RW_LOAD(0);
        for (int t0 = 0; t0 < SEQ; t0 += TC) {
            const int par = (t0 >> 5) & 1;
            LDS_BARRIER();
            { RW_LANES(); RW_SLOTS();
            { float v[8]; RW_SHIFT(v, 0, mu0); const int base = ((tid & 8) ? KS : RS) + (tid >> 4) * FST + (tid & 7) * 32;
              *(LAS f32x4*)(L + base) = (f32x4){v[0], v[1], v[2], v[3]}; *(LAS f32x4*)(L + base + 16) = (f32x4){v[4], v[5], v[6], v[7]};
              float n2 = 0.f;
#pragma unroll
              for (int q = 0; q < 8; ++q) { const float x = v[q] * (q < 4 ? kkp0[q & 3] : kkp1[q & 3]); n2 += x * x; }
              n2 += __shfl_xor(n2, 1); n2 += __shfl_xor(n2, 2); n2 += __shfl_xor(n2, 4);
              if ((tid & 15) == 8) *(LAS float*)(L + N2 + (tid >> 4) * 4) = n2; }
            if (wave < 4) { float v[8]; RW_SHIFT(v, 1, mu1); *(LAS bf16x8*)(L + VB + par * TC * TST + tt1 * TST + pc1 * 16) = pack8f(v); }
            else *(LAS v4u*)(L + TWD + tt1 * TST + pc1 * 16) = cur[1];
            if (wave < 4) *(LAS v4u*)(L + SAD + tt1 * TST + pc1 * 16) = cur[2];
            else if (wave < 6) *(LAS v4u*)(L + SGD + tt2g * GST + pc2g * 16) = cur[2];
            *(LAS v4u*)(L + SGD + tt3 * GST + pc3 * 16) = cur[3];
            if (t0 > 0) RW_PASS_E(t0 - TC, par ^ 1);
            }
            LDS_BARRIER();
            if (t0 + TC < SEQ) RW_LOAD(t0 + TC);
            { RW_LANES();
#pragma unroll
            for (int tt2 = 0; tt2 < 2; ++tt2) {
                if (wave < 4) { f32x4 dw = (f32x4){0.f, 0.f, 0.f, 0.f}, da = (f32x4){0.f, 0.f, 0.f, 0.f};
#pragma unroll
                    for (int ks = 0; ks < 2; ++ks) {
                        const bf16x8 bw = *(const LAS bf16x8*)(L + TWD + (16 * tt2 + lr) * TST + (32 * ks + 8 * g) * 2), ba = *(const LAS bf16x8*)(L + SAD + (16 * tt2 + lr) * TST + (32 * ks + 8 * g) * 2);
                        dw = MFMA16(wf[ks], bw, dw); da = MFMA16(wf[2 + ks], ba, da); }
                    const int o = (16 * tt2 + lr) * FST + (16 * ct + 4 * g) * 4;
                    const f32x4 kv = *(const LAS f32x4*)(L + KS + o), rv = *(const LAS f32x4*)(L + RS + o);
                    const float inv = 1.f / fmaxf(sqrtf(*(const LAS float*)(L + N2 + (16 * tt2 + lr) * 4)), 1e-12f);
                    f32x4 lw, kp, av, bv; float bon = 0.f;
#pragma unroll
                    for (int r = 0; r < 4; ++r) { lw[r] = -0.6065306597126334f * fast_sigmoid(w0v[r] + dw[r]); const float icl = fast_sigmoid(a0v[r] + da[r]);
                        const float kkn = kv[r] * kk4[r] * inv; kp[r] = kv[r] * (1.f + (icl - 1.f) * ka4[r]); av[r] = -kkn; bv[r] = kkn * icl; bon += rv[r] * kp[r] * rk4[r]; }
                    *(LAS f32x4*)(L + LW + o) = lw; *(LAS f32x4*)(L + KS + o) = kp; *(LAS f32x4*)(L + AAF + o) = av; *(LAS f32x4*)(L + ICL + o) = bv;
                    bon += __shfl_xor(bon, 16); bon += __shfl_xor(bon, 32);
                    if (g == 0) *(LAS float*)(L + BON + par * 512 + ct * 128 + (16 * tt2 + lr) * 4) = bon;
                } else { f32x4 dg = (f32x4){0.f, 0.f, 0.f, 0.f};
#pragma unroll
                    for (int ks = 0; ks < 5; ++ks) { const bf16x8 bg = *(const LAS bf16x8*)(L + SGD + (16 * tt2 + lr) * GST + (32 * ks + 8 * g) * 2); dg = MFMA16(wf[ks], bg, dg); }
                    *(LAS f32x4*)(L + GT + (16 * tt2 + lr) * FST + (16 * ct + 4 * g) * 4) = dg; } }
            }
            LDS_BARRIER();
            { RW_LANES();
            { const int ch = tid >> 8, q = (tid >> 6) & 3, c = lane; float lp[16]; float run = 0.f;
#pragma unroll
              for (int t = 0; t < 16; ++t) { run += *(LAS float*)(L + LW + (16 * ch + t) * FST + c * 4); lp[t] = run; }
              const float lend = lp[15];
#pragma unroll
              for (int t = 0; t < 16; ++t) if ((t >> 2) == q) { const int tok = 16 * ch + t, o = tok * FST + c * 4, ob = tok * TST + c * 2;
                  const float av = *(LAS float*)(L + AAF + o), bv = *(LAS float*)(L + ICL + o), kp = *(LAS float*)(L + KS + o), rv = *(LAS float*)(L + RS + o);
                  const float em1 = t ? __expf(lp[t ? t - 1 : 0]) : 1.f, et = __expf(lp[t]), iet = __expf(-lp[t]), ee = __expf(lend - lp[t]);
                  *(LAS bf16*)(L + AT + ob) = (bf16)f2bf(av * em1); *(LAS bf16*)(L + RT + ob) = (bf16)f2bf(rv * et); *(LAS bf16*)(L + BH + ob) = (bf16)f2bf(bv * iet);
                  *(LAS bf16*)(L + KH + ob) = (bf16)f2bf(kp * iet); *(LAS bf16*)(L + BBAR + ob) = (bf16)f2bf(bv * ee); *(LAS bf16*)(L + KBAR + ob) = (bf16)f2bf(kp * ee); }
              if (q == 0) *(LAS float*)(L + PCO + (ch * 64 + c) * 4) = __expf(lend); }
            }
            LDS_BARRIER();
            { RW_LANES();
            { const int mi = wave & 3, ch = wave >> 2; const int lhs = (mi & 1) ? KH : BH, rhs = (mi & 2) ? RT : AT; f32x4 acc = (f32x4){0.f, 0.f, 0.f, 0.f};
#pragma unroll
              for (int ks = 0; ks < 2; ++ks) { const bf16x8 a_ = *(const LAS bf16x8*)(L + lhs + (16 * ch + lr) * TST + (32 * ks + 8 * g) * 2), b_ = *(const LAS bf16x8*)(L + rhs + (16 * ch + lr) * TST + (32 * ks + 8 * g) * 2);
                  acc = MFMA16(a_, b_, acc); }
#pragma unroll
              for (int r = 0; r < 4; ++r) { const int s_ = 4 * g + r; acc[r] = ((mi < 2) ? (s_ < lr) : (s_ <= lr)) ? acc[r] : 0.f; }
              if (mi != 0) *(LAS s16x4*)(L + SM + ch * 2048 + (mi - 1) * 512 + lr * 32 + 8 * g) = pack4(acc);
              else {
#pragma unroll
                  for (int r = 0; r < 4; ++r) *(LAS float*)(L + MABF + ch * 1024 + ((4 * g + r) * 16 + lr) * 4) = acc[r];
                  float m[16];
#pragma unroll
                  for (int s_ = 15; s_ >= 0; --s_) { float row[16];
#pragma unroll
                      for (int u4 = 0; u4 < 4; ++u4) { const f32x4 rv = *(const LAS f32x4*)(L + MABF + ch * 1024 + s_ * 64 + u4 * 16); row[4 * u4] = rv[0]; row[4 * u4 + 1] = rv[1]; row[4 * u4 + 2] = rv[2]; row[4 * u4 + 3] = rv[3]; }
                      float sum = (s_ == lr) ? 1.f : 0.f;
#pragma unroll
                      for (int u = s_ + 1; u < 16; ++u) sum += row[u] * m[u];
                      m[s_] = sum; asm volatile("" ::: "memory"); }
                  if (lane < 16) { *(LAS bf16x8*)(L + SM + ch * 2048 + 1536 + lr * 32) = pack8f(m); *(LAS bf16x8*)(L + SM + ch * 2048 + 1536 + lr * 32 + 16) = pack8f(m + 8); }
              } }
            }
            LDS_BARRIER();
            { RW_LANES();
            if (wave < 4) {
#pragma unroll 1
                for (int ch = 0; ch < 2; ++ch) {
                    const bf16x8 sf0 = pack8(sT[0], sT[1]), sf1 = pack8(sT[2], sT[3]);
                    const s16x4 vf = lds_tr(L + VB + par * TC * TST + (16 * ch + 4 * g + q4) * TST + (16 * wave + 4 * p4) * 2);
                    const int rowb = (16 * ch + lr) * TST, smb = SM + ch * 2048 + lr * 32 + 8 * g;
                    f32x4 x = (f32x4){0.f, 0.f, 0.f, 0.f}, y = (f32x4){0.f, 0.f, 0.f, 0.f};
                    x = MFMA16(cat8(*(const LAS s16x4*)(L + AT + rowb + (4 * g) * 2), *(const LAS s16x4*)(L + AT + rowb + (16 + 4 * g) * 2)), sf0, x);
                    x = MFMA16(cat8(*(const LAS s16x4*)(L + AT + rowb + (32 + 4 * g) * 2), *(const LAS s16x4*)(L + AT + rowb + (48 + 4 * g) * 2)), sf1, x);
                    x = MFMA16K(*(const LAS s16x4*)(L + smb), vf, x);
                    const s16x4 xf = pack4(x);
                    const f32x4 sa = MFMA16K(*(const LAS s16x4*)(L + smb + 1536), xf, ((f32x4){0.f, 0.f, 0.f, 0.f}));
                    const s16x4 saf = pack4(sa);
                    y = MFMA16(cat8(*(const LAS s16x4*)(L + RT + rowb + (4 * g) * 2), *(const LAS s16x4*)(L + RT + rowb + (16 + 4 * g) * 2)), sf0, y);
                    y = MFMA16(cat8(*(const LAS s16x4*)(L + RT + rowb + (32 + 4 * g) * 2), *(const LAS s16x4*)(L + RT + rowb + (48 + 4 * g) * 2)), sf1, y);
                    y = MFMA16K(*(const LAS s16x4*)(L + smb + 512), saf, y);
                    y = MFMA16K(*(const LAS s16x4*)(L + smb + 1024), vf, y);
#pragma unroll
                    for (int kt = 0; kt < 4; ++kt) { const f32x4 pc = *(const LAS f32x4*)(L + PCO + (ch * 64 + 16 * kt + 4 * g) * 4);
                        const s16x4 bb = lds_tr(L + BBAR + (16 * ch + 4 * g + q4) * TST + (16 * kt + 4 * p4) * 2), kb = lds_tr(L + KBAR + (16 * ch + 4 * g + q4) * TST + (16 * kt + 4 * p4) * 2);
                        f32x4 sn = sT[kt] * pc; sn = MFMA16K(bb, saf, sn); sn = MFMA16K(kb, vf, sn); sT[kt] = sn; }
#pragma unroll
                    for (int r = 0; r < 4; ++r) *(LAS float*)(L + YR + (16 * ch + 4 * g + r) * FST + (16 * wave + lr) * 4) = y[r];
                }
            }
            }
        }
        LDS_BARRIER();
        { RW_LANES(); RW_PASS_E(SEQ - TC, ((SEQ - TC) >> 5) & 1); }
#undef RW_LOAD
#undef RW_LD1
#undef RW_LD0
#undef RW_SHIFT
#undef RW_LANES
#undef RW_SLOTS
#undef RW_PASS_E
    }
}

__device__ __forceinline__ void retention_mfma(const Frame& F, bf16* Q) {
    constexpr int KST = 528, VST = 272, SST = 528;
    constexpr int KOFF = 0, VOFF = 64 * KST, SOFF = VOFF + 64 * VST;
    LAS unsigned char* const L = F.lds;
    const int tid = F.tid, lane0 = F.lane, w = F.wave;
    const int it = w & 3, vh = w >> 2;
#define RT_LANES() int lane = lane0; asm volatile("" : "+v"(lane)); const int g = lane >> 4, lr = lane & 15, q4 = lr >> 2, p4 = lane & 3; (void)g; (void)lr; (void)q4; (void)p4
    const int lr0 = lane0 & 15;
    for (int item = F.bid; item < BATCH * 16; item += F.G) {
        const int b = item >> 4, h = (item >> 2) & 3, sl = item & 3;
        const float lg2 = log2f(1.f - exp2f(-5.f - (float)h));
        const float g64 = exp2f(64.f * lg2);
        const float vf0 = exp2f(-(float)((tid >> 4) + 1) * lg2), vf1 = exp2f(-(float)((tid >> 4) + 33) * lg2);
        const float ysc = exp2f((float)(16 * it + lr0 + 1) * lg2);
        const bf16* qg = Q + L1_QKH + (size_t)(b * 4 + h) * 2048 * 512;
        const bf16* kg = qg + 256;
        bf16* vg = Q + L1_VH + (size_t)((b * 4 + h) * 4 + sl) * 2048 * 128;
        f32x4 st[2][8];
#pragma unroll
        for (int a = 0; a < 2; ++a)
#pragma unroll
            for (int c = 0; c < 8; ++c) st[a][c] = (f32x4){0.f, 0.f, 0.f, 0.f};
        __syncthreads();
        for (int i = tid; i < 128 * SST / 16; i += NTHR) *(LAS v4u*)(L + SOFF + i * 16) = (v4u){0u, 0u, 0u, 0u};
        v4u kp[4], vp[2];
#define RET_LOAD(c) do { const size_t r0_ = (size_t)(64 * (c)); \
            _Pragma("unroll") for (int i_ = 0; i_ < 4; ++i_) { const int p_ = tid + NTHR * i_; kp[i_] = *(const v4u*)(kg + (r0_ + (p_ >> 5)) * 512 + (p_ & 31) * 8); } \
            _Pragma("unroll") for (int i_ = 0; i_ < 2; ++i_) { const int p_ = tid + NTHR * i_; vp[i_] = *(const v4u*)(vg + (r0_ + (p_ >> 4)) * 128 + (p_ & 15) * 8); } } while (0)
        RET_LOAD(0);
        bf16x8 qc[8];
#define RET_QLOAD(c_) do { RT_LANES(); _Pragma("unroll") for (int ks = 0; ks < 8; ++ks) qc[ks] = *(const bf16x8*)(qg + (size_t)(64 * (c_) + 16 * it + lr) * 512 + 32 * ks + 8 * g); } while (0)
        RET_QLOAD(0);
        for (int c = 0; c < SEQ / 64; ++c) {
#pragma unroll
            for (int i = 0; i < 4; ++i) { const int p = tid + NTHR * i; *(LAS v4u*)(L + KOFF + (p >> 5) * KST + (p & 31) * 16) = kp[i]; }
#pragma unroll
            for (int i = 0; i < 2; ++i) { const int p = tid + NTHR * i; const float f = i ? vf1 : vf0; const v4u x = vp[i]; v4u o;
                o.x = cvtpk(bflo(x.x) * f, bfhi(x.x) * f); o.y = cvtpk(bflo(x.y) * f, bfhi(x.y) * f); o.z = cvtpk(bflo(x.z) * f, bfhi(x.z) * f); o.w = cvtpk(bflo(x.w) * f, bfhi(x.w) * f);
                *(LAS v4u*)(L + VOFF + (p >> 4) * VST + (p & 15) * 16) = o; }
            LDS_BARRIER();
            if (c + 1 < SEQ / 64) RET_LOAD(c + 1);
            { RT_LANES();
#pragma unroll
            for (int s2 = 0; s2 < 2; ++s2) { bf16x8 ka[2];
#pragma unroll
                for (int dt = 0; dt < 2; ++dt) { const s16x4 lo = lds_tr(L + KOFF + (32 * s2 + 8 * g + q4) * KST + (32 * w + 16 * dt + 4 * p4) * 2), hi = lds_tr(L + KOFF + (32 * s2 + 8 * g + 4 + q4) * KST + (32 * w + 16 * dt + 4 * p4) * 2); ka[dt] = cat8(lo, hi); }
#pragma unroll
                for (int vq = 0; vq < 2; ++vq) { bf16x8 vb[4];
#pragma unroll
                    for (int v4 = 0; v4 < 4; ++v4) { const int vt = 4 * vq + v4; const s16x4 lo = lds_tr(L + VOFF + (32 * s2 + 8 * g + q4) * VST + (16 * vt + 4 * p4) * 2), hi = lds_tr(L + VOFF + (32 * s2 + 8 * g + 4 + q4) * VST + (16 * vt + 4 * p4) * 2); vb[v4] = cat8(lo, hi); }
                    __builtin_amdgcn_sched_barrier(0);
#pragma unroll
                    for (int v4 = 0; v4 < 4; ++v4) { st[0][4 * vq + v4] = MFMA16(ka[0], vb[v4], st[0][4 * vq + v4]); st[1][4 * vq + v4] = MFMA16(ka[1], vb[v4], st[1][4 * vq + v4]); }
                    __builtin_amdgcn_sched_barrier(0); } }
#pragma unroll
            for (int dt = 0; dt < 2; ++dt)
#pragma unroll
                for (int vt = 0; vt < 8; ++vt) st[dt][vt] = st[dt][vt] * g64;
            }
            __builtin_amdgcn_sched_barrier(0);
            { RT_LANES();
            f32x4 sacc[4];
#pragma unroll
            for (int jt = 0; jt < 4; ++jt) { sacc[jt] = (f32x4){0.f, 0.f, 0.f, 0.f};
                if (jt <= it) { bf16x8 kr[8];
#pragma unroll
                    for (int ks = 0; ks < 8; ++ks) kr[ks] = *(const LAS bf16x8*)(L + KOFF + (16 * jt + lr) * KST + (32 * ks + 8 * g) * 2);
                    __builtin_amdgcn_sched_barrier(0);
#pragma unroll
                    for (int ks = 0; ks < 8; ++ks) sacc[jt] = MFMA16(kr[ks], qc[ks], sacc[jt]);
                    if (jt == it) {
#pragma unroll
                        for (int r = 0; r < 4; ++r) sacc[jt][r] = (4 * g + r <= lr) ? sacc[jt][r] : 0.f; }
                    __builtin_amdgcn_sched_barrier(0);
                } }
            bf16x8 sf[2]; sf[0] = pack8(sacc[0], sacc[1]); sf[1] = pack8(sacc[2], sacc[3]); __builtin_amdgcn_sched_barrier(0);
#pragma unroll
            for (int x = 0; x < 4; ++x) { const int vt = 4 * vh + x; f32x4 y = (f32x4){0.f, 0.f, 0.f, 0.f};
#pragma unroll
                for (int kh = 0; kh < 2; ++kh) { bf16x8 sr[4];
#pragma unroll
                    for (int k4 = 0; k4 < 4; ++k4) sr[k4] = *(const LAS bf16x8*)(L + SOFF + (16 * vt + lr) * SST + (32 * (4 * kh + k4) + 8 * g) * 2);
                    __builtin_amdgcn_sched_barrier(0);
#pragma unroll
                    for (int k4 = 0; k4 < 4; ++k4) y = MFMA16(sr[k4], qc[4 * kh + k4], y);
                    __builtin_amdgcn_sched_barrier(0); }
#pragma unroll
                for (int s2 = 0; s2 < 2; ++s2) if (2 * s2 <= it) {
                    const s16x4 lo = lds_tr(L + VOFF + (32 * s2 + 4 * g + q4) * VST + (16 * vt + 4 * p4) * 2), hi = lds_tr(L + VOFF + (32 * s2 + 16 + 4 * g + q4) * VST + (16 * vt + 4 * p4) * 2);
                    y = MFMA16(cat8(lo, hi), sf[s2], y); }
                v2u o; o.x = cvtpk(y[0] * ysc, y[1] * ysc); o.y = cvtpk(y[2] * ysc, y[3] * ysc);
                *(v2u*)(vg + (size_t)(64 * c + 16 * it + lr) * 128 + 16 * vt + 4 * g) = o; __builtin_amdgcn_sched_barrier(0); }
            }
            if (c + 1 < SEQ / 64) RET_QLOAD(c + 1);
            LDS_BARRIER();
            { RT_LANES();
#pragma unroll
            for (int dt = 0; dt < 2; ++dt)
#pragma unroll
                for (int vt = 0; vt < 8; ++vt) { v2u o; o.x = cvtpk(st[dt][vt][0], st[dt][vt][1]); o.y = cvtpk(st[dt][vt][2], st[dt][vt][3]);
                    *(LAS v2u*)(L + SOFF + (16 * vt + lr) * SST + (32 * w + 16 * dt + 4 * g) * 2) = o; }
            }
        }
#undef RET_LOAD
#undef RET_QLOAD
#undef RT_LANES
    }
}

__device__ __forceinline__ void retention_norm(const Frame& F, bf16* Q) {
    const int gw = F.bid * NWAVES + F.wave, NGW = F.G * NWAVES, lane = F.lane;
    for (int it = gw; it < MTOK * 4; it += NGW) {
        const int row = it >> 2, h = it & 3, c8 = 8 * lane; const bf16* yp = Q + L1_VH + ((size_t)(((row >> 11) * 4 + h) * 4 + (c8 >> 7)) * 2048 + (row & 2047)) * 128 + (c8 & 127); bf16* gp = Q + L1_GB + (size_t)row * 2048 + h * 512 + c8;
        const v4u w = *(const v4u*)yp; const v4u gq = *(const v4u*)gp;
        float v[8] = {bflo(w.x), bfhi(w.x), bflo(w.y), bfhi(w.y), bflo(w.z), bfhi(w.z), bflo(w.w), bfhi(w.w)};
        const float g[8] = {bflo(gq.x), bfhi(gq.x), bflo(gq.y), bfhi(gq.y), bflo(gq.z), bfhi(gq.z), bflo(gq.w), bfhi(gq.w)};
        float s = 0.f;
#pragma unroll
        for (int j = 0; j < 8; ++j) s += v[j];
        const float mean = wave_sum(s) * (1.f / 512.f); float s2 = 0.f;
#pragma unroll
        for (int j = 0; j < 8; ++j) { v[j] -= mean; s2 += v[j] * v[j]; }
        const float r = 1.f / sqrtf(wave_sum(s2) * (1.f / 512.f) + LN_EPS);
        float o[8];
#pragma unroll
        for (int j = 0; j < 8; ++j) o[j] = silu_f(g[j]) * v[j] * r;
        v4u ow; ow.x = pk2(o[0], o[1]); ow.y = pk2(o[2], o[3]); ow.z = pk2(o[4], o[5]); ow.w = pk2(o[6], o[7]);
        *(v4u*)gp = ow;
    }
}

__device__ __forceinline__ int pad256(int n) { return (n + 255) & ~255; }
__device__ __forceinline__ void moe_slots(const Frame& F, const unsigned* cnt, const int* tok_e, const float* tok_p, const int* tok_pos, int* rowtok, int* rowdst, float* rowp) {
    const int gt = F.bid * NTHR + F.tid, NGT = F.G * NTHR;
    for (int row = gt; row < MTOK; row += NGT) {
        const int e01 = tok_e[row], e0 = e01 & 255, e1 = e01 >> 8; const float p0 = tok_p[row];
        int base0 = 0, base1 = 0;
#pragma unroll
        for (int e = 0; e < 8; ++e) { const int pc = pad256((int)cnt[e]); if (e < e0) base0 += pc; if (e < e1) base1 += pc; }
        const int s0 = base0 + tok_pos[2 * row], s1 = base1 + tok_pos[2 * row + 1];
        rowtok[s0] = row; rowdst[s0] = row; rowp[s0] = p0;
        rowtok[s1] = row; rowdst[s1] = MTOK + row; rowp[s1] = 1.f - p0;
    }
    for (int it = gt; it < 8 * 256; it += NGT) {
        const int e = it >> 8, i = it & 255;
        int base = 0;
#pragma unroll
        for (int q = 0; q < 8; ++q) if (q < e) base += pad256((int)cnt[q]);
        const int n = (int)cnt[e];
        if (n + i < pad256(n)) { const int s = base + n + i; rowtok[s] = 0; rowdst[s] = -1; rowp[s] = 0.f; }
    }
}
struct MoeOrder {
    int npan, nN, G, c; const char* W; size_t estride, tstepB; const int* rows; const LAS int* pexp; int p0;
    __device__ bool next(int i, pg8::Unit& u) const {
        const int nwg = npan * nN; const long L = (long)i * G + c; if (L >= nwg) return false;
        int wgid = (int)L; { const int q = nwg / pg8::NXCD, r = nwg % pg8::NXCD, xcd = wgid % pg8::NXCD, off = wgid / pg8::NXCD; wgid = (xcd < r ? xcd * (q + 1) : r * (q + 1) + (xcd - r) * q) + off; }
        const int nig = pg8::WGM * nN, gid = wgid / nig, fm = gid * pg8::WGM, gsz = (npan - fm) < pg8::WGM ? (npan - fm) : pg8::WGM;
        u.pm = fm + ((wgid % nig) % gsz); u.pn = (wgid % nig) / gsz; return true; }
    __device__ __forceinline__ const char* b_base(const pg8::Unit& u) const { const int e = __builtin_amdgcn_readfirstlane(pexp[p0 + u.pm]); return W + (size_t)e * estride + (size_t)u.pn * tstepB; }
    __device__ __forceinline__ const int* a_rows(const pg8::Unit& u) const { return rows + (p0 + u.pm) * 256; }
};
__device__ __forceinline__ int moe_panels(const unsigned* cnt, LAS int* pexp, int tid) {
    int pb[9]; pb[0] = 0;
#pragma unroll
    for (int e = 0; e < 8; ++e) pb[e + 1] = pb[e] + pad256((int)cnt[e]) / 256;
    if (tid < MOE_SLOTS / 256) { int e = 0;
#pragma unroll
        for (int q = 1; q < 8; ++q) e += (tid >= pb[q]) ? 1 : 0;
        pexp[tid] = e; }
    __syncthreads();
    return pb[8];
}

__global__ void __launch_bounds__(NTHR, 2) fwd_kernel(Args args) {
    extern __shared__ __attribute__((aligned(16))) unsigned char lds_raw[];
    Frame F;
    F.lds = (LAS unsigned char*)lds_raw;
    F.tid = threadIdx.x; F.lane = F.tid & 63; F.wave = __builtin_amdgcn_readfirstlane(F.tid >> 6); F.G = gridDim.x; F.bid = blockIdx.x;
    typedef const unsigned char __attribute__((address_space(4))) kseg_t;
    kseg_t* kp0 = (kseg_t*)__builtin_amdgcn_kernarg_segment_ptr();
#define KARG(T, off) (*(T const __attribute__((address_space(4)))*)(kp + (off)))
#define PHASE_ENTER { int l_; asm volatile("v_mbcnt_lo_u32_b32 %0, -1, 0\n\tv_mbcnt_hi_u32_b32 %0, -1, %0" : "=v"(l_)); F.lane = l_; F.tid = F.wave * 64 + l_; } kseg_t* kp = kp0; asm volatile("" : "+s"(kp)); unsigned char* const ws = KARG(unsigned char*, 38 * 8 + 8); gu32* const ctl = (gu32*)(ws + WS_CTL); (void)ctl
#define INP(i) KARG(const float*, 8 * (i))
#define OUTP KARG(float*, 38 * 8)
#define WSP(T, off) ((T*)(ws + (off)))
    int lo, hi;
    { kseg_t* kp = kp0; lo = KARG(int, 38 * 8 + 16); hi = KARG(int, 38 * 8 + 20); }
    volatile LAS unsigned* MISC = (volatile LAS unsigned*)(F.lds + MISC_OFF);
    for (int u = F.tid; u < (LDS_BYTES - RING_BYTES) / 4; u += NTHR) ((LAS unsigned*)(F.lds + RING_BYTES))[u] = 0u;
    __syncthreads();
    const bool multi = (hi - lo) > 1;
    XcdBarrier bar; bar.x = 0; bar.st = nullptr;
    { PHASE_ENTER; bar.bar = (unsigned*)(ctl + CW_BAR); if (multi) bar = xcd_barrier_post((unsigned*)(ctl + CW_BAR), MISC + 8); }
#ifndef PH_MASK
#define PH_MASK 0xFFFFFFu
#endif
#define IN(k) (((PH_MASK >> (k)) & 1u) && lo <= (k) && (k) < hi)
#define SEAM(k) do { if (IN(k) && IN((k) + 1)) xcd_barrier(bar); } while (0)
#define W0IN WSP(bf16, WS_W0IN)
#define W0OUT WSP(bf16, WS_W0OUT)
#define W0GU WSP(bf16, WS_W0GU)
#define W0D WSP(bf16, WS_W0D)
#define W1IN WSP(bf16, WS_W1IN)
#define W1OUT WSP(bf16, WS_W1OUT)
#define XB WSP(bf16, WS_XB)
#define P WSP(bf16, WS_P)
#define X1 WSP(float, WS_X1)
#define HID WSP(bf16, WS_HID)
#define HB WSP(bf16, WS_H)
#define MIX ((bf16*)OUTP)
#define OUT OUTP
#define MOEGU ((bf16*)OUTP)
#define MOED WSP(bf16, WS_MOED)
#define Y0 WSP(bf16, WS_Y0)
#define Y1 WSP(bf16, WS_Y1)
#define MHID WSP(bf16, WS_MHID)
#define TOK_E WSP(int, WS_TAB + TAB_E)
#define TOK_P WSP(float, WS_TAB + TAB_P)
#define TOK_POS WSP(int, WS_TAB + TAB_POS)
#define ROWTOK WSP(int, WS_TAB + TAB_ROWTOK)
#define ROWDST WSP(int, WS_TAB + TAB_ROWDST)
#define ROWP WSP(float, WS_TAB + TAB_ROWP)
#define CNT ((unsigned*)(ctl + CW_CNT))
#define CSTAB WSP(float, WS_CS)
#define XA WSP(bf16, WS_H)
#define BCA WSP(bf16, WS_XB)
#define SMSB WSP(bf16, WS_XB + 32 * MiB)
    const int gw = F.bid * NWAVES + F.wave, NGW = F.G * NWAVES;
    LAS float* const scr = (LAS float*)(F.lds + F.wave * 16384);

    if (IN(0)) { PHASE_ENTER;
        transpose_job<1>(INP(I_EV_WIN), nullptr, 5936, 1024, W0IN, 6144, scr, gw, NGW, F.lane);
        transpose_job<0>(INP(I_EV_WOUT), nullptr, 1024, 2048, W0OUT, 1024, scr, gw, NGW, F.lane);
        transpose_job<2>(INP(I_FFN_WG), INP(I_FFN_WU), 3584, 1024, W0GU, 7168, scr, gw, NGW, F.lane);
        transpose_job<0>(INP(I_FFN_WD), nullptr, 1024, 3584, W0D, 1024, scr, gw, NGW, F.lane);
        transpose_job<0>(INP(I_OD_WIN), nullptr, 6144, 1024, W1IN, 6144, scr, gw, NGW, F.lane);
        transpose_job<0>(INP(I_OD_WOUT), nullptr, 1024, 2048, W1OUT, 1024, scr, gw, NGW, F.lane);
        const float* x = INP(I_X);
        for (size_t i = (size_t)(F.bid * NTHR + F.tid) * 8; i < (size_t)MTOK * DM; i += (size_t)F.G * NTHR * 8) {
            const f32x4 a = __builtin_nontemporal_load((const f32x4*)(x + i)), b = __builtin_nontemporal_load((const f32x4*)(x + i + 4));
            v4u o; o.x = pk2(a.x, a.y); o.y = pk2(a.z, a.w); o.z = pk2(b.x, b.y); o.w = pk2(b.z, b.w); *(v4u*)(XB + i) = o; }
    }
    SEAM(0);
    if (IN(1)) { PHASE_ENTER; pg8::StaticOrder S; S.init(MTOK, PW, F.G, F.bid, W0IN, 1024); pg8::EpiRoute0 E{P, L0_XBC, L0_RKVH, L0_SMB};
        pg8::gemm_phase<pg8::EpiRoute0, pg8::StaticOrder, true, false>(F.lds, XB, 1024, 1024, 1024, S, E); }
    SEAM(1);
    if (IN(2)) { PHASE_ENTER; conv_prepass(F, P, INP(I_CONVW), INP(I_CONVB), XA, BCA); small_prepass(F, P + L0_SMB, INP(I_MU), SMSB); }
    SEAM(2);
    if (IN(3)) { PHASE_ENTER;
        ssd_mfma(F, P, XA, BCA, INP(I_DTB), INP(I_ALOG), INP(I_DSKIP), MIX);
        __syncthreads();
        RwkvW W{INP(I_MU), INP(I_W0), INP(I_WUP), INP(I_A0), INP(I_AUP), INP(I_GUP), INP(I_KK), INP(I_KA), INP(I_RK), INP(I_RLNW), INP(I_RLNB)};
        rwkv_items(F, P, SMSB, W, MIX);
    }
    SEAM(3);
    if (IN(4)) { PHASE_ENTER; ssd_norm(F, MIX, INP(I_MNORM)); }
    SEAM(4);
    if (IN(5)) { PHASE_ENTER; pg8::StaticOrder S; S.init(MTOK, 1024, F.G, F.bid, W0OUT, 2048); pg8::EpiStore E{HB, 1024};
        pg8::gemm_phase<pg8::EpiStore, pg8::StaticOrder, true, false>(F.lds, MIX, 2048, 2048, 2048, S, E); }
    SEAM(5);
    if (IN(6)) { PHASE_ENTER; ln_rows<false, false>(F, INP(I_X), nullptr, HB, nullptr, INP(I_EV_LN1G), INP(I_EV_LN1B), nullptr, XB, 0, MTOK, nullptr, nullptr, nullptr, nullptr, nullptr); }
    SEAM(6);
    if (IN(7)) { PHASE_ENTER; pg8::StaticOrder S; S.init(MTOK, 2 * DFF, F.G, F.bid, W0GU, 1024); pg8::EpiSwiGLU E{HID, DFF};
        pg8::gemm_phase<pg8::EpiSwiGLU, pg8::StaticOrder, true, false>(F.lds, XB, 1024, 1024, 1024, S, E); }
    SEAM(7);
    if (IN(8)) { PHASE_ENTER; pg8::StaticOrder S; S.init(MTOK, 1024, F.G, F.bid, W0D, DFF); pg8::EpiStore E{HB, 1024};
        pg8::gemm_phase<pg8::EpiStore, pg8::StaticOrder, true, false>(F.lds, HID, DFF, DFF, DFF, S, E); }
    SEAM(8);
    if (IN(9)) { PHASE_ENTER; ln_rows<false, false>(F, nullptr, XB, HB, nullptr, INP(I_EV_LN2G), INP(I_EV_LN2B), nullptr, XB, 0, MTOK, nullptr, nullptr, nullptr, nullptr, nullptr); }
    SEAM(9);
    if (IN(10)) { PHASE_ENTER; pg8::StaticOrder S; S.init(MTOK, PW, F.G, F.bid, W1IN, 1024); pg8::EpiRoute1 E{P, L1_VH, L1_GB, (const int*)INP(I_POS)};
        pg8::gemm_phase<pg8::EpiRoute1, pg8::StaticOrder, true, false>(F.lds, XB, 1024, 1024, 1024, S, E); }
    SEAM(10);
    if (IN(11)) { PHASE_ENTER; retention_mfma(F, P); }
    SEAM(11);
    if (IN(12)) { PHASE_ENTER; retention_norm(F, P); }
    SEAM(12);
    if (IN(13)) { PHASE_ENTER; pg8::StaticOrder S; S.init(MTOK, 1024, F.G, F.bid, W1OUT, 2048); pg8::EpiStore E{HB, 1024};
        pg8::gemm_phase<pg8::EpiStore, pg8::StaticOrder, true, false>(F.lds, P + L1_GB, 2048, 2048, 2048, S, E); }
    SEAM(13);
    if (IN(14)) { PHASE_ENTER; ln_rows<true, false>(F, nullptr, XB, HB, nullptr, INP(I_OD_LN1G), INP(I_OD_LN1B), nullptr, XB, 0, MTOK, INP(I_ROUTER), CNT, TOK_E, TOK_P, TOK_POS); }
    SEAM(14);
    if (IN(15)) { PHASE_ENTER;
        for (int e = 0; e < NEXP; ++e) transpose_job<0>(INP(I_MOE_WD) + (size_t)e * DFF * 1024, nullptr, 1024, DFF, MOED + (size_t)e * 1024 * DFF, 1024, scr, gw, NGW, F.lane);
        for (int e = NEXP - 1; e >= 0; --e)
            transpose_job<2>(INP(I_MOE_WG) + (size_t)e * 1024 * DFF, INP(I_MOE_WU) + (size_t)e * 1024 * DFF, DFF, 1024, MOEGU + (size_t)e * 7168 * 1024, 7168, scr, gw, NGW, F.lane);
        moe_slots(F, CNT, TOK_E, TOK_P, TOK_POS, ROWTOK, ROWDST, ROWP);
    }
    SEAM(15);
#pragma unroll
    for (int part = 0; part < 2; ++part) {
        const int pa = 16 + 2 * part;
        if (IN(pa)) { PHASE_ENTER;
            LAS int* pexp = (LAS int*)(F.lds + PEXP_OFF);
            const int ptot = moe_panels(CNT, pexp, F.tid); const int p0 = part ? MOE_P1 : 0, np = part ? ptot - MOE_P1 : (ptot < MOE_P1 ? ptot : MOE_P1);
            MoeOrder S{np, 28, F.G, F.bid, (const char*)MOEGU, (size_t)7168 * 1024 * 2, (size_t)256 * 1024 * 2, ROWTOK, pexp, p0};
            pg8::EpiSwiGLU E{MHID, DFF};
            pg8::gemm_phase<pg8::EpiSwiGLU, MoeOrder, true, true>(F.lds, XB, 1024, 1024, 1024, S, E);
        }
        SEAM(pa);
        if (IN(pa + 1)) { PHASE_ENTER;
            LAS int* pexp = (LAS int*)(F.lds + PEXP_OFF);
            const int ptot = moe_panels(CNT, pexp, F.tid); const int p0 = part ? MOE_P1 : 0, np = part ? ptot - MOE_P1 : (ptot < MOE_P1 ? ptot : MOE_P1);
            MoeOrder S{np, 4, F.G, F.bid, (const char*)MOED, (size_t)1024 * DFF * 2, (size_t)256 * DFF * 2, nullptr, pexp, p0};
            pg8::EpiMoeOut E{Y0, Y1, 1024, MTOK, ROWDST + p0 * 256, ROWP + p0 * 256};
            pg8::gemm_phase<pg8::EpiMoeOut, MoeOrder, true, false>(F.lds, MHID, DFF, DFF, DFF, S, E);
        }
        SEAM(pa + 1);
    }
    if (IN(20)) { PHASE_ENTER; ln_rows<false, true>(F, nullptr, XB, Y0, Y1, INP(I_OD_LN2G), INP(I_OD_LN2B), OUT, nullptr, 0, MTOK, nullptr, nullptr, nullptr, nullptr, nullptr); }
#undef IN
#undef SEAM
#undef INP
#undef P
}
constexpr int N_PHASES = 21;

extern "C" void kernel_launch(void* const* d_in, const int* in_sizes, int n_in, void* d_out, int out_size, void* d_ws, size_t ws_size, hipStream_t stream) {
    static int grid = 0;
    if (grid == 0) {
        if (n_in != 38 || out_size != MTOK * DM || ws_size < WS_END) { fprintf(stderr, "kernel_launch: unexpected shapes (n_in %d out %d ws %zu)\n", n_in, out_size, ws_size); grid = -1; return; }
        int dev = 0, cus = 0;
        if (hipGetDevice(&dev) != hipSuccess || hipDeviceGetAttribute(&cus, hipDeviceAttributeMultiprocessorCount, dev) != hipSuccess) { grid = -1; return; }
        if (hipFuncSetAttribute((const void*)fwd_kernel, hipFuncAttributeMaxDynamicSharedMemorySize, LDS_BYTES) != hipSuccess) { grid = -1; return; }
        int per_cu = 0;
        (void)hipOccupancyMaxActiveBlocksPerMultiprocessor(&per_cu, (const void*)fwd_kernel, NTHR, LDS_BYTES);
        (void)hipGetLastError();
        grid = cus;
    }
    if (grid < 0) return;
    (void)hipMemsetAsync((char*)d_ws + WS_CTL, 0, CTL_ZERO_BYTES, stream);
    Args a{};
    for (int i = 0; i < 38; ++i) a.in[i] = d_in[i];
    a.out = (float*)d_out; a.ws = (unsigned char*)d_ws;
#if MK_ONE_LAUNCH
    a.ph_lo = 0; a.ph_hi = N_PHASES;
    hipLaunchKernelGGL(fwd_kernel, dim3(grid), dim3(NTHR), LDS_BYTES, stream, a);
#else
    for (int p = 0; p < N_PHASES; ++p) { a.ph_lo = p; a.ph_hi = p + 1; hipLaunchKernelGGL(fwd_kernel, dim3(grid), dim3(NTHR), LDS_BYTES, stream, a); }
#endif
}
```

```cpp
#include <hip/hip_runtime.h>
#include <cstdio>
#include <cstdint>

#ifndef MK_ONE_LAUNCH
#define MK_ONE_LAUNCH 1
#endif

namespace pg8 {
#define PG8_LAS __attribute__((address_space(3)))
typedef unsigned short bf16_t;
typedef short bf16x8 __attribute__((ext_vector_type(8)));
typedef float f32x4 __attribute__((ext_vector_type(4)));
typedef unsigned u32x4 __attribute__((ext_vector_type(4)));
constexpr int BM = 256, BK = 64, HALF = 128, HTB = HALF * BK * 2, STAGE_BYTES = 8 * HTB, NXCD = 8, WGM = 8;

__host__ __device__ __forceinline__ int lds_byte(int r, int c) { const int st = (r >> 4) * 2 + (c >> 5), rr = r & 15, cc = c & 31, ob = rr * 64 + cc * 2; return st * 1024 + (ob ^ (((ob >> 9) & 1) << 5)); }
__host__ __device__ __forceinline__ void stage_rc(int b, int& R, int& C) { const int st = b / 1024, sb = b % 1024, swz = sb ^ (((sb >> 9) & 1) << 5); R = (st >> 1) * 16 + swz / 64; C = (st & 1) * 32 + (swz % 64) / 2; }
__host__ __device__ __forceinline__ int perm32(int rho) { const int n = rho >> 4, i = rho & 15; return 8 * (i >> 2) + 4 * n + (i & 3); }

struct Unit { int pm, pn; int kt0 = 0, knt = 0, ks = 0; };

struct StaticOrder {
    int nM, nN, nwg, G, c; const char* Bt; size_t tstepB;
    __device__ void init(int M, int N, int G_, int c_, const bf16_t* Bt_, int ldb) { nM = M / BM; nN = N / BM; nwg = nM * nN; G = G_; c = c_; Bt = (const char*)Bt_; tstepB = (size_t)BM * ldb * 2; }
    __device__ bool next(int i, Unit& u) const {
        const long L = (long)i * G + c; if (L >= nwg) return false;
        int wgid = (int)L; { const int q = nwg / NXCD, r = nwg % NXCD, xcd = wgid % NXCD, off = wgid / NXCD; wgid = (xcd < r ? xcd * (q + 1) : r * (q + 1) + (xcd - r) * q) + off; }
        const int nig = WGM * nN, gid = wgid / nig, fm = gid * WGM, gsz = (nM - fm) < WGM ? (nM - fm) : WGM;
        u.pm = fm + ((wgid % nig) % gsz); u.pn = (wgid % nig) / gsz; return true;
    }
    __device__ __forceinline__ const char* b_base(const Unit& u) const { return Bt + (size_t)u.pn * tstepB; }
    __device__ __forceinline__ const int* a_rows(const Unit&) const { return nullptr; }
};

__device__ __forceinline__ unsigned cvt_pk_bf16(float lo, float hi) { unsigned r; asm volatile("v_cvt_pk_bf16_f32 %0, %1, %2" : "=v"(r) : "v"(lo), "v"(hi)); return r; }
__device__ __forceinline__ float silu_f(float x) { return x * __builtin_amdgcn_rcpf(1.0f + __expf(-x)); }

struct EpiStore {
    static constexpr bool PERM = true, AFTER_DRAIN = false;
    bf16_t* O; int ldc;
    __device__ __forceinline__ void operator()(const f32x4 (&acc)[2][2][4][2], const Unit& u, int wr, int wc, int fr, int fq) const {
        const int row0 = u.pm * BM + wr * 64 + fr, col0 = u.pn * BM + wc * 32 + 8 * fq;
#pragma unroll
        for (int ai = 0; ai < 2; ++ai)
#pragma unroll
            for (int m = 0; m < 4; ++m) { bf16_t* rowp = O + (size_t)(row0 + ai * HALF + m * 16) * ldc + col0;
#pragma unroll
                for (int bj = 0; bj < 2; ++bj) { const f32x4 v0 = acc[ai][bj][m][0], v1 = acc[ai][bj][m][1];
                    u32x4 w; w.x = cvt_pk_bf16(v0[0], v0[1]); w.y = cvt_pk_bf16(v0[2], v0[3]); w.z = cvt_pk_bf16(v1[0], v1[1]); w.w = cvt_pk_bf16(v1[2], v1[3]);
                    *(u32x4*)(rowp + bj * HALF) = w; } }
    }
};
struct EpiStoreRot {
    static constexpr bool PERM = true, AFTER_DRAIN = false;
    bf16_t* O; int ldc; const float* cs;
    __device__ __forceinline__ void operator()(const f32x4 (&acc)[2][2][4][2], const Unit& u, int wr, int wc, int fr, int fq) const {
        const int row0 = u.pm * BM + wr * 64 + fr, col0 = u.pn * BM + wc * 32 + 8 * fq;
        const bool rot = u.pn < 8; const float sc = u.pn >= 4 ? 0.0625f : 1.0f;
#pragma unroll
        for (int ai = 0; ai < 2; ++ai)
#pragma unroll
            for (int m = 0; m < 4; ++m) { const int row = row0 + ai * HALF + m * 16; bf16_t* rowp = O + (size_t)row * ldc + col0;
#pragma unroll
                for (int bj = 0; bj < 2; ++bj) { f32x4 v0 = acc[ai][bj][m][0], v1 = acc[ai][bj][m][1];
                    if (rot) { const int i0 = ((col0 + bj * HALF) & 255) >> 1; const float* cp = cs + ((size_t)row * 128 + i0) * 2;
                        const f32x4 c01 = *(const f32x4*)cp, c23 = *(const f32x4*)(cp + 4);
                        const f32x4 r0 = (f32x4){v0[0] * c01[0] - v0[1] * c01[1], v0[1] * c01[0] + v0[0] * c01[1], v0[2] * c01[2] - v0[3] * c01[3], v0[3] * c01[2] + v0[2] * c01[3]};
                        const f32x4 r1 = (f32x4){v1[0] * c23[0] - v1[1] * c23[1], v1[1] * c23[0] + v1[0] * c23[1], v1[2] * c23[2] - v1[3] * c23[3], v1[3] * c23[2] + v1[2] * c23[3]};
                        v0 = r0 * sc; v1 = r1 * sc; }
                    u32x4 w; w.x = cvt_pk_bf16(v0[0], v0[1]); w.y = cvt_pk_bf16(v0[2], v0[3]); w.z = cvt_pk_bf16(v1[0], v1[1]); w.w = cvt_pk_bf16(v1[2], v1[3]);
                    *(u32x4*)(rowp + bj * HALF) = w; } }
    }
};
struct EpiRoute0 {
    static constexpr bool PERM = true, AFTER_DRAIN = false;
    bf16_t* base; size_t o_xbc, o_rkvh, o_smb;
    __device__ __forceinline__ void operator()(const f32x4 (&acc)[2][2][4][2], const Unit& u, int wr, int wc, int fr, int fq) const {
        const int row0 = u.pm * BM + wr * 64 + fr, col0 = u.pn * BM + wc * 32 + 8 * fq, pn = u.pn;
#pragma unroll
        for (int ai = 0; ai < 2; ++ai)
#pragma unroll
            for (int m = 0; m < 4; ++m) { const int row = row0 + ai * HALF + m * 16, b = row >> 11, t = row & 2047;
#pragma unroll
                for (int bj = 0; bj < 2; ++bj) { const int col = col0 + bj * HALF; bf16_t* dst; bool ok = true;
                    if (pn < 4) dst = base + ((size_t)(b * 16 + (col >> 6)) * 2048 + t) * 64 + (col & 63);
                    else if (pn < 10) dst = base + o_xbc + (size_t)row * 1536 + (col - 1024);
                    else if (pn < 22) { const int cc = col - 2560; dst = base + o_rkvh + ((size_t)(b * 16 + ((cc & 1023) >> 6)) * 2048 + t) * 192 + (cc >> 10) * 64 + (cc & 63); }
                    else { const int cc = col - 5632; ok = cc < 320; dst = base + o_smb + (size_t)row * 320 + cc; }
                    const f32x4 v0 = acc[ai][bj][m][0], v1 = acc[ai][bj][m][1];
                    u32x4 w; w.x = cvt_pk_bf16(v0[0], v0[1]); w.y = cvt_pk_bf16(v0[2], v0[3]); w.z = cvt_pk_bf16(v1[0], v1[1]); w.w = cvt_pk_bf16(v1[2], v1[3]);
                    if (ok) *(u32x4*)dst = w; } }
    }
};
struct EpiRoute1 {
    static constexpr bool PERM = true, AFTER_DRAIN = false;
    bf16_t* base; size_t o_vh, o_gb; const int* pos;
    __device__ __forceinline__ void operator()(const f32x4 (&acc)[2][2][4][2], const Unit& u, int wr, int wc, int fr, int fq) const {
        const int row0 = u.pm * BM + wr * 64 + fr, col0 = u.pn * BM + wc * 32 + 8 * fq, pn = u.pn;
        const bool rot = pn < 8; const float sc = pn >= 4 ? 0.0625f : 1.0f;
        float frq[2][4];
#pragma unroll
        for (int bj = 0; bj < 2; ++bj)
#pragma unroll
            for (int q = 0; q < 4; ++q) frq[bj][q] = __builtin_amdgcn_exp2f((float)((((col0 + bj * HALF) & 255) >> 1) + q) * (-13.287712379549449f / 127.0f)) * 0.15915494309189535f;
#pragma unroll
        for (int ai = 0; ai < 2; ++ai)
#pragma unroll
            for (int m = 0; m < 4; ++m) { const int row = row0 + ai * HALF + m * 16, b = row >> 11, t = row & 2047; const float ps = rot ? (float)pos[row] : 0.f;
#pragma unroll
                for (int bj = 0; bj < 2; ++bj) { const int col = col0 + bj * HALF; f32x4 v0 = acc[ai][bj][m][0], v1 = acc[ai][bj][m][1]; bf16_t* dst;
                    if (rot) { const int cc = col & 1023;
                        float cs_[8];
#pragma unroll
                        for (int q = 0; q < 4; ++q) { const float rev = __builtin_amdgcn_fractf(ps * frq[bj][q]); cs_[2 * q] = __builtin_amdgcn_cosf(rev); cs_[2 * q + 1] = __builtin_amdgcn_sinf(rev); }
                        const f32x4 c01 = (f32x4){cs_[0], cs_[1], cs_[2], cs_[3]}, c23 = (f32x4){cs_[4], cs_[5], cs_[6], cs_[7]};
                        const f32x4 r0 = (f32x4){v0[0] * c01[0] - v0[1] * c01[1], v0[1] * c01[0] + v0[0] * c01[1], v0[2] * c01[2] - v0[3] * c01[3], v0[3] * c01[2] + v0[2] * c01[3]};
                        const f32x4 r1 = (f32x4){v1[0] * c23[0] - v1[1] * c23[1], v1[1] * c23[0] + v1[0] * c23[1], v1[2] * c23[2] - v1[3] * c23[3], v1[3] * c23[2] + v1[2] * c23[3]};
                        v0 = r0 * sc; v1 = r1 * sc;
                        dst = base + ((size_t)(b * 4 + (cc >> 8)) * 2048 + t) * 512 + (pn >> 2) * 256 + (cc & 255); }
                    else if (pn < 16) { const int cc = col - 2048; dst = base + o_vh + ((size_t)((b * 4 + (cc >> 9)) * 4 + ((cc & 511) >> 7)) * 2048 + t) * 128 + (cc & 127); }
                    else dst = base + o_gb + (size_t)row * 2048 + (col - 4096);
                    u32x4 w; w.x = cvt_pk_bf16(v0[0], v0[1]); w.y = cvt_pk_bf16(v0[2], v0[3]); w.z = cvt_pk_bf16(v1[0], v1[1]); w.w = cvt_pk_bf16(v1[2], v1[3]);
                    *(u32x4*)dst = w; } }
    }
};
struct EpiSwiGLU {
    static constexpr bool PERM = true, AFTER_DRAIN = false;
    bf16_t* H; int ldc;
    __device__ __forceinline__ void operator()(const f32x4 (&acc)[2][2][4][2], const Unit& u, int wr, int wc, int fr, int fq) const {
        const int row0 = u.pm * BM + wr * 64 + fr, col0 = u.pn * HALF + wc * 32 + 8 * fq;
#pragma unroll
        for (int ai = 0; ai < 2; ++ai)
#pragma unroll
            for (int m = 0; m < 4; ++m) { bf16_t* rowp = H + (size_t)(row0 + ai * HALF + m * 16) * ldc + col0;
                float o[8];
#pragma unroll
                for (int n = 0; n < 2; ++n)
#pragma unroll
                    for (int j = 0; j < 4; ++j) o[n * 4 + j] = silu_f(acc[ai][0][m][n][j]) * acc[ai][1][m][n][j];
                u32x4 w; w.x = cvt_pk_bf16(o[0], o[1]); w.y = cvt_pk_bf16(o[2], o[3]); w.z = cvt_pk_bf16(o[4], o[5]); w.w = cvt_pk_bf16(o[6], o[7]);
                __builtin_nontemporal_store(w, (u32x4*)rowp); }
    }
};
struct EpiSlab {
    static constexpr bool PERM = true, AFTER_DRAIN = false;
    float* slab; int ldc, nslice;
    __device__ __forceinline__ void operator()(const f32x4 (&acc)[2][2][4][2], const Unit& u, int wr, int wc, int fr, int fq) const {
        float* base = slab + (size_t)(u.pm * nslice + u.ks) * BM * ldc + (size_t)(wr * 64 + fr) * ldc + u.pn * BM + wc * 32 + 8 * fq;
#pragma unroll
        for (int ai = 0; ai < 2; ++ai)
#pragma unroll
            for (int m = 0; m < 4; ++m) { float* rowp = base + (size_t)(ai * HALF + m * 16) * ldc;
#pragma unroll
                for (int bj = 0; bj < 2; ++bj) { *(f32x4*)(rowp + bj * HALF) = acc[ai][bj][m][0]; *(f32x4*)(rowp + bj * HALF + 4) = acc[ai][bj][m][1]; } }
    }
};
struct EpiMoeOut {
    static constexpr bool PERM = true, AFTER_DRAIN = false;
    bf16_t* Y0; bf16_t* Y1; int ldc; int nhalf; const int* rowdst; const float* rowp;
    __device__ __forceinline__ void operator()(const f32x4 (&acc)[2][2][4][2], const Unit& u, int wr, int wc, int fr, int fq) const {
        const int row0 = u.pm * BM + wr * 64 + fr, col0 = u.pn * BM + wc * 32 + 8 * fq;
#pragma unroll
        for (int ai = 0; ai < 2; ++ai)
#pragma unroll
            for (int m = 0; m < 4; ++m) { const int slot = row0 + ai * HALF + m * 16; const int dst = rowdst[slot]; const float p = rowp[slot];
                if (dst >= 0) { bf16_t* rowpt = (dst >= nhalf ? Y1 + (size_t)(dst - nhalf) * ldc : Y0 + (size_t)dst * ldc) + col0;
#pragma unroll
                    for (int bj = 0; bj < 2; ++bj) { const f32x4 v0 = acc[ai][bj][m][0] * p, v1 = acc[ai][bj][m][1] * p;
                        u32x4 w; w.x = cvt_pk_bf16(v0[0], v0[1]); w.y = cvt_pk_bf16(v0[2], v0[3]); w.z = cvt_pk_bf16(v1[0], v1[1]); w.w = cvt_pk_bf16(v1[2], v1[3]);
                        *(u32x4*)(rowpt + bj * HALF) = w; } }
                asm volatile("" ::: "memory"); }
    }
};

template <class Epi, class Sched, bool ALIGN_EPI, bool GATHER>
__device__ __forceinline__ void gemm_phase(PG8_LAS unsigned char* lds, const bf16_t* Abase, int lda, int ldb, int K, const Sched& S, const Epi& E) {
    const int tid = threadIdx.x, wid = __builtin_amdgcn_readfirstlane(tid >> 6), lane = tid & 63, wr = wid >> 2, wc = wid & 3, fr = lane & 15, fq = lane >> 4;
    const int nt = K / BK;
    int RA[2], CA[2]; unsigned voffB[2];
#pragma unroll
    for (int i = 0; i < 2; ++i) { int R, C; stage_rc(tid * 16 + i * 8192, R, C); const int Rb = Epi::PERM ? ((R & ~31) + perm32(R & 31)) : R;
        RA[i] = R; CA[i] = C; voffB[i] = (unsigned)(Rb * ldb + C) * 2u; }
    const size_t kstep = (size_t)(BK * 2);
    const size_t hstepB = (size_t)HALF * ldb * 2;
    const size_t tstepA = (size_t)BM * lda * 2;
    const unsigned ldsw = (unsigned)wid * 1024u;
    const int aoff = lds_byte(wr * 64 + fr, fq * 8), boff = lds_byte(wc * 32 + fr, fq * 8);
#define PG8_SA(b, h) (((b) * 2 + (h)) * HTB)
#define PG8_SB(b, h) ((4 + (b) * 2 + (h)) * HTB)
#define PG8_STAGE(bufoff, gbase, voff) do { _Pragma("unroll") for (int _i = 0; _i < 2; ++_i) \
        __builtin_amdgcn_global_load_lds((const unsigned*)((const char*)(gbase) + (voff)[_i]), (PG8_LAS unsigned*)(lds + (bufoff) + ldsw + _i * 8192), 16, 0, 0); } while (0)
#define PG8_LDA(dst, b, h) do { _Pragma("unroll") for (int m = 0; m < 4; ++m) _Pragma("unroll") for (int k = 0; k < 2; ++k) dst[m][k] = *(const PG8_LAS bf16x8*)(lds + PG8_SA(b, h) + aoff + m * 2048 + k * 1024); } while (0)
#define PG8_LDB(dst, b, h) do { _Pragma("unroll") for (int n = 0; n < 2; ++n) _Pragma("unroll") for (int k = 0; k < 2; ++k) dst[n][k] = *(const PG8_LAS bf16x8*)(lds + PG8_SB(b, h) + boff + n * 2048 + k * 1024); } while (0)
#define PG8_MMA(ai, bj, At, Bt) do { __builtin_amdgcn_s_setprio(1); _Pragma("unroll") for (int m = 0; m < 4; ++m) _Pragma("unroll") for (int n = 0; n < 2; ++n) _Pragma("unroll") for (int k = 0; k < 2; ++k) \
        acc[ai][bj][m][n] = __builtin_amdgcn_mfma_f32_16x16x32_bf16(Bt[n][k], At[m][k], acc[ai][bj][m][n], 0, 0, 0); __builtin_amdgcn_s_setprio(0); } while (0)
#define PG8_WAIT_V(n) asm volatile("s_waitcnt vmcnt(" #n ")" ::: "memory")
#define PG8_WAIT_L(n) asm volatile("s_waitcnt lgkmcnt(" #n ")" ::: "memory")
#define PG8_BAR __builtin_amdgcn_s_barrier()
#define PG8_SCHED __builtin_amdgcn_sched_barrier(0)
    Unit cur, nxt; int ui = 0;
    if (!S.next(0, cur)) return;
    f32x4 acc[2][2][4][2];
#pragma unroll
    for (int a = 0; a < 2; ++a)
#pragma unroll
        for (int b = 0; b < 2; ++b)
#pragma unroll
            for (int m = 0; m < 4; ++m)
#pragma unroll
                for (int n = 0; n < 2; ++n) acc[a][b][m][n] = (f32x4){0.f, 0.f, 0.f, 0.f};
    bf16x8 At[4][2], B0[2][2], B1[2][2];
    unsigned vA[2][2];
    int knt = cur.knt ? cur.knt : nt;
    const char* cA; const char* cB = S.b_base(cur) + (size_t)cur.kt0 * kstep;
    PG8_LAS int* const rowslot = (PG8_LAS int*)(lds + STAGE_BYTES + 4096);
#define PG8_ROWS_DMA(slot, rows) do { if (wid < 4) __builtin_amdgcn_global_load_lds((const unsigned*)((rows) + tid), (PG8_LAS unsigned*)(rowslot + (slot) * 256 + wid * 64), 4, 0, 0); } while (0)
#define PG8_GOFF(dst, slot) do { _Pragma("unroll") for (int _h = 0; _h < 2; ++_h) _Pragma("unroll") for (int _i = 0; _i < 2; ++_i) dst[_h][_i] = (unsigned)(rowslot[(slot) * 256 + _h * HALF + RA[_i]] * lda + CA[_i]) * 2u; } while (0)
    if constexpr (GATHER) { cA = (const char*)Abase + (size_t)cur.kt0 * kstep; PG8_ROWS_DMA(0, S.a_rows(cur)); PG8_WAIT_V(0); PG8_BAR; PG8_GOFF(vA, 0); }
    else { cA = (const char*)Abase + (size_t)cur.pm * tstepA + (size_t)cur.kt0 * kstep;
#pragma unroll
        for (int h = 0; h < 2; ++h)
#pragma unroll
            for (int i = 0; i < 2; ++i) vA[h][i] = (unsigned)((h * HALF + RA[i]) * lda + CA[i]) * 2u;
    }
    PG8_STAGE(PG8_SB(0, 0), cB, voffB); PG8_STAGE(PG8_SB(0, 1), cB + hstepB, voffB); PG8_STAGE(PG8_SA(0, 0), cA, vA[0]); PG8_STAGE(PG8_SA(0, 1), cA, vA[1]);
    if (wr == 1) PG8_BAR;
    PG8_WAIT_V(2); PG8_BAR;
    PG8_STAGE(PG8_SB(1, 0), cB + kstep, voffB); PG8_STAGE(PG8_SA(1, 0), cA + kstep, vA[0]); PG8_STAGE(PG8_SB(1, 1), cB + hstepB + kstep, voffB);
    PG8_WAIT_V(6); PG8_BAR;
    for (;;) {
        const bool has_next = S.next(ui + 1, nxt);
        const char* nA; const char* nB = has_next ? S.b_base(nxt) + (size_t)nxt.kt0 * kstep : cB;
        if constexpr (GATHER) { nA = has_next ? (const char*)Abase + (size_t)nxt.kt0 * kstep : cA; if (has_next) PG8_ROWS_DMA((ui + 1) & 1, S.a_rows(nxt)); }
        else nA = has_next ? (const char*)Abase + (size_t)nxt.pm * tstepA + (size_t)nxt.kt0 * kstep : cA;
        for (int t = 0; t < knt; t += 2) {
            const bool last = (t == knt - 2);
            const char* a1 = cA + (size_t)(t + 1) * kstep;
            const char* a2 = last ? nA : cA + (size_t)(t + 2) * kstep; const char* b2 = last ? nB : cB + (size_t)(t + 2) * kstep;
            const char* a3 = a2 + kstep; const char* b3 = b2 + kstep;
            unsigned v2[2][2];
            if constexpr (GATHER) { if (last && has_next) PG8_GOFF(v2, (ui + 1) & 1); else PG8_GOFF(v2, ui & 1); PG8_GOFF(vA, ui & 1); }
            else {
#pragma unroll
                for (int h = 0; h < 2; ++h)
#pragma unroll
                    for (int i = 0; i < 2; ++i) v2[h][i] = vA[h][i];
            }
            PG8_LDB(B0, 0, 0); PG8_LDB(B1, 0, 1); PG8_SCHED; PG8_LDA(At, 0, 0); PG8_STAGE(PG8_SA(1, 1), a1, vA[1]);
            PG8_WAIT_V(8); PG8_WAIT_L(0); PG8_BAR; PG8_MMA(0, 0, At, B0); PG8_MMA(0, 1, At, B1); PG8_BAR; PG8_SCHED;
            PG8_LDA(At, 0, 1); PG8_STAGE(PG8_SB(0, 0), b2, voffB); PG8_STAGE(PG8_SB(0, 1), b2 + hstepB, voffB); PG8_STAGE(PG8_SA(0, 0), a2, v2[0]);
            PG8_WAIT_V(8); PG8_WAIT_L(0); PG8_BAR; PG8_MMA(1, 0, At, B0); PG8_MMA(1, 1, At, B1); PG8_BAR; PG8_SCHED;
            PG8_LDB(B0, 1, 0); PG8_LDB(B1, 1, 1); PG8_SCHED; PG8_LDA(At, 1, 0); PG8_STAGE(PG8_SA(0, 1), a2, v2[1]);
            PG8_WAIT_V(8); PG8_WAIT_L(0); PG8_BAR; PG8_MMA(0, 0, At, B0); PG8_MMA(0, 1, At, B1); PG8_BAR; PG8_SCHED;
            PG8_LDA(At, 1, 1); PG8_STAGE(PG8_SB(1, 0), b3, voffB); PG8_STAGE(PG8_SB(1, 1), b3 + hstepB, voffB); PG8_STAGE(PG8_SA(1, 0), a3, v2[0]);
            PG8_WAIT_V(8); PG8_WAIT_L(0); PG8_BAR; PG8_MMA(1, 0, At, B0); PG8_MMA(1, 1, At, B1); PG8_BAR; PG8_SCHED;
        }
        if constexpr (ALIGN_EPI) { if (wr == 0) PG8_BAR; }
        E(acc, cur, wr, wc, fr, fq);
        if (!has_next) break;
#pragma unroll
        for (int a = 0; a < 2; ++a)
#pragma unroll
            for (int b = 0; b < 2; ++b)
#pragma unroll
                for (int m = 0; m < 4; ++m)
#pragma unroll
                    for (int n = 0; n < 2; ++n) acc[a][b][m][n] = (f32x4){0.f, 0.f, 0.f, 0.f};
        cur = nxt; cA = nA; cB = nB; ++ui; knt = cur.knt ? cur.knt : nt;
        if constexpr (ALIGN_EPI) { if (wr == 1) PG8_BAR; }
    }
    PG8_WAIT_V(0);
    if constexpr (!ALIGN_EPI) { if (wr == 0) PG8_BAR; }
    PG8_BAR;
#undef PG8_SA
#undef PG8_SB
#undef PG8_STAGE
#undef PG8_LDA
#undef PG8_LDB
#undef PG8_MMA
#undef PG8_WAIT_V
#undef PG8_WAIT_L
#undef PG8_BAR
#undef PG8_SCHED
#undef PG8_ROWS_DMA
#undef PG8_GOFF
}
}

constexpr int NWAVES = 8, NTHR = 512;
constexpr int BATCH = 16, SEQ = 2048, DM = 1024, MTOK = BATCH * SEQ;
constexpr int PW = 6144;
constexpr int DFF = 3584, NEXP = 8;
constexpr int MOE_P1 = 128, MOE_ROWS = (MTOK * 2 / 256 - MOE_P1 + NEXP) * 256, MOE_SLOTS = MTOK * 2 + NEXP * 256;
constexpr float ALPHA = 1.4142135623730951f;
constexpr float LN_EPS = 1e-5f;
constexpr int PC_Z = 0, PC_XBC = 1024, PC_RKV = 2560, PC_SM = 5632, PC_DT = 5920;
constexpr size_t L0_ZH = 0, L0_XBC = (size_t)MTOK * 1024, L0_RKVH = (size_t)MTOK * 2560, L0_SMB = (size_t)MTOK * 5632;
constexpr size_t L1_QKH = 0, L1_VH = (size_t)MTOK * 2048, L1_GB = (size_t)MTOK * 4096;

constexpr size_t MiB = 1u << 20;
constexpr size_t WS_CTL = 0, CTL_ZERO_BYTES = 1 * MiB;
constexpr size_t WS_W0IN = 1 * MiB, WS_W0OUT = 13 * MiB, WS_W0GU = 17 * MiB, WS_W0D = 31 * MiB, WS_W1IN = 38 * MiB, WS_W1OUT = 50 * MiB;
constexpr size_t WS_XB = 54 * MiB;
constexpr size_t WS_P = 118 * MiB;
constexpr size_t WS_X1 = 118 * MiB;
constexpr size_t WS_HID = 246 * MiB;
constexpr size_t WS_H = 502 * MiB;
constexpr size_t WS_MOED = 118 * MiB;
constexpr size_t WS_Y0 = 174 * MiB, WS_Y1 = 238 * MiB, WS_MHID = 302 * MiB;
constexpr size_t WS_CS = 1 * MiB;
constexpr size_t WS_SLAB = 1 * MiB;
constexpr int MOE_TAIL0 = 256, MOE_KS = 4;
constexpr size_t WS_TAB = 34 * MiB;
constexpr size_t TAB_E = 0, TAB_P = 128 * 1024, TAB_POS = 256 * 1024, TAB_ROWTOK = 512 * 1024, TAB_ROWDST = 1024 * 1024, TAB_ROWP = 1536 * 1024;
constexpr size_t WS_END = 566 * MiB;
constexpr int CW_TMO = 0, CW_BAR = 4096, CW_CNT = 8192;

constexpr int RING_BYTES = 131072, MISC_OFF = RING_BYTES + 320, LCNT_OFF = RING_BYTES + 512, PEXP_OFF = RING_BYTES + 1024, LDS_BYTES = 147456;

#define GAS __attribute__((address_space(1)))
#define LAS __attribute__((address_space(3)))
typedef unsigned short bf16;
typedef unsigned v4u __attribute__((ext_vector_type(4)));
typedef unsigned v2u __attribute__((ext_vector_type(2)));
typedef float f32x4 __attribute__((ext_vector_type(4)));
typedef GAS unsigned gu32;
#define RLX_AGENT __ATOMIC_RELAXED, __HIP_MEMORY_SCOPE_AGENT
#define LDS_WAIT() asm volatile("s_waitcnt lgkmcnt(0)" ::: "memory")
__device__ __forceinline__ unsigned f2bf(float f) { unsigned u = __builtin_bit_cast(unsigned, f); return (u + 0x7fffu + ((u >> 16) & 1u)) >> 16; }
__device__ __forceinline__ unsigned pk2(float lo, float hi) { return f2bf(lo) | (f2bf(hi) << 16); }
__device__ __forceinline__ float bf2f(bf16 v) { return __builtin_bit_cast(float, (unsigned)v << 16); }
__device__ __forceinline__ float bflo(unsigned w) { return __builtin_bit_cast(float, w << 16); }
__device__ __forceinline__ float bfhi(unsigned w) { return __builtin_bit_cast(float, w & 0xffff0000u); }
__device__ __forceinline__ float sigmoid_f(float x) { return 1.0f / (1.0f + __expf(-x)); }
__device__ __forceinline__ float silu_f(float x) { return x / (1.0f + __expf(-x)); }
__device__ __forceinline__ float softplus_f(float x) { return x > 20.f ? x : log1pf(__expf(x)); }
__device__ __forceinline__ float wave_sum(float v) {
    v += __builtin_bit_cast(float, __builtin_amdgcn_update_dpp(0, __builtin_bit_cast(int, v), 0x128, 0xf, 0xf, true));
    v += __builtin_bit_cast(float, __builtin_amdgcn_update_dpp(0, __builtin_bit_cast(int, v), 0x124, 0xf, 0xf, true));
    v += __builtin_bit_cast(float, __builtin_amdgcn_update_dpp(0, __builtin_bit_cast(int, v), 0x122, 0xf, 0xf, true));
    v += __builtin_bit_cast(float, __builtin_amdgcn_update_dpp(0, __builtin_bit_cast(int, v), 0x121, 0xf, 0xf, true));
    const float r0 = __builtin_bit_cast(float, __builtin_amdgcn_readlane(__builtin_bit_cast(int, v), 0)), r1 = __builtin_bit_cast(float, __builtin_amdgcn_readlane(__builtin_bit_cast(int, v), 16));
    const float r2 = __builtin_bit_cast(float, __builtin_amdgcn_readlane(__builtin_bit_cast(int, v), 32)), r3 = __builtin_bit_cast(float, __builtin_amdgcn_readlane(__builtin_bit_cast(int, v), 48));
    return (r0 + r1) + (r2 + r3);
}

#define LDS_BARRIER() asm volatile("s_waitcnt lgkmcnt(0)\n\ts_barrier" ::: "memory")
#define XB_TMO      128
#define XB_XCNT(j)  (256  + 64 * (j))
#define XB_XSUB(j)  (1280 + 64 * (j))
#define XB_XGEN(j)  (2304 + 64 * (j))
#define XB_TOP      3328
#define XB_TOPGEN   3392
#define XCD_BAR_WORDS 3456
#define XB_SPIN_CAP (1u << 18)
__device__ __forceinline__ unsigned xb_ld(unsigned* p)              { return __hip_atomic_load(p, __ATOMIC_RELAXED, __HIP_MEMORY_SCOPE_AGENT); }
__device__ __forceinline__ unsigned xb_add(unsigned* p, unsigned v) { return __hip_atomic_fetch_add(p, v, __ATOMIC_RELAXED, __HIP_MEMORY_SCOPE_AGENT); }
__device__ __forceinline__ unsigned xb_xcc_id() { return (unsigned)__builtin_amdgcn_s_getreg((3 << 11) | 20) & 0xFu; }
#define XB_SPIN(cond, bar) do { unsigned _sp = 0; while (cond) { __builtin_amdgcn_s_sleep(1); \
    if ((++_sp & 255u) == 0u) { if (xb_ld(&(bar)[XB_TMO])) break; if (_sp > XB_SPIN_CAP) { atomicAdd(&(bar)[XB_TMO], 1u); break; } } } } while (0)
struct XcdBarrier { unsigned* bar; unsigned x; volatile LAS unsigned* st; };
__device__ __forceinline__ XcdBarrier xcd_barrier_post(unsigned* bar, volatile LAS unsigned* st) {
    XcdBarrier b; b.bar = bar; b.x = xb_xcc_id(); b.st = st;
    if (threadIdx.x == 0) (void)xb_add(&bar[XB_XCNT(b.x)], 1u);
    return b;
}
__device__ __forceinline__ void xcd_barrier_complete(unsigned* bar, unsigned x, unsigned& nloc, unsigned& nx) {
    const unsigned G = gridDim.x * gridDim.y * gridDim.z;
    unsigned sum, cnt, mine, sp = 0u;
    for (;;) {
        sum = 0u; cnt = 0u; mine = 0u;
#pragma unroll
        for (unsigned j = 0; j < 16; ++j) { const unsigned c = xb_ld(&bar[XB_XCNT(j)]); sum += c; cnt += (c > 0u) ? 1u : 0u; mine = (j == x) ? c : mine; }
        if (sum == G) break;
        __builtin_amdgcn_s_sleep(1);
        if ((++sp & 255u) == 0u) { if (xb_ld(&bar[XB_TMO])) break; if (sp > XB_SPIN_CAP) { atomicAdd(&bar[XB_TMO], 1u); break; } }
    }
    nloc = mine > 0u ? mine : 1u; nx = cnt > 0u ? cnt : 1u;
}
__device__ __forceinline__ void xcd_barrier(const XcdBarrier& b) {
    asm volatile("s_waitcnt vmcnt(0)" ::: "memory");
    __syncthreads();
    if (threadIdx.x == 0) {
        unsigned* bar = b.bar;
        __builtin_amdgcn_s_waitcnt(0);
        unsigned nloc = b.st[0], nx = b.st[1];
        if (nloc == 0u) { xcd_barrier_complete(bar, b.x, nloc, nx); b.st[0] = nloc; b.st[1] = nx; }
        const unsigned old = xb_add(&bar[XB_XSUB(b.x)], 1u);
        const unsigned gen = old / nloc;
        if (old + 1u == (gen + 1u) * nloc) {
            __builtin_amdgcn_fence(__ATOMIC_RELEASE, "agent");
            asm volatile("s_waitcnt vmcnt(0)" ::: "memory");
            const unsigned og = xb_add(&bar[XB_TOP], 1u);
            const unsigned tg = og / nx;
            if (og + 1u == (tg + 1u) * nx) xb_add(&bar[XB_TOPGEN], 1u);
            else XB_SPIN(xb_ld(&bar[XB_TOPGEN]) == tg, bar);
            __builtin_amdgcn_fence(__ATOMIC_ACQUIRE, "agent");
            xb_add(&bar[XB_XGEN(b.x)], 1u);
            asm volatile("s_waitcnt vmcnt(0)" ::: "memory");
        } else {
            XB_SPIN(xb_ld(&bar[XB_XGEN(b.x)]) == gen, bar);
            __builtin_amdgcn_fence(__ATOMIC_ACQUIRE, "agent");
            asm volatile("s_waitcnt vmcnt(0)" ::: "memory");
        }
    }
    __syncthreads();
}

struct Args { const void* in[38]; float* out; unsigned char* ws; int ph_lo, ph_hi; };
enum { I_X = 0, I_POS, I_EV_WIN, I_CONVW, I_CONVB, I_DTB, I_ALOG, I_DSKIP, I_MNORM, I_MU, I_W0, I_WUP, I_A0, I_AUP, I_GUP, I_KK, I_KA, I_RK, I_RLNW, I_RLNB, I_EV_WOUT,
       I_EV_LN1G, I_EV_LN1B, I_FFN_WG, I_FFN_WU, I_FFN_WD, I_EV_LN2G, I_EV_LN2B, I_OD_WIN, I_OD_WOUT, I_OD_LN1G, I_OD_LN1B, I_ROUTER, I_MOE_WG, I_MOE_WU, I_MOE_WD, I_OD_LN2G, I_OD_LN2B };

struct Frame {
    LAS unsigned char* lds;
    int tid, lane, wave, G, bid;
};

template <int TYPE>
__device__ __forceinline__ void transpose_job(const float* W, const float* W2, int ldw, int K, bf16* WT, int nrows, LAS float* scr_f, int gw, int NGW, int lane) {
    LAS unsigned char* scr = (LAS unsigned char*)scr_f;
    const int nblk = nrows / 64, nitems = (K / 64) * nblk;
    const int l16 = lane & 15, lq = lane >> 4;
    for (int item = gw; item < nitems; item += NGW) {
        const int kb = item / nblk, nb = item % nblk, k0 = 64 * kb, n0 = 64 * nb;
        const int np = n0 + 4 * l16;
        const float* src = W; int col = np;
        if (TYPE == 1) { if (np < 2560) col = np; else if (np < 5920) col = np + 16; else if (np < 5936) col = 2560 + (np - 5920); else col = -1; }
        if (TYPE == 2) { const int pn = np >> 8, j = np & 255; if (j < 128) col = 128 * pn + j; else { src = W2; col = 128 * pn + j - 128; } }
#pragma unroll
        for (int i = 0; i < 8; ++i) { const int kk = 8 * i + 2 * lq;
            f32x4 va = (f32x4){0.f, 0.f, 0.f, 0.f}, vb = va;
            if (col >= 0) { va = __builtin_nontemporal_load((const f32x4*)(src + (size_t)(k0 + kk) * ldw + col)); vb = __builtin_nontemporal_load((const f32x4*)(src + (size_t)(k0 + kk + 1) * ldw + col)); }
#pragma unroll
            for (int j = 0; j < 4; ++j) *(LAS unsigned*)(scr + (4 * l16 + j) * 136 + kk * 2) = pk2(va[j], vb[j]); }
        LDS_WAIT(); asm volatile("" ::: "memory");
#pragma unroll
        for (int j = 0; j < 8; ++j) { const int ch = lane + 64 * j, n = ch >> 3, kc = ch & 7;
            const v2u lo = *(const LAS v2u*)(scr + n * 136 + kc * 16), hi = *(const LAS v2u*)(scr + n * 136 + kc * 16 + 8);
            *(v4u*)(WT + (size_t)(n0 + n) * K + k0 + 8 * kc) = (v4u){lo.x, lo.y, hi.x, hi.y}; }
        LDS_WAIT(); asm volatile("" ::: "memory");
    }
}

template <bool ROUTER, bool MOE_COMBINE, bool CSTAB = false>
__device__ __forceinline__ void ln_rows(const Frame& F, const float* xi, const bf16* xib, const bf16* hb, const bf16* hb2, const float* gam, const float* bet, float* xo, bf16* xbo,
                                        int row_lo, int row_hi, const float* wr, unsigned* cnt, int* tok_e, float* tok_p, int* tok_pos, const int* positions = nullptr, float* cstab = nullptr, const float* slab = nullptr) {
    const int gw = F.bid * NWAVES + F.wave, NGW = F.G * NWAVES, lane = F.lane;
    float invf0 = 0.f, invf1 = 0.f;
    if (CSTAB) { invf0 = (float)pow(10000.0, -(double)lane / 127.0); invf1 = (float)pow(10000.0, -(double)(lane + 64) / 127.0); }
    f32x4 gv[4], bv[4];
#pragma unroll
    for (int j = 0; j < 4; ++j) { gv[j] = *(const f32x4*)(gam + 4 * lane + 256 * j); bv[j] = *(const f32x4*)(bet + 4 * lane + 256 * j); }
    float mylg[8] = {0.f, 0.f, 0.f, 0.f, 0.f, 0.f, 0.f, 0.f};
    f32x4 rw0[16], rw1[16];
    if (ROUTER) {
#pragma unroll
        for (int j = 0; j < 4; ++j)
#pragma unroll
            for (int q = 0; q < 4; ++q) { const int c = 4 * lane + 256 * j + q; rw0[4 * j + q] = *(const f32x4*)(wr + c * 8); rw1[4 * j + q] = *(const f32x4*)(wr + c * 8 + 4); }
    }
    for (int row = row_lo + gw; row < row_hi; row += NGW) {
        f32x4 v[4]; float s = 0.f;
#pragma unroll
        for (int j = 0; j < 4; ++j) {
            f32x4 x;
            if (xi) x = *(const f32x4*)(xi + (size_t)row * DM + 4 * lane + 256 * j);
            else { const v2u xw = *(const v2u*)(xib + (size_t)row * DM + 4 * lane + 256 * j); x = (f32x4){bflo(xw.x), bfhi(xw.x), bflo(xw.y), bfhi(xw.y)}; }
            const size_t hrow = MOE_COMBINE ? (size_t)(row - row_lo) : (size_t)row;
            const v2u hw = *(const v2u*)(hb + hrow * DM + 4 * lane + 256 * j);
            f32x4 h = (f32x4){bflo(hw.x), bfhi(hw.x), bflo(hw.y), bfhi(hw.y)};
            if (MOE_COMBINE) {
                const int s0_ = tok_pos[2 * row], s1_ = tok_pos[2 * row + 1];
                if (s0_ >= MOE_TAIL0 * 256) { const float* sp = slab + ((size_t)((s0_ >> 8) - MOE_TAIL0) * MOE_KS * 256 + (s0_ & 255)) * DM + 4 * lane + 256 * j; f32x4 a = *(const f32x4*)sp;
#pragma unroll
                    for (int q = 1; q < MOE_KS; ++q) a += *(const f32x4*)(sp + (size_t)q * 256 * DM);
                    h = a * tok_p[row]; }
                f32x4 hh;
                if (s1_ >= MOE_TAIL0 * 256) { const float* sp = slab + ((size_t)((s1_ >> 8) - MOE_TAIL0) * MOE_KS * 256 + (s1_ & 255)) * DM + 4 * lane + 256 * j; f32x4 a = *(const f32x4*)sp;
#pragma unroll
                    for (int q = 1; q < MOE_KS; ++q) a += *(const f32x4*)(sp + (size_t)q * 256 * DM);
                    hh = a * (1.f - tok_p[row]); }
                else { const v2u h2 = *(const v2u*)(hb2 + hrow * DM + 4 * lane + 256 * j); hh = (f32x4){bflo(h2.x), bfhi(h2.x), bflo(h2.y), bfhi(h2.y)}; }
                h += hh; }
            v[j] = x * ALPHA + h; s += (v[j].x + v[j].y) + (v[j].z + v[j].w);
        }
        const float mean = wave_sum(s) * (1.f / DM); float s2 = 0.f;
#pragma unroll
        for (int j = 0; j < 4; ++j) { v[j] = v[j] - mean; s2 += (v[j].x * v[j].x + v[j].y * v[j].y) + (v[j].z * v[j].z + v[j].w * v[j].w); }
        const float rstd = 1.f / sqrtf(wave_sum(s2) * (1.f / DM) + LN_EPS);
#pragma unroll
        for (int j = 0; j < 4; ++j) { v[j] = v[j] * rstd * gv[j] + bv[j];
            if (xo) *(f32x4*)(xo + (size_t)row * DM + 4 * lane + 256 * j) = v[j];
            if (xbo) { v2u w; w.x = pk2(v[j].x, v[j].y); w.y = pk2(v[j].z, v[j].w); *(v2u*)(xbo + (size_t)row * DM + 4 * lane + 256 * j) = w; } }
        if (CSTAB) { const float pos = (float)positions[row]; float sn, cs_; typedef float f32x2v __attribute__((ext_vector_type(2)));
            sincosf(pos * invf0, &sn, &cs_); *(f32x2v*)(cstab + ((size_t)row * 128 + lane) * 2) = (f32x2v){cs_, sn};
            sincosf(pos * invf1, &sn, &cs_); *(f32x2v*)(cstab + ((size_t)row * 128 + lane + 64) * 2) = (f32x2v){cs_, sn}; }
        if (ROUTER) {
            float lg[8];
#pragma unroll
            for (int e = 0; e < 8; ++e) lg[e] = 0.f;
#pragma unroll
            for (int j = 0; j < 4; ++j)
#pragma unroll
                for (int q = 0; q < 4; ++q) { const f32x4 w0 = rw0[4 * j + q], w1 = rw1[4 * j + q]; const float xv = v[j][q];
                    lg[0] += xv * w0.x; lg[1] += xv * w0.y; lg[2] += xv * w0.z; lg[3] += xv * w0.w; lg[4] += xv * w1.x; lg[5] += xv * w1.y; lg[6] += xv * w1.z; lg[7] += xv * w1.w; }
            {
                float a4[4];
#pragma unroll
                for (int e = 0; e < 4; ++e) { const float mine = (lane & 32) ? lg[4 + e] : lg[e], send = (lane & 32) ? lg[e] : lg[4 + e]; a4[e] = mine + __shfl_xor(send, 32); }
                float a2[2];
#pragma unroll
                for (int e = 0; e < 2; ++e) { const float mine = (lane & 16) ? a4[2 + e] : a4[e], send = (lane & 16) ? a4[e] : a4[2 + e]; a2[e] = mine + __shfl_xor(send, 16); }
                float a1; { const float mine = (lane & 8) ? a2[1] : a2[0], send = (lane & 8) ? a2[0] : a2[1]; a1 = mine + __shfl_xor(send, 8); }
                a1 += __shfl_xor(a1, 4); a1 += __shfl_xor(a1, 2); a1 += __shfl_xor(a1, 1);
#pragma unroll
                for (int e = 0; e < 8; ++e) lg[e] = __shfl(a1, ((e >> 2) & 1) * 32 + ((e >> 1) & 1) * 16 + (e & 1) * 8);
            }
            const int it_ = (row - row_lo - gw) / NGW;
#pragma unroll
            for (int e = 0; e < 8; ++e) mylg[e] = (lane == it_) ? lg[e] : mylg[e];
        }
    }
    if (ROUTER) {
        LAS unsigned* lc = (LAS unsigned*)(F.lds + LCNT_OFF);
        const int row = row_lo + gw + lane * NGW; const bool act = row < row_hi;
        int i0 = 0, i1 = -1, pos0 = 0, pos1 = 0;
        if (act) { float v0 = mylg[0];
#pragma unroll
            for (int e = 1; e < 8; ++e) if (mylg[e] > v0) { v0 = mylg[e]; i0 = e; }
            float v1 = -3.0e38f;
#pragma unroll
            for (int e = 0; e < 8; ++e) if (e != i0 && mylg[e] > v1) { v1 = mylg[e]; i1 = e; }
            pos0 = (int)__hip_atomic_fetch_add(lc + i0, 1u, __ATOMIC_RELAXED, __HIP_MEMORY_SCOPE_WORKGROUP); pos1 = (int)__hip_atomic_fetch_add(lc + i1, 1u, __ATOMIC_RELAXED, __HIP_MEMORY_SCOPE_WORKGROUP);
            tok_e[row] = i0 | (i1 << 8); tok_p[row] = 1.f / (1.f + __expf(v1 - v0)); }
        __syncthreads();
        if (F.tid < 8) lc[16 + F.tid] = __hip_atomic_fetch_add(cnt + F.tid, lc[F.tid], RLX_AGENT);
        __syncthreads();
        if (act) { tok_pos[2 * row] = pos0 + (int)lc[16 + i0]; tok_pos[2 * row + 1] = pos1 + (int)lc[16 + i1]; }
    }
}

typedef short bf16x8 __attribute__((ext_vector_type(8)));
typedef short s16x4 __attribute__((ext_vector_type(4)));
typedef __attribute__((address_space(3))) const unsigned char* lds_cptr;
__device__ __forceinline__ s16x4 lds_tr(lds_cptr p) { return __builtin_bit_cast(s16x4, __builtin_amdgcn_ds_read_tr16_b64_v4i16((LAS s16x4*)p)); }
__device__ __forceinline__ bf16x8 cat8(s16x4 lo, s16x4 hi) { return (bf16x8){lo[0], lo[1], lo[2], lo[3], hi[0], hi[1], hi[2], hi[3]}; }
typedef float f32x2_t __attribute__((ext_vector_type(2))); typedef __bf16 bf16x2_t __attribute__((ext_vector_type(2)));
__device__ __forceinline__ unsigned cvtpk(float lo, float hi) { f32x2_t v = {lo, hi}; bf16x2_t b = __builtin_convertvector(v, bf16x2_t); return __builtin_bit_cast(unsigned, b); }
__device__ __forceinline__ bf16x8 pack8(f32x4 a, f32x4 b) { v4u w; w.x = cvtpk(a[0], a[1]); w.y = cvtpk(a[2], a[3]); w.z = cvtpk(b[0], b[1]); w.w = cvtpk(b[2], b[3]); return __builtin_bit_cast(bf16x8, w); }
#define MFMA16(a, b, c) __builtin_amdgcn_mfma_f32_16x16x32_bf16(a, b, c, 0, 0, 0)
__device__ __forceinline__ void conv_prepass(const Frame& F, const bf16* P, const float* convw, const float* convb, bf16* XA, bf16* BCA) {
    constexpr int CR = 16;
    const int gt = F.bid * NTHR + F.tid, NGT = F.G * NTHR;
    for (int task = gt; task < (MTOK / CR) * 192; task += NGT) {
        const int cg = task % 192, rb = task / 192, ch = cg * 8, row0 = rb * CR, t0 = row0 & (SEQ - 1);
        float wk[4][8], bias[8], x0[8], x1[8], x2[8];
#pragma unroll
        for (int k = 0; k < 4; ++k) { const f32x4 a = *(const f32x4*)(convw + k * 1536 + ch), b = *(const f32x4*)(convw + k * 1536 + ch + 4);
#pragma unroll
            for (int j = 0; j < 4; ++j) { wk[k][j] = a[j]; wk[k][4 + j] = b[j]; } }
        { const f32x4 a = *(const f32x4*)(convb + ch), b = *(const f32x4*)(convb + ch + 4);
#pragma unroll
            for (int j = 0; j < 4; ++j) { bias[j] = a[j]; bias[4 + j] = b[j]; } }
        const bf16* src = P + L0_XBC + (size_t)row0 * 1536 + ch; const int bb_ = row0 >> 11;
#define CONV_LD(dst, ptr) do { const v4u r_ = *(const v4u*)(ptr); dst[0] = bflo(r_.x); dst[1] = bfhi(r_.x); dst[2] = bflo(r_.y); dst[3] = bfhi(r_.y); dst[4] = bflo(r_.z); dst[5] = bfhi(r_.z); dst[6] = bflo(r_.w); dst[7] = bfhi(r_.w); } while (0)
        if (t0 > 0) { CONV_LD(x0, src - 3 * 1536); CONV_LD(x1, src - 2 * 1536); CONV_LD(x2, src - 1536); }
        else {
#pragma unroll
            for (int j = 0; j < 8; ++j) { x0[j] = 0.f; x1[j] = 0.f; x2[j] = 0.f; } }
        const int cc_ = ch - 1024;
        bf16* dst = ch < 1024 ? XA + ((size_t)(bb_ * 16 + (ch >> 6)) * 2048 + t0) * 64 + (ch & 63) : BCA + ((size_t)(bb_ * 2 + ((cc_ & 255) >> 7)) * 2048 + t0) * 256 + (cc_ >> 8) * 128 + (cc_ & 127);
        const int dpitch = ch < 1024 ? 64 : 256;
#pragma unroll 4
        for (int r = 0; r < CR; ++r) {
            float cur[8], o[8]; CONV_LD(cur, src + (size_t)r * 1536);
#pragma unroll
            for (int j = 0; j < 8; ++j) { o[j] = silu_f(bias[j] + wk[0][j] * x0[j] + wk[1][j] * x1[j] + wk[2][j] * x2[j] + wk[3][j] * cur[j]); x0[j] = x1[j]; x1[j] = x2[j]; x2[j] = cur[j]; }
            v4u ow; ow.x = pk2(o[0], o[1]); ow.y = pk2(o[2], o[3]); ow.z = pk2(o[4], o[5]); ow.w = pk2(o[6], o[7]);
            *(v4u*)(dst + (size_t)r * dpitch) = ow;
        }
#undef CONV_LD
    }
}

__device__ __forceinline__ void small_prepass(const Frame& F, const bf16* SMBp, const float* mu, bf16* SMS) {
    const int gt = F.bid * NTHR + F.tid, NGT = F.G * NTHR;
    for (int idx = gt; idx < MTOK * 36; idx += NGT) {
        const int row = idx / 36, j = idx % 36; const bf16* src = SMBp + (size_t)row * 320 + j * 8;
        const v4u cw = *(const v4u*)src; const v4u pw = (row & (SEQ - 1)) ? *(const v4u*)(src - 320) : (v4u){0u, 0u, 0u, 0u};
        const f32x4 m0 = *(const f32x4*)(mu + 3072 + j * 8), m1 = *(const f32x4*)(mu + 3072 + j * 8 + 4);
        const float c_[8] = {bflo(cw.x), bfhi(cw.x), bflo(cw.y), bfhi(cw.y), bflo(cw.z), bfhi(cw.z), bflo(cw.w), bfhi(cw.w)};
        const float p_[8] = {bflo(pw.x), bfhi(pw.x), bflo(pw.y), bfhi(pw.y), bflo(pw.z), bfhi(pw.z), bflo(pw.w), bfhi(pw.w)};
        float v[8];
#pragma unroll
        for (int q = 0; q < 8; ++q) { const float x = c_[q] + (p_[q] - c_[q]) * (q < 4 ? m0[q & 3] : m1[q & 3]);
            v[q] = j < 8 ? 1.f - 2.f * __builtin_amdgcn_rcpf(1.f + __expf(2.f * x)) : (j < 16 ? x : __builtin_amdgcn_rcpf(1.f + __expf(-x))); }
        v4u o; o.x = pk2(v[0], v[1]); o.y = pk2(v[2], v[3]); o.z = pk2(v[4], v[5]); o.w = pk2(v[6], v[7]);
        *(v4u*)(SMS + (size_t)row * 320 + j * 8) = o;
    }
}

__device__ __forceinline__ float wave_scan_incl(float v, int lane) {
#pragma unroll
    for (int o = 1; o < 64; o <<= 1) { const float t = __shfl_up(v, o); if (lane >= o) v += t; }
    return v;
}
__device__ __forceinline__ void ssd_mfma(const Frame& F, const bf16* P, const bf16* XA, const bf16* BCA, const float* dtb, const float* alog, const float* dskip, bf16* mix) {
    constexpr int XST = 144, BST = 272;
    constexpr int XOFF = 0, XWOFF = 128 * XST, BOFF = 2 * 128 * XST, COFF = BOFF + 128 * BST, SOFF = COFF + 128 * BST, DTOFF = SOFF + 64 * BST, ACSOFF = DTOFF + 512;
    static_assert(ACSOFF + 512 <= RING_BYTES, "SSD LDS map");
    LAS unsigned char* const L = F.lds;
    LAS float* const DT = (LAS float*)(L + DTOFF); LAS float* const ACS = (LAS float*)(L + ACSOFF);
    const int tid = F.tid, lane = F.lane, w = F.wave, g = lane >> 4, lr = lane & 15, q4 = lr >> 2, p4 = lane & 3;
    for (int item = F.bid; item < BATCH * 16; item += F.G) {
        const int b = item >> 4, h = item & 15, grp = h >> 3;
        const float A_h = -__expf(alog[h]), dtbias = dtb[h], dsk = dskip[h];
        const bf16* xg = XA + (size_t)(b * 16 + h) * 2048 * 64;
        const bf16* bg = BCA + (size_t)(b * 2 + grp) * 2048 * 256;
        const bf16* cg = bg + 128;
        const bf16* dg = P + L0_SMB + (size_t)(b * SEQ) * 320 + 288 + h;
        const bf16* zg = P + L0_ZH + (size_t)(b * 16 + h) * 2048 * 64;
        bf16* og = mix + (size_t)(b * SEQ) * 2048 + h * 64;
        f32x4 stT[4];
#pragma unroll
        for (int pt = 0; pt < 4; ++pt) stT[pt] = (f32x4){0.f, 0.f, 0.f, 0.f};
        __syncthreads();
        for (int i = tid; i < 64 * BST / 16; i += NTHR) *(LAS v4u*)(L + SOFF + i * 16) = (v4u){0u, 0u, 0u, 0u};
        v4u xp[2], bp[4], cp[4]; float raw0 = 0.f, raw1 = 0.f;
#define SSD_LOAD(c) do { const size_t r0_ = (size_t)(128 * (c)); \
            _Pragma("unroll") for (int i_ = 0; i_ < 2; ++i_) { const int p_ = tid + NTHR * i_; xp[i_] = *(const v4u*)(xg + (r0_ + (p_ >> 3)) * 64 + (p_ & 7) * 8); } \
            _Pragma("unroll") for (int i_ = 0; i_ < 4; ++i_) { const int p_ = tid + NTHR * i_; bp[i_] = *(const v4u*)(bg + (r0_ + (p_ >> 4)) * 256 + (p_ & 15) * 8); cp[i_] = *(const v4u*)(cg + (r0_ + (p_ >> 4)) * 256 + (p_ & 15) * 8); } \
            if (w < 2) { raw0 = bf2f(dg[(r0_ + lane) * 320]); raw1 = bf2f(dg[(r0_ + 64 + lane) * 320]); } } while (0)
        SSD_LOAD(0);
        for (int c = 0; c < SEQ / 128; ++c) {
#pragma unroll
            for (int i = 0; i < 2; ++i) { const int p = tid + NTHR * i; *(LAS v4u*)(L + XOFF + (p >> 3) * XST + (p & 7) * 16) = xp[i]; }
#pragma unroll
            for (int i = 0; i < 4; ++i) { const int p = tid + NTHR * i; *(LAS v4u*)(L + BOFF + (p >> 4) * BST + (p & 15) * 16) = bp[i]; *(LAS v4u*)(L + COFF + (p >> 4) * BST + (p & 15) * 16) = cp[i]; }
            if (w < 2) {
                const float d0 = softplus_f(raw0 + dtbias), d1 = softplus_f(raw1 + dtbias);
                const float s0 = wave_scan_incl(d0 * A_h, lane); const float tot0 = __shfl(s0, 63); const float s1 = wave_scan_incl(d1 * A_h, lane) + tot0;
                if (w == 0) { DT[lane] = d0; ACS[lane] = s0; } else { DT[64 + lane] = d1; ACS[64 + lane] = s1; }
            }
            __syncthreads();
            const float acs_end = ACS[127];
#pragma unroll
            for (int i = 0; i < 2; ++i) { const int p = tid + NTHR * i, j = p >> 3; const float f = __expf(acs_end - ACS[j]) * DT[j]; const v4u x = xp[i]; v4u o;
                o.x = cvtpk(bflo(x.x) * f, bfhi(x.x) * f); o.y = cvtpk(bflo(x.y) * f, bfhi(x.y) * f); o.z = cvtpk(bflo(x.z) * f, bfhi(x.z) * f); o.w = cvtpk(bflo(x.w) * f, bfhi(x.w) * f);
                *(LAS v4u*)(L + XWOFF + j * XST + (p & 7) * 16) = o; }
            if (c + 1 < SEQ / 128) SSD_LOAD(c + 1);
            bf16x8 cf[4];
#pragma unroll
            for (int ks = 0; ks < 4; ++ks) cf[ks] = *(const LAS bf16x8*)(L + COFF + (16 * w + lr) * BST + (32 * ks + 8 * g) * 2);
            const float acs_i = ACS[16 * w + lr];
            bf16x8 mf[4];
#pragma unroll
            for (int s2 = 0; s2 < 4; ++s2) { f32x4 mm[2];
#pragma unroll
                for (int e = 0; e < 2; ++e) { const int jt = 2 * s2 + e; mm[e] = (f32x4){0.f, 0.f, 0.f, 0.f};
                    if (jt <= w) {
#pragma unroll
                        for (int ks = 0; ks < 4; ++ks) { const bf16x8 a = *(const LAS bf16x8*)(L + BOFF + (16 * jt + lr) * BST + (32 * ks + 8 * g) * 2); mm[e] = MFMA16(a, cf[ks], mm[e]); }
                        const f32x4 aj = *(const LAS f32x4*)(ACS + 16 * jt + 4 * g), dj = *(const LAS f32x4*)(DT + 16 * jt + 4 * g);
#pragma unroll
                        for (int r = 0; r < 4; ++r) { const float v = mm[e][r] * __expf(acs_i - aj[r]) * dj[r]; mm[e][r] = (jt < w || 4 * g + r <= lr) ? v : 0.f; }
                    } }
                mf[s2] = pack8(mm[0], mm[1]); }
            __builtin_amdgcn_sched_barrier(0);
            const float e_i = __expf(acs_i);
#pragma unroll
            for (int pt = 0; pt < 4; ++pt) { f32x4 y = (f32x4){0.f, 0.f, 0.f, 0.f};
#pragma unroll
                for (int ks = 0; ks < 4; ++ks) { const bf16x8 a = *(const LAS bf16x8*)(L + SOFF + (16 * pt + lr) * BST + (32 * ks + 8 * g) * 2); y = MFMA16(a, cf[ks], y); }
                y = y * e_i;
#pragma unroll
                for (int s2 = 0; s2 < 4; ++s2) if (2 * s2 <= w) {
                    const s16x4 lo = lds_tr(L + XOFF + (32 * s2 + 4 * g + q4) * XST + (16 * pt + 4 * p4) * 2), hi = lds_tr(L + XOFF + (32 * s2 + 16 + 4 * g + q4) * XST + (16 * pt + 4 * p4) * 2);
                    y = MFMA16(cat8(lo, hi), mf[s2], y); }
                const int tok = 128 * c + 16 * w + lr, p0 = 16 * pt + 4 * g;
                const v2u xw = *(const LAS v2u*)(L + XOFF + (16 * w + lr) * XST + p0 * 2); const v2u zw = *(const v2u*)(zg + (size_t)tok * 64 + p0);
                const float o0 = (y[0] + dsk * bflo(xw.x)) * silu_f(bflo(zw.x)), o1 = (y[1] + dsk * bfhi(xw.x)) * silu_f(bfhi(zw.x)), o2 = (y[2] + dsk * bflo(xw.y)) * silu_f(bflo(zw.y)), o3 = (y[3] + dsk * bfhi(xw.y)) * silu_f(bfhi(zw.y));
                v2u o; o.x = cvtpk(o0, o1); o.y = cvtpk(o2, o3); *(v2u*)(og + (size_t)tok * 2048 + p0) = o; }
            __syncthreads();
            { const float e_end = __expf(acs_end);
#pragma unroll
              for (int pt = 0; pt < 4; ++pt) stT[pt] = stT[pt] * e_end; }
#pragma unroll
            for (int s2 = 0; s2 < 4; ++s2) {
                const s16x4 lo = lds_tr(L + BOFF + (32 * s2 + 8 * g + q4) * BST + (16 * w + 4 * p4) * 2), hi = lds_tr(L + BOFF + (32 * s2 + 8 * g + 4 + q4) * BST + (16 * w + 4 * p4) * 2); const bf16x8 a = cat8(lo, hi);
#pragma unroll
                for (int pt = 0; pt < 4; ++pt) { const s16x4 xl = lds_tr(L + XWOFF + (32 * s2 + 8 * g + q4) * XST + (16 * pt + 4 * p4) * 2), xh = lds_tr(L + XWOFF + (32 * s2 + 8 * g + 4 + q4) * XST + (16 * pt + 4 * p4) * 2);
                    stT[pt] = MFMA16(a, cat8(xl, xh), stT[pt]); } }
#pragma unroll
            for (int pt = 0; pt < 4; ++pt) { v2u o; o.x = cvtpk(stT[pt][0], stT[pt][1]); o.y = cvtpk(stT[pt][2], stT[pt][3]); *(LAS v2u*)(L + SOFF + (16 * pt + lr) * BST + (16 * w + 4 * g) * 2) = o; }
            __syncthreads();
        }
#undef SSD_LOAD
    }
}

__device__ __forceinline__ void ssd_norm(const Frame& F, bf16* mix, const float* mnorm) {
    const int gw = F.bid * NWAVES + F.wave, NGW = F.G * NWAVES, lane = F.lane;
    for (int it = gw; it < MTOK * 2; it += NGW) {
        const int row = it >> 1, g = it & 1; bf16* p = mix + (size_t)row * 2048 + g * 512 + 8 * lane;
        const v4u w = *(const v4u*)p; float v[8] = {bflo(w.x), bfhi(w.x), bflo(w.y), bfhi(w.y), bflo(w.z), bfhi(w.z), bflo(w.w), bfhi(w.w)};
        float s = 0.f;
#pragma unroll
        for (int j = 0; j < 8; ++j) s += v[j] * v[j];
        const float r = 1.f / sqrtf(wave_sum(s) * (1.f / 512.f) + LN_EPS);
        const f32x4 m0 = *(const f32x4*)(mnorm + g * 512 + 8 * lane), m1 = *(const f32x4*)(mnorm + g * 512 + 8 * lane + 4);
        v4u o; o.x = pk2(v[0] * r * m0.x, v[1] * r * m0.y); o.y = pk2(v[2] * r * m0.z, v[3] * r * m0.w); o.z = pk2(v[4] * r * m1.x, v[5] * r * m1.y); o.w = pk2(v[6] * r * m1.z, v[7] * r * m1.w);
        *(v4u*)p = o;
    }
}

struct RwkvW { const float *mu, *w0, *wup, *a0, *aup, *gup, *kk, *ka, *rk, *rlnw, *rlnb; };
typedef float f32x2 __attribute__((ext_vector_type(2)));
#define MFMA16K(a, b, c) __builtin_amdgcn_mfma_f32_16x16x32_bf16(cat8(a, (s16x4){0, 0, 0, 0}), cat8(b, (s16x4){0, 0, 0, 0}), c, 0, 0, 0)
__device__ __forceinline__ s16x4 pack4(f32x4 a) { v2u w; w.x = cvtpk(a[0], a[1]); w.y = cvtpk(a[2], a[3]); return __builtin_bit_cast(s16x4, w); }
__device__ __forceinline__ float fast_sigmoid(float x) { return __builtin_amdgcn_rcpf(1.f + __expf(-x)); }
__device__ __forceinline__ float fast_tanh(float x) { return 1.f - 2.f * __builtin_amdgcn_rcpf(1.f + __expf(2.f * x)); }
__device__ __forceinline__ bf16x8 pack8f(const float* v) { v4u w; w.x = cvtpk(v[0], v[1]); w.y = cvtpk(v[2], v[3]); w.z = cvtpk(v[4], v[5]); w.w = cvtpk(v[6], v[7]); return __builtin_bit_cast(bf16x8, w); }
__device__ __forceinline__ void rwkv_items(const Frame& F, const bf16* P, const bf16* SMS, const RwkvW W, bf16* mix) {
    constexpr int TC = 32, TST = 144, GST = 336, FST = 272, FSZ = TC * FST;
    constexpr int RS = 0, KS = FSZ, VB = 2 * FSZ, OPS = VB + 2 * TC * TST;
    constexpr int AT = OPS, RT = OPS + 4608, BH = OPS + 9216, KH = OPS + 13824, BBAR = OPS + 18432, KBAR = OPS + 23040;
    constexpr int TWD = OPS, SAD = OPS + 4608, SGD = OPS + 9216;
    constexpr int LW = OPS + 27648, ICL = LW + FSZ, GT = ICL + FSZ, AAF = GT + FSZ, SM = AAF + FSZ, MABF = SM + 4096, PCO = MABF + 2048, BON = PCO + 512, N2 = BON + 1024, YR = N2 + 128, MU = YR + FSZ;
    static_assert(SGD + TC * GST <= LW && MU + 1920 <= RING_BYTES, "RWKV LDS map");
    LAS unsigned char* const L = F.lds;
    const int tid0 = F.tid, wave = F.wave;
#define RW_LANES() int tid = tid0; asm volatile("" : "+v"(tid)); const int lane = tid & 63, g = lane >> 4, lr = lane & 15, q4 = lr >> 2, p4 = lane & 3; (void)g; (void)lr; (void)q4; (void)p4
    for (int item = F.bid; item < BATCH * 16; item += F.G) {
        RW_LANES();
        const int b = item >> 4, h = item & 15, hc = h * 64 + lane;
        const bf16* Pr = P + L0_RKVH + (size_t)(b * 16 + h) * 2048 * 192;
        const bf16* Ps = SMS + (size_t)(b * SEQ) * 320;
        const int ct = wave & 3, c0 = h * 64 + 16 * ct + 4 * g;
        __syncthreads();
        if (tid < 480) { const int pc = tid >> 3, q = tid & 7; *(LAS float*)(L + MU + tid * 4) = W.mu[pc < 24 ? (pc >> 3) * 1024 + h * 64 + (pc & 7) * 8 + q : 3072 + (pc - 24) * 8 + q]; }
        bf16x8 wf[5];
        if (wave < 4) {
#pragma unroll
            for (int ks = 0; ks < 2; ++ks) { float t0_[8], t1_[8];
#pragma unroll
                for (int jj = 0; jj < 8; ++jj) { const size_t o = (size_t)(32 * ks + 8 * g + jj) * 1024 + h * 64 + 16 * ct + lr; t0_[jj] = W.wup[o]; t1_[jj] = W.aup[o]; }
                wf[ks] = pack8f(t0_); wf[2 + ks] = pack8f(t1_); asm volatile("" ::: "memory"); }
            wf[4] = wf[0];
        } else {
#pragma unroll
            for (int ks = 0; ks < 5; ++ks) { float t0_[8];
#pragma unroll
                for (int jj = 0; jj < 8; ++jj) t0_[jj] = W.gup[(size_t)(32 * ks + 8 * g + jj) * 1024 + h * 64 + 16 * ct + lr];
                wf[ks] = pack8f(t0_); asm volatile("" ::: "memory"); }
        }
        const float rlw = W.rlnw[hc], rlb = W.rlnb[hc];
        const f32x4 w0v = *(const f32x4*)(W.w0 + c0), a0v = *(const f32x4*)(W.a0 + c0), kk4 = *(const f32x4*)(W.kk + c0), ka4 = *(const f32x4*)(W.ka + c0), rk4 = *(const f32x4*)(W.rk + c0);
        const f32x4 kkp0 = *(const f32x4*)(W.kk + h * 64 + (tid & 7) * 8), kkp1 = *(const f32x4*)(W.kk + h * 64 + (tid & 7) * 8 + 4);
        f32x4 sT[4];
#pragma unroll
        for (int kt = 0; kt < 4; ++kt) sT[kt] = (f32x4){0.f, 0.f, 0.f, 0.f};
        v4u cur[4], prv[4];
#define RW_SLOTS() const int u8 = tid & 255, tt1 = u8 >> 3, pc1 = u8 & 7, ix2 = 256 + tid, tt2g = ix2 / 20, pc2g = ix2 % 20, tt3 = tid / 20, pc3 = tid % 20; \
        const int mu0 = tid & 15, mu1 = wave < 4 ? 16 + pc1 : 24 + pc1, mu2 = wave < 4 ? 32 + pc1 : 40 + pc2g, mu3 = 40 + pc3, ttb2 = wave < 4 ? tt1 : tt2g; \
        const int off0 = ((tid >> 3) & 1) * 64 + (tid & 7) * 8, off1 = wave < 4 ? 128 + pc1 * 8 : pc1 * 8, off2 = wave < 4 ? 64 + pc1 * 8 : 128 + pc2g * 8, off3 = 128 + pc3 * 8; (void)mu0; (void)mu1; (void)mu2; (void)mu3
#define RW_LD1(i_, tt_, base_, pitch_, off_) do { const int t_ = t0n_ + (tt_); cur[i_] = *(const v4u*)((base_) + (size_t)t_ * (pitch_) + (off_)); prv[i_] = t_ > 0 ? *(const v4u*)((base_) + (size_t)(t_ - 1) * (pitch_) + (off_)) : (v4u){0u, 0u, 0u, 0u}; } while (0)
#define RW_LD0(i_, tt_, off_) do { cur[i_] = *(const v4u*)(Ps + (size_t)(t0n_ + (tt_)) * 320 + (off_)); } while (0)
#define RW_LOAD(t0_) do { RW_LANES(); RW_SLOTS(); const int t0n_ = (t0_); RW_LD1(0, tid >> 4, Pr, 192, off0); if (wave < 4) RW_LD1(1, tt1, Pr, 192, off1); else RW_LD0(1, tt1, off1); if (wave < 6) RW_LD0(2, ttb2, off2); RW_LD0(3, tt3, off3); } while (0)
#define RW_SHIFT(v_, i_, mu_) do { const f32x4 m0_ = *(const LAS f32x4*)(L + MU + (mu_) * 32), m1_ = *(const LAS f32x4*)(L + MU + (mu_) * 32 + 16); const v4u cw_ = cur[i_], pw_ = prv[i_]; \
            const float c_[8] = {bflo(cw_.x), bfhi(cw_.x), bflo(cw_.y), bfhi(cw_.y), bflo(cw_.z), bfhi(cw_.z), bflo(cw_.w), bfhi(cw_.w)}; \
            const float p_[8] = {bflo(pw_.x), bfhi(pw_.x), bflo(pw_.y), bfhi(pw_.y), bflo(pw_.z), bfhi(pw_.z), bflo(pw_.w), bfhi(pw_.w)}; \
            _Pragma("unroll") for (int q_ = 0; q_ < 8; ++q_) v_[q_] = c_[q_] + (p_[q_] - c_[q_]) * (q_ < 4 ? m0_[q_ & 3] : m1_[q_ & 3]); } while (0)
#define RW_PASS_E(te_, par_) do { _Pragma("unroll") for (int rep = 0; rep < TC / NWAVES; ++rep) { const int tt = wave + NWAVES * rep, o = tt * FST + lane * 4; const size_t row = (size_t)(b * SEQ + (te_) + tt); \
                const float y = *(LAS float*)(L + YR + o); const float mu = wave_sum(y) * (1.f / 64.f); const float d = y - mu; const float var = wave_sum(d * d) * (1.f / 64.f); \
                const float yn = d * (1.f / sqrtf(var + 64e-5f)) * rlw + rlb; \
                const LAS float* bp_ = (const LAS float*)(L + BON + (par_) * 512 + tt * 4); const float bonus = ((bp_[0] + bp_[32]) + (bp_[64] + bp_[96])) * bf2f(*(LAS bf16*)(L + VB + (par_) * TC * TST + tt * TST + lane * 2)); \
                mix[row * 2048 + 1024 + hc] = (bf16)f2bf((yn + bonus) * *(LAS float*)(L + GT + o)); } } while (0)
        RW_LOAD(0);
        for (int t0 = 0; t0 < SEQ; t0 += TC) {
            const int par = (t0 >> 5) & 1;
            LDS_BARRIER();
            { RW_LANES(); RW_SLOTS();
            { float v[8]; RW_SHIFT(v, 0, mu0); const int base = ((tid & 8) ? KS : RS) + (tid >> 4) * FST + (tid & 7) * 32;
              *(LAS f32x4*)(L + base) = (f32x4){v[0], v[1], v[2], v[3]}; *(LAS f32x4*)(L + base + 16) = (f32x4){v[4], v[5], v[6], v[7]};
              float n2 = 0.f;
#pragma unroll
              for (int q = 0; q < 8; ++q) { const float x = v[q] * (q < 4 ? kkp0[q & 3] : kkp1[q & 3]); n2 += x * x; }
              n2 += __shfl_xor(n2, 1); n2 += __shfl_xor(n2, 2); n2 += __shfl_xor(n2, 4);
              if ((tid & 15) == 8) *(LAS float*)(L + N2 + (tid >> 4) * 4) = n2; }
            if (wave < 4) { float v[8]; RW_SHIFT(v, 1, mu1); *(LAS bf16x8*)(L + VB + par * TC * TST + tt1 * TST + pc1 * 16) = pack8f(v); }
            else *(LAS v4u*)(L + TWD + tt1 * TST + pc1 * 16) = cur[1];
            if (wave < 4) *(LAS v4u*)(L + SAD + tt1 * TST + pc1 * 16) = cur[2];
            else if (wave < 6) *(LAS v4u*)(L + SGD + tt2g * GST + pc2g * 16) = cur[2];
            *(LAS v4u*)(L + SGD + tt3 * GST + pc3 * 16) = cur[3];
            if (t0 > 0) RW_PASS_E(t0 - TC, par ^ 1);
            }
            LDS_BARRIER();
            if (t0 + TC < SEQ) RW_LOAD(t0 + TC);
            { RW_LANES();
#pragma unroll
            for (int tt2 = 0; tt2 < 2; ++tt2) {
                if (wave < 4) { f32x4 dw = (f32x4){0.f, 0.f, 0.f, 0.f}, da = (f32x4){0.f, 0.f, 0.f, 0.f};
#pragma unroll
                    for (int ks = 0; ks < 2; ++ks) {
                        const bf16x8 bw = *(const LAS bf16x8*)(L + TWD + (16 * tt2 + lr) * TST + (32 * ks + 8 * g) * 2), ba = *(const LAS bf16x8*)(L + SAD + (16 * tt2 + lr) * TST + (32 * ks + 8 * g) * 2);
                        dw = MFMA16(wf[ks], bw, dw); da = MFMA16(wf[2 + ks], ba, da); }
                    const int o = (16 * tt2 + lr) * FST + (16 * ct + 4 * g) * 4;
                    const f32x4 kv = *(const LAS f32x4*)(L + KS + o), rv = *(const LAS f32x4*)(L + RS + o);
                    const float inv = 1.f / fmaxf(sqrtf(*(const LAS float*)(L + N2 + (16 * tt2 + lr) * 4)), 1e-12f);
                    f32x4 lw, kp, av, bv; float bon = 0.f;
#pragma unroll
                    for (int r = 0; r < 4; ++r) { lw[r] = -0.6065306597126334f * fast_sigmoid(w0v[r] + dw[r]); const float icl = fast_sigmoid(a0v[r] + da[r]);
                        const float kkn = kv[r] * kk4[r] * inv; kp[r] = kv[r] * (1.f + (icl - 1.f) * ka4[r]); av[r] = -kkn; bv[r] = kkn * icl; bon += rv[r] * kp[r] * rk4[r]; }
                    *(LAS f32x4*)(L + LW + o) = lw; *(LAS f32x4*)(L + KS + o) = kp; *(LAS f32x4*)(L + AAF + o) = av; *(LAS f32x4*)(L + ICL + o) = bv;
                    bon += __shfl_xor(bon, 16); bon += __shfl_xor(bon, 32);
                    if (g == 0) *(LAS float*)(L + BON + par * 512 + ct * 128 + (16 * tt2 + lr) * 4) = bon;
                } else { f32x4 dg = (f32x4){0.f, 0.f, 0.f, 0.f};
#pragma unroll
                    for (int ks = 0; ks < 5; ++ks) { const bf16x8 bg = *(const LAS bf16x8*)(L + SGD + (16 * tt2 + lr) * GST + (32 * ks + 8 * g) * 2); dg = MFMA16(wf[ks], bg, dg); }
                    *(LAS f32x4*)(L + GT + (16 * tt2 + lr) * FST + (16 * ct + 4 * g) * 4) = dg; } }
            }
            LDS_BARRIER();
            { RW_LANES();
            { const int ch = tid >> 8, q = (tid >> 6) & 3, c = lane; float lp[16]; float run = 0.f;
#pragma unroll
              for (int t = 0; t < 16; ++t) { run += *(LAS float*)(L + LW + (16 * ch + t) * FST + c * 4); lp[t] = run; }
              const float lend = lp[15];
#pragma unroll
              for (int t = 0; t < 16; ++t) if ((t >> 2) == q) { const int tok = 16 * ch + t, o = tok * FST + c * 4, ob = tok * TST + c * 2;
                  const float av = *(LAS float*)(L + AAF + o), bv = *(LAS float*)(L + ICL + o), kp = *(LAS float*)(L + KS + o), rv = *(LAS float*)(L + RS + o);
                  const float em1 = t ? __expf(lp[t ? t - 1 : 0]) : 1.f, et = __expf(lp[t]), iet = __expf(-lp[t]), ee = __expf(lend - lp[t]);
                  *(LAS bf16*)(L + AT + ob) = (bf16)f2bf(av * em1); *(LAS bf16*)(L + RT + ob) = (bf16)f2bf(rv * et); *(LAS bf16*)(L + BH + ob) = (bf16)f2bf(bv * iet);
                  *(LAS bf16*)(L + KH + ob) = (bf16)f2bf(kp * iet); *(LAS bf16*)(L + BBAR + ob) = (bf16)f2bf(bv * ee); *(LAS bf16*)(L + KBAR + ob) = (bf16)f2bf(kp * ee); }
              if (q == 0) *(LAS float*)(L + PCO + (ch * 64 + c) * 4) = __expf(lend); }
            }
            LDS_BARRIER();
            { RW_LANES();
            { const int mi = wave & 3, ch = wave >> 2; const int lhs = (mi & 1) ? KH : BH, rhs = (mi & 2) ? RT : AT; f32x4 acc = (f32x4){0.f, 0.f, 0.f, 0.f};
#pragma unroll
              for (int ks = 0; ks < 2; ++ks) { const bf16x8 a_ = *(const LAS bf16x8*)(L + lhs + (16 * ch + lr) * TST + (32 * ks + 8 * g) * 2), b_ = *(const LAS bf16x8*)(L + rhs + (16 * ch + lr) * TST + (32 * ks + 8 * g) * 2);
                  acc = MFMA16(a_, b_, acc); }
#pragma unroll
              for (int r = 0; r < 4; ++r) { const int s_ = 4 * g + r; acc[r] = ((mi < 2) ? (s_ < lr) : (s_ <= lr)) ? acc[r] : 0.f; }
              if (mi != 0) *(LAS s16x4*)(L + SM + ch * 2048 + (mi - 1) * 512 + lr * 32 + 8 * g) = pack4(acc);
              else {
#pragma unroll
                  for (int r = 0; r < 4; ++r) *(LAS float*)(L + MABF + ch * 1024 + ((4 * g + r) * 16 + lr) * 4) = acc[r];
                  float m[16];
#pragma unroll
                  for (int s_ = 15; s_ >= 0; --s_) { float row[16];
#pragma unroll
                      for (int u4 = 0; u4 < 4; ++u4) { const f32x4 rv = *(const LAS f32x4*)(L + MABF + ch * 1024 + s_ * 64 + u4 * 16); row[4 * u4] = rv[0]; row[4 * u4 + 1] = rv[1]; row[4 * u4 + 2] = rv[2]; row[4 * u4 + 3] = rv[3]; }
                      float sum = (s_ == lr) ? 1.f : 0.f;
#pragma unroll
                      for (int u = s_ + 1; u < 16; ++u) sum += row[u] * m[u];
                      m[s_] = sum; asm volatile("" ::: "memory"); }
                  if (lane < 16) { *(LAS bf16x8*)(L + SM + ch * 2048 + 1536 + lr * 32) = pack8f(m); *(LAS bf16x8*)(L + SM + ch * 2048 + 1536 + lr * 32 + 16) = pack8f(m + 8); }
              } }
            }
            LDS_BARRIER();
            { RW_LANES();
            if (wave < 4) {
#pragma unroll 1
                for (int ch = 0; ch < 2; ++ch) {
                    const bf16x8 sf0 = pack8(sT[0], sT[1]), sf1 = pack8(sT[2], sT[3]);
                    const s16x4 vf = lds_tr(L + VB + par * TC * TST + (16 * ch + 4 * g + q4) * TST + (16 * wave + 4 * p4) * 2);
                    const int rowb = (16 * ch + lr) * TST, smb = SM + ch * 2048 + lr * 32 + 8 * g;
                    f32x4 x = (f32x4){0.f, 0.f, 0.f, 0.f}, y = (f32x4){0.f, 0.f, 0.f, 0.f};
                    x = MFMA16(cat8(*(const LAS s16x4*)(L + AT + rowb + (4 * g) * 2), *(const LAS s16x4*)(L + AT + rowb + (16 + 4 * g) * 2)), sf0, x);
                    x = MFMA16(cat8(*(const LAS s16x4*)(L + AT + rowb + (32 + 4 * g) * 2), *(const LAS s16x4*)(L + AT + rowb + (48 + 4 * g) * 2)), sf1, x);
                    x = MFMA16K(*(const LAS s16x4*)(L + smb), vf, x);
                    const s16x4 xf = pack4(x);
                    const f32x4 sa = MFMA16K(*(const LAS s16x4*)(L + smb + 1536), xf, ((f32x4){0.f, 0.f, 0.f, 0.f}));
                    const s16x4 saf = pack4(sa);
                    y = MFMA16(cat8(*(const LAS s16x4*)(L + RT + rowb + (4 * g) * 2), *(const LAS s16x4*)(L + RT + rowb + (16 + 4 * g) * 2)), sf0, y);
                    y = MFMA16(cat8(*(const LAS s16x4*)(L + RT + rowb + (32 + 4 * g) * 2), *(const LAS s16x4*)(L + RT + rowb + (48 + 4 * g) * 2)), sf1, y);
                    y = MFMA16K(*(const LAS s16x4*)(L + smb + 512), saf, y);
                    y = MFMA16K(*(const LAS s16x4*)(L + smb + 1024), vf, y);
#pragma unroll
                    for (int kt = 0; kt < 4; ++kt) { const f32x4 pc = *(const LAS f32x4*)(L + PCO + (ch * 64 + 16 * kt + 4 * g) * 4);
                        const s16x4 bb = lds_tr(L + BBAR + (16 * ch + 4 * g + q4) * TST + (16 * kt + 4 * p4) * 2), kb = lds_tr(L + KBAR + (16 * ch + 4 * g + q4) * TST + (16 * kt + 4 * p4) * 2);
                        f32x4 sn = sT[kt] * pc; sn = MFMA16K(bb, saf, sn); sn = MFMA16K(kb, vf, sn); sT[kt] = sn; }
#pragma unroll
                    for (int r = 0; r < 4; ++r) *(LAS float*)(L + YR + (16 * ch + 4 * g + r) * FST + (16 * wave + lr) * 4) = y[r];
                }
            }
            }
        }
        LDS_BARRIER();
        { RW_LANES(); RW_PASS_E(SEQ - TC, ((SEQ - TC) >> 5) & 1); }
#undef RW_LOAD
#undef RW_LD1
#undef RW_LD0
#undef RW_SHIFT
#undef RW_LANES
#undef RW_SLOTS
#undef RW_PASS_E
    }
}

__device__ __forceinline__ void retention_mfma(const Frame& F, bf16* Q) {
    constexpr int KST = 528, VST = 272, SST = 528;
    constexpr int KOFF = 0, VOFF = 64 * KST, SOFF = VOFF + 64 * VST;
    LAS unsigned char* const L = F.lds;
    const int tid = F.tid, lane0 = F.lane, w = F.wave;
    const int it = w & 3, vh = w >> 2;
#define RT_LANES() int lane = lane0; asm volatile("" : "+v"(lane)); const int g = lane >> 4, lr = lane & 15, q4 = lr >> 2, p4 = lane & 3; (void)g; (void)lr; (void)q4; (void)p4
    const int lr0 = lane0 & 15;
    for (int item = F.bid; item < BATCH * 16; item += F.G) {
        const int b = item >> 4, h = (item >> 2) & 3, sl = item & 3;
        const float lg2 = log2f(1.f - exp2f(-5.f - (float)h));
        const float g64 = exp2f(64.f * lg2);
        const float vf0 = exp2f(-(float)((tid >> 4) + 1) * lg2), vf1 = exp2f(-(float)((tid >> 4) + 33) * lg2);
        const float ysc = exp2f((float)(16 * it + lr0 + 1) * lg2);
        const bf16* qg = Q + L1_QKH + (size_t)(b * 4 + h) * 2048 * 512;
        const bf16* kg = qg + 256;
        bf16* vg = Q + L1_VH + (size_t)((b * 4 + h) * 4 + sl) * 2048 * 128;
        f32x4 st[2][8];
#pragma unroll
        for (int a = 0; a < 2; ++a)
#pragma unroll
            for (int c = 0; c < 8; ++c) st[a][c] = (f32x4){0.f, 0.f, 0.f, 0.f};
        __syncthreads();
        for (int i = tid; i < 128 * SST / 16; i += NTHR) *(LAS v4u*)(L + SOFF + i * 16) = (v4u){0u, 0u, 0u, 0u};
        v4u kp[4], vp[2];
#define RET_LOAD(c) do { const size_t r0_ = (size_t)(64 * (c)); \
            _Pragma("unroll") for (int i_ = 0; i_ < 4; ++i_) { const int p_ = tid + NTHR * i_; kp[i_] = *(const v4u*)(kg + (r0_ + (p_ >> 5)) * 512 + (p_ & 31) * 8); } \
            _Pragma("unroll") for (int i_ = 0; i_ < 2; ++i_) { const int p_ = tid + NTHR * i_; vp[i_] = *(const v4u*)(vg + (r0_ + (p_ >> 4)) * 128 + (p_ & 15) * 8); } } while (0)
        RET_LOAD(0);
        bf16x8 qc[8];
#define RET_QLOAD(c_) do { RT_LANES(); _Pragma("unroll") for (int ks = 0; ks < 8; ++ks) qc[ks] = *(const bf16x8*)(qg + (size_t)(64 * (c_) + 16 * it + lr) * 512 + 32 * ks + 8 * g); } while (0)
        RET_QLOAD(0);
        for (int c = 0; c < SEQ / 64; ++c) {
#pragma unroll
            for (int i = 0; i < 4; ++i) { const int p = tid + NTHR * i; *(LAS v4u*)(L + KOFF + (p >> 5) * KST + (p & 31) * 16) = kp[i]; }
#pragma unroll
            for (int i = 0; i < 2; ++i) { const int p = tid + NTHR * i; const float f = i ? vf1 : vf0; const v4u x = vp[i]; v4u o;
                o.x = cvtpk(bflo(x.x) * f, bfhi(x.x) * f); o.y = cvtpk(bflo(x.y) * f, bfhi(x.y) * f); o.z = cvtpk(bflo(x.z) * f, bfhi(x.z) * f); o.w = cvtpk(bflo(x.w) * f, bfhi(x.w) * f);
                *(LAS v4u*)(L + VOFF + (p >> 4) * VST + (p & 15) * 16) = o; }
            LDS_BARRIER();
            if (c + 1 < SEQ / 64) RET_LOAD(c + 1);
            { RT_LANES();
#pragma unroll
            for (int s2 = 0; s2 < 2; ++s2) { bf16x8 ka[2];
#pragma unroll
                for (int dt = 0; dt < 2; ++dt) { const s16x4 lo = lds_tr(L + KOFF + (32 * s2 + 8 * g + q4) * KST + (32 * w + 16 * dt + 4 * p4) * 2), hi = lds_tr(L + KOFF + (32 * s2 + 8 * g + 4 + q4) * KST + (32 * w + 16 * dt + 4 * p4) * 2); ka[dt] = cat8(lo, hi); }
#pragma unroll
                for (int vq = 0; vq < 2; ++vq) { bf16x8 vb[4];
#pragma unroll
                    for (int v4 = 0; v4 < 4; ++v4) { const int vt = 4 * vq + v4; const s16x4 lo = lds_tr(L + VOFF + (32 * s2 + 8 * g + q4) * VST + (16 * vt + 4 * p4) * 2), hi = lds_tr(L + VOFF + (32 * s2 + 8 * g + 4 + q4) * VST + (16 * vt + 4 * p4) * 2); vb[v4] = cat8(lo, hi); }
                    __builtin_amdgcn_sched_barrier(0);
#pragma unroll
                    for (int v4 = 0; v4 < 4; ++v4) { st[0][4 * vq + v4] = MFMA16(ka[0], vb[v4], st[0][4 * vq + v4]); st[1][4 * vq + v4] = MFMA16(ka[1], vb[v4], st[1][4 * vq + v4]); }
                    __builtin_amdgcn_sched_barrier(0); } }
#pragma unroll
            for (int dt = 0; dt < 2; ++dt)
#pragma unroll
                for (int vt = 0; vt < 8; ++vt) st[dt][vt] = st[dt][vt] * g64;
            }
            __builtin_amdgcn_sched_barrier(0);
            { RT_LANES();
            f32x4 sacc[4];
#pragma unroll
            for (int jt = 0; jt < 4; ++jt) { sacc[jt] = (f32x4){0.f, 0.f, 0.f, 0.f};
                if (jt <= it) { bf16x8 kr[8];
#pragma unroll
                    for (int ks = 0; ks < 8; ++ks) kr[ks] = *(const LAS bf16x8*)(L + KOFF + (16 * jt + lr) * KST + (32 * ks + 8 * g) * 2);
                    __builtin_amdgcn_sched_barrier(0);
#pragma unroll
                    for (int ks = 0; ks < 8; ++ks) sacc[jt] = MFMA16(kr[ks], qc[ks], sacc[jt]);
                    if (jt == it) {
#pragma unroll
                        for (int r = 0; r < 4; ++r) sacc[jt][r] = (4 * g + r <= lr) ? sacc[jt][r] : 0.f; }
                    __builtin_amdgcn_sched_barrier(0);
                } }
            bf16x8 sf[2]; sf[0] = pack8(sacc[0], sacc[1]); sf[1] = pack8(sacc[2], sacc[3]); __builtin_amdgcn_sched_barrier(0);
#pragma unroll
            for (int x = 0; x < 4; ++x) { const int vt = 4 * vh + x; f32x4 y = (f32x4){0.f, 0.f, 0.f, 0.f};
#pragma unroll
                for (int kh = 0; kh < 2; ++kh) { bf16x8 sr[4];
#pragma unroll
                    for (int k4 = 0; k4 < 4; ++k4) sr[k4] = *(const LAS bf16x8*)(L + SOFF + (16 * vt + lr) * SST + (32 * (4 * kh + k4) + 8 * g) * 2);
                    __builtin_amdgcn_sched_barrier(0);
#pragma unroll
                    for (int k4 = 0; k4 < 4; ++k4) y = MFMA16(sr[k4], qc[4 * kh + k4], y);
                    __builtin_amdgcn_sched_barrier(0); }
#pragma unroll
                for (int s2 = 0; s2 < 2; ++s2) if (2 * s2 <= it) {
                    const s16x4 lo = lds_tr(L + VOFF + (32 * s2 + 4 * g + q4) * VST + (16 * vt + 4 * p4) * 2), hi = lds_tr(L + VOFF + (32 * s2 + 16 + 4 * g + q4) * VST + (16 * vt + 4 * p4) * 2);
                    y = MFMA16(cat8(lo, hi), sf[s2], y); }
                v2u o; o.x = cvtpk(y[0] * ysc, y[1] * ysc); o.y = cvtpk(y[2] * ysc, y[3] * ysc);
                *(v2u*)(vg + (size_t)(64 * c + 16 * it + lr) * 128 + 16 * vt + 4 * g) = o; __builtin_amdgcn_sched_barrier(0); }
            }
            if (c + 1 < SEQ / 64) RET_QLOAD(c + 1);
            LDS_BARRIER();
            { RT_LANES();
#pragma unroll
            for (int dt = 0; dt < 2; ++dt)
#pragma unroll
                for (int vt = 0; vt < 8; ++vt) { v2u o; o.x = cvtpk(st[dt][vt][0], st[dt][vt][1]); o.y = cvtpk(st[dt][vt][2], st[dt][vt][3]);
                    *(LAS v2u*)(L + SOFF + (16 * vt + lr) * SST + (32 * w + 16 * dt + 4 * g) * 2) = o; }
            }
        }
#undef RET_LOAD
#undef RET_QLOAD
#undef RT_LANES
    }
}

__device__ __forceinline__ void retention_norm(const Frame& F, bf16* Q) {
    const int gw = F.bid * NWAVES + F.wave, NGW = F.G * NWAVES, lane = F.lane;
    for (int it = gw; it < MTOK * 4; it += NGW) {
        const int row = it >> 2, h = it & 3, c8 = 8 * lane; const bf16* yp = Q + L1_VH + ((size_t)(((row >> 11) * 4 + h) * 4 + (c8 >> 7)) * 2048 + (row & 2047)) * 128 + (c8 & 127); bf16* gp = Q + L1_GB + (size_t)row * 2048 + h * 512 + c8;
        const v4u w = *(const v4u*)yp; const v4u gq = *(const v4u*)gp;
        float v[8] = {bflo(w.x), bfhi(w.x), bflo(w.y), bfhi(w.y), bflo(w.z), bfhi(w.z), bflo(w.w), bfhi(w.w)};
        const float g[8] = {bflo(gq.x), bfhi(gq.x), bflo(gq.y), bfhi(gq.y), bflo(gq.z), bfhi(gq.z), bflo(gq.w), bfhi(gq.w)};
        float s = 0.f;
#pragma unroll
        for (int j = 0; j < 8; ++j) s += v[j];
        const float mean = wave_sum(s) * (1.f / 512.f); float s2 = 0.f;
#pragma unroll
        for (int j = 0; j < 8; ++j) { v[j] -= mean; s2 += v[j] * v[j]; }
        const float r = 1.f / sqrtf(wave_sum(s2) * (1.f / 512.f) + LN_EPS);
        float o[8];
#pragma unroll
        for (int j = 0; j < 8; ++j) o[j] = silu_f(g[j]) * v[j] * r;
        v4u ow; ow.x = pk2(o[0], o[1]); ow.y = pk2(o[2], o[3]); ow.z = pk2(o[4], o[5]); ow.w = pk2(o[6], o[7]);
        *(v4u*)gp = ow;
    }
}

__device__ __forceinline__ int pad256(int n) { return (n + 255) & ~255; }
__device__ __forceinline__ void moe_slots(const Frame& F, const unsigned* cnt, const int* tok_e, const float* tok_p, const int* tok_pos, int* tok_slot, int* rowtok, int* rowdst, float* rowp) {
    const int gt = F.bid * NTHR + F.tid, NGT = F.G * NTHR;
    for (int row = gt; row < MTOK; row += NGT) {
        const int e01 = tok_e[row], e0 = e01 & 255, e1 = e01 >> 8; const float p0 = tok_p[row];
        int base0 = 0, base1 = 0;
#pragma unroll
        for (int e = 0; e < 8; ++e) { const int pc = pad256((int)cnt[e]); if (e < e0) base0 += pc; if (e < e1) base1 += pc; }
        const int s0 = base0 + tok_pos[2 * row], s1 = base1 + tok_pos[2 * row + 1];
        rowtok[s0] = row; rowdst[s0] = row; rowp[s0] = p0;
        rowtok[s1] = row; rowdst[s1] = MTOK + row; rowp[s1] = 1.f - p0;
        tok_slot[2 * row] = s0; tok_slot[2 * row + 1] = s1;
    }
    for (int it = gt; it < 8 * 256; it += NGT) {
        const int e = it >> 8, i = it & 255;
        int base = 0;
#pragma unroll
        for (int q = 0; q < 8; ++q) if (q < e) base += pad256((int)cnt[q]);
        const int n = (int)cnt[e];
        if (n + i < pad256(n)) { const int s = base + n + i; rowtok[s] = 0; rowdst[s] = -1; rowp[s] = 0.f; }
    }
}
struct MoeOrder {
    int npan, nN, G, c; const char* W; size_t estride, tstepB; const int* rows; const LAS int* pexp; int p0;
    __device__ bool next(int i, pg8::Unit& u) const {
        const int nwg = npan * nN; const long L = (long)i * G + c; if (L >= nwg) return false;
        int wgid = (int)L; { const int q = nwg / pg8::NXCD, r = nwg % pg8::NXCD, xcd = wgid % pg8::NXCD, off = wgid / pg8::NXCD; wgid = (xcd < r ? xcd * (q + 1) : r * (q + 1) + (xcd - r) * q) + off; }
        const int nig = pg8::WGM * nN, gid = wgid / nig, fm = gid * pg8::WGM, gsz = (npan - fm) < pg8::WGM ? (npan - fm) : pg8::WGM;
        u.pm = fm + ((wgid % nig) % gsz); u.pn = (wgid % nig) / gsz; return true; }
    __device__ __forceinline__ const char* b_base(const pg8::Unit& u) const { const int e = __builtin_amdgcn_readfirstlane(pexp[p0 + u.pm]); return W + (size_t)e * estride + (size_t)u.pn * tstepB; }
    __device__ __forceinline__ const int* a_rows(const pg8::Unit& u) const { return rows + (p0 + u.pm) * 256; }
};
struct MoeTailOrder {
    int ntail, G, c, kslice; const char* W; size_t estride, tstepB; const LAS int* pexp;
    __device__ bool next(int i, pg8::Unit& u) const { const int L = i * G + c; if (L >= ntail * 4 * MOE_KS) return false;
        u.ks = L % MOE_KS; u.pn = (L / MOE_KS) & 3; u.pm = L / (4 * MOE_KS); u.kt0 = u.ks * kslice; u.knt = kslice; return true; }
    __device__ __forceinline__ const char* b_base(const pg8::Unit& u) const { const int e = __builtin_amdgcn_readfirstlane(pexp[MOE_TAIL0 + u.pm]); return W + (size_t)e * estride + (size_t)u.pn * tstepB; }
    __device__ __forceinline__ const int* a_rows(const pg8::Unit&) const { return nullptr; }
};
__device__ __forceinline__ int moe_panels(const unsigned* cnt, LAS int* pexp, int tid) {
    int pb[9]; pb[0] = 0;
#pragma unroll
    for (int e = 0; e < 8; ++e) pb[e + 1] = pb[e] + pad256((int)cnt[e]) / 256;
    if (tid < MOE_SLOTS / 256) { int e = 0;
#pragma unroll
        for (int q = 1; q < 8; ++q) e += (tid >= pb[q]) ? 1 : 0;
        pexp[tid] = e; }
    __syncthreads();
    return pb[8];
}

__global__ void __launch_bounds__(NTHR, 2) fwd_kernel(Args args) {
    extern __shared__ __attribute__((aligned(16))) unsigned char lds_raw[];
    Frame F;
    F.lds = (LAS unsigned char*)lds_raw;
    F.tid = threadIdx.x; F.lane = F.tid & 63; F.wave = __builtin_amdgcn_readfirstlane(F.tid >> 6); F.G = gridDim.x; F.bid = blockIdx.x;
    typedef const unsigned char __attribute__((address_space(4))) kseg_t;
    kseg_t* kp0 = (kseg_t*)__builtin_amdgcn_kernarg_segment_ptr();
#define KARG(T, off) (*(T const __attribute__((address_space(4)))*)(kp + (off)))
#define PHASE_ENTER { int l_; asm volatile("v_mbcnt_lo_u32_b32 %0, -1, 0\n\tv_mbcnt_hi_u32_b32 %0, -1, %0" : "=v"(l_)); F.lane = l_; F.tid = F.wave * 64 + l_; } kseg_t* kp = kp0; asm volatile("" : "+s"(kp)); unsigned char* const ws = KARG(unsigned char*, 38 * 8 + 8); gu32* const ctl = (gu32*)(ws + WS_CTL); (void)ctl
#define INP(i) KARG(const float*, 8 * (i))
#define OUTP KARG(float*, 38 * 8)
#define WSP(T, off) ((T*)(ws + (off)))
    int lo, hi;
    { kseg_t* kp = kp0; lo = KARG(int, 38 * 8 + 16); hi = KARG(int, 38 * 8 + 20); }
    volatile LAS unsigned* MISC = (volatile LAS unsigned*)(F.lds + MISC_OFF);
    for (int u = F.tid; u < (LDS_BYTES - RING_BYTES) / 4; u += NTHR) ((LAS unsigned*)(F.lds + RING_BYTES))[u] = 0u;
    __syncthreads();
    const bool multi = (hi - lo) > 1;
    XcdBarrier bar; bar.x = 0; bar.st = nullptr;
    { PHASE_ENTER; bar.bar = (unsigned*)(ctl + CW_BAR); if (multi) bar = xcd_barrier_post((unsigned*)(ctl + CW_BAR), MISC + 8); }
#ifndef PH_MASK
#define PH_MASK 0xFFFFFFu
#endif
#define IN(k) (((PH_MASK >> (k)) & 1u) && lo <= (k) && (k) < hi)
#define SEAM(k) do { if (IN(k) && IN((k) + 1)) xcd_barrier(bar); } while (0)
#define W0IN WSP(bf16, WS_W0IN)
#define W0OUT WSP(bf16, WS_W0OUT)
#define W0GU WSP(bf16, WS_W0GU)
#define W0D WSP(bf16, WS_W0D)
#define W1IN WSP(bf16, WS_W1IN)
#define W1OUT WSP(bf16, WS_W1OUT)
#define XB WSP(bf16, WS_XB)
#define P WSP(bf16, WS_P)
#define X1 WSP(float, WS_X1)
#define HID WSP(bf16, WS_HID)
#define HB WSP(bf16, WS_H)
#define MIX ((bf16*)OUTP)
#define OUT OUTP
#define MOEGU ((bf16*)OUTP)
#define MOED WSP(bf16, WS_MOED)
#define Y0 WSP(bf16, WS_Y0)
#define Y1 WSP(bf16, WS_Y1)
#define MHID WSP(bf16, WS_MHID)
#define TOK_E WSP(int, WS_TAB + TAB_E)
#define TOK_P WSP(float, WS_TAB + TAB_P)
#define TOK_POS WSP(int, WS_TAB + TAB_POS)
#define ROWTOK WSP(int, WS_TAB + TAB_ROWTOK)
#define ROWDST WSP(int, WS_TAB + TAB_ROWDST)
#define ROWP WSP(float, WS_TAB + TAB_ROWP)
#define CNT ((unsigned*)(ctl + CW_CNT))
#define CSTAB WSP(float, WS_CS)
#define XA WSP(bf16, WS_H)
#define BCA WSP(bf16, WS_XB)
#define SMSB WSP(bf16, WS_XB + 32 * MiB)
    const int gw = F.bid * NWAVES + F.wave, NGW = F.G * NWAVES;
    LAS float* const scr = (LAS float*)(F.lds + F.wave * 16384);

    if (IN(0)) { PHASE_ENTER;
        transpose_job<1>(INP(I_EV_WIN), nullptr, 5936, 1024, W0IN, 6144, scr, gw, NGW, F.lane);
        transpose_job<0>(INP(I_EV_WOUT), nullptr, 1024, 2048, W0OUT, 1024, scr, gw, NGW, F.lane);
        transpose_job<2>(INP(I_FFN_WG), INP(I_FFN_WU), 3584, 1024, W0GU, 7168, scr, gw, NGW, F.lane);
        transpose_job<0>(INP(I_FFN_WD), nullptr, 1024, 3584, W0D, 1024, scr, gw, NGW, F.lane);
        transpose_job<0>(INP(I_OD_WIN), nullptr, 6144, 1024, W1IN, 6144, scr, gw, NGW, F.lane);
        transpose_job<0>(INP(I_OD_WOUT), nullptr, 1024, 2048, W1OUT, 1024, scr, gw, NGW, F.lane);
        const float* x = INP(I_X);
        for (size_t i = (size_t)(F.bid * NTHR + F.tid) * 8; i < (size_t)MTOK * DM; i += (size_t)F.G * NTHR * 8) {
            const f32x4 a = __builtin_nontemporal_load((const f32x4*)(x + i)), b = __builtin_nontemporal_load((const f32x4*)(x + i + 4));
            v4u o; o.x = pk2(a.x, a.y); o.y = pk2(a.z, a.w); o.z = pk2(b.x, b.y); o.w = pk2(b.z, b.w); *(v4u*)(XB + i) = o; }
    }
    SEAM(0);
    if (IN(1)) { PHASE_ENTER; pg8::StaticOrder S; S.init(MTOK, PW, F.G, F.bid, W0IN, 1024); pg8::EpiRoute0 E{P, L0_XBC, L0_RKVH, L0_SMB};
        pg8::gemm_phase<pg8::EpiRoute0, pg8::StaticOrder, true, false>(F.lds, XB, 1024, 1024, 1024, S, E); }
    SEAM(1);
    if (IN(2)) { PHASE_ENTER; conv_prepass(F, P, INP(I_CONVW), INP(I_CONVB), XA, BCA); small_prepass(F, P + L0_SMB, INP(I_MU), SMSB); }
    SEAM(2);
    if (IN(3)) { PHASE_ENTER;
        ssd_mfma(F, P, XA, BCA, INP(I_DTB), INP(I_ALOG), INP(I_DSKIP), MIX);
        __syncthreads();
        RwkvW W{INP(I_MU), INP(I_W0), INP(I_WUP), INP(I_A0), INP(I_AUP), INP(I_GUP), INP(I_KK), INP(I_KA), INP(I_RK), INP(I_RLNW), INP(I_RLNB)};
        rwkv_items(F, P, SMSB, W, MIX);
    }
    SEAM(3);
    if (IN(4)) { PHASE_ENTER; ssd_norm(F, MIX, INP(I_MNORM)); }
    SEAM(4);
    if (IN(5)) { PHASE_ENTER; pg8::StaticOrder S; S.init(MTOK, 1024, F.G, F.bid, W0OUT, 2048); pg8::EpiStore E{HB, 1024};
        pg8::gemm_phase<pg8::EpiStore, pg8::StaticOrder, true, false>(F.lds, MIX, 2048, 2048, 2048, S, E); }
    SEAM(5);
    if (IN(6)) { PHASE_ENTER; ln_rows<false, false>(F, INP(I_X), nullptr, HB, nullptr, INP(I_EV_LN1G), INP(I_EV_LN1B), nullptr, XB, 0, MTOK, nullptr, nullptr, nullptr, nullptr, nullptr); }
    SEAM(6);
    if (IN(7)) { PHASE_ENTER; pg8::StaticOrder S; S.init(MTOK, 2 * DFF, F.G, F.bid, W0GU, 1024); pg8::EpiSwiGLU E{HID, DFF};
        pg8::gemm_phase<pg8::EpiSwiGLU, pg8::StaticOrder, true, false>(F.lds, XB, 1024, 1024, 1024, S, E); }
    SEAM(7);
    if (IN(8)) { PHASE_ENTER; pg8::StaticOrder S; S.init(MTOK, 1024, F.G, F.bid, W0D, DFF); pg8::EpiStore E{HB, 1024};
        pg8::gemm_phase<pg8::EpiStore, pg8::StaticOrder, true, false>(F.lds, HID, DFF, DFF, DFF, S, E); }
    SEAM(8);
    if (IN(9)) { PHASE_ENTER; ln_rows<false, false>(F, nullptr, XB, HB, nullptr, INP(I_EV_LN2G), INP(I_EV_LN2B), nullptr, XB, 0, MTOK, nullptr, nullptr, nullptr, nullptr, nullptr); }
    SEAM(9);
    if (IN(10)) { PHASE_ENTER; pg8::StaticOrder S; S.init(MTOK, PW, F.G, F.bid, W1IN, 1024); pg8::EpiRoute1 E{P, L1_VH, L1_GB, (const int*)INP(I_POS)};
        pg8::gemm_phase<pg8::EpiRoute1, pg8::StaticOrder, true, false>(F.lds, XB, 1024, 1024, 1024, S, E); }
    SEAM(10);
    if (IN(11)) { PHASE_ENTER; retention_mfma(F, P); }
    SEAM(11);
    if (IN(12)) { PHASE_ENTER; retention_norm(F, P); }
    SEAM(12);
    if (IN(13)) { PHASE_ENTER; pg8::StaticOrder S; S.init(MTOK, 1024, F.G, F.bid, W1OUT, 2048); pg8::EpiStore E{HB, 1024};
        pg8::gemm_phase<pg8::EpiStore, pg8::StaticOrder, true, false>(F.lds, P + L1_GB, 2048, 2048, 2048, S, E); }
    SEAM(13);
    if (IN(14)) { PHASE_ENTER; ln_rows<true, false>(F, nullptr, XB, HB, nullptr, INP(I_OD_LN1G), INP(I_OD_LN1B), nullptr, XB, 0, MTOK, INP(I_ROUTER), CNT, TOK_E, TOK_P, TOK_POS); }
    SEAM(14);
    if (IN(15)) { PHASE_ENTER;
        for (int e = 0; e < NEXP; ++e) transpose_job<0>(INP(I_MOE_WD) + (size_t)e * DFF * 1024, nullptr, 1024, DFF, MOED + (size_t)e * 1024 * DFF, 1024, scr, gw, NGW, F.lane);
        for (int e = NEXP - 1; e >= 0; --e)
            transpose_job<2>(INP(I_MOE_WG) + (size_t)e * 1024 * DFF, INP(I_MOE_WU) + (size_t)e * 1024 * DFF, DFF, 1024, MOEGU + (size_t)e * 7168 * 1024, 7168, scr, gw, NGW, F.lane);
        moe_slots(F, CNT, TOK_E, TOK_P, TOK_POS, TOK_POS, ROWTOK, ROWDST, ROWP);
    }
    SEAM(15);
#pragma unroll
    for (int part = 0; part < 2; ++part) {
        const int pa = 16 + 2 * part;
        if (IN(pa)) { PHASE_ENTER;
            LAS int* pexp = (LAS int*)(F.lds + PEXP_OFF);
            const int ptot = moe_panels(CNT, pexp, F.tid); const int p0 = part ? MOE_P1 : 0, np = part ? ptot - MOE_P1 : (ptot < MOE_P1 ? ptot : MOE_P1);
            MoeOrder S{np, 28, F.G, F.bid, (const char*)MOEGU, (size_t)7168 * 1024 * 2, (size_t)256 * 1024 * 2, ROWTOK, pexp, p0};
            pg8::EpiSwiGLU E{MHID, DFF};
            pg8::gemm_phase<pg8::EpiSwiGLU, MoeOrder, true, true>(F.lds, XB, 1024, 1024, 1024, S, E);
        }
        SEAM(pa);
        if (IN(pa + 1)) { PHASE_ENTER;
            LAS int* pexp = (LAS int*)(F.lds + PEXP_OFF);
            const int ptot = moe_panels(CNT, pexp, F.tid); const int p0 = part ? MOE_P1 : 0, pend = ptot < (part ? MOE_TAIL0 : MOE_P1) ? ptot : (part ? MOE_TAIL0 : MOE_P1);
            MoeOrder S{pend - p0, 4, F.G, F.bid, (const char*)MOED, (size_t)1024 * DFF * 2, (size_t)256 * DFF * 2, nullptr, pexp, p0};
            pg8::EpiMoeOut E{Y0, Y1, 1024, MTOK, ROWDST + p0 * 256, ROWP + p0 * 256};
            pg8::gemm_phase<pg8::EpiMoeOut, MoeOrder, true, false>(F.lds, MHID, DFF, DFF, DFF, S, E);
            if (part == 1 && ptot > MOE_TAIL0) {
                __syncthreads();
                MoeTailOrder T{ptot - MOE_TAIL0, F.G, F.bid, DFF / 64 / MOE_KS, (const char*)MOED, (size_t)1024 * DFF * 2, (size_t)256 * DFF * 2, pexp};
                pg8::EpiSlab ES{WSP(float, WS_SLAB), 1024, MOE_KS};
                pg8::gemm_phase<pg8::EpiSlab, MoeTailOrder, true, false>(F.lds, MHID + (size_t)(MOE_TAIL0 - MOE_P1) * 256 * DFF, DFF, DFF, DFF, T, ES);
            }
        }
        SEAM(pa + 1);
    }
    if (IN(20)) { PHASE_ENTER; ln_rows<false, true>(F, nullptr, XB, Y0, Y1, INP(I_OD_LN2G), INP(I_OD_LN2B), OUT, nullptr, 0, MTOK, nullptr, nullptr, nullptr, TOK_P, TOK_POS, nullptr, nullptr, WSP(float, WS_SLAB)); }
#undef IN
#undef SEAM
#undef INP
#undef P
}
constexpr int N_PHASES = 21;

extern "C" void kernel_launch(void* const* d_in, const int* in_sizes, int n_in, void* d_out, int out_size, void* d_ws, size_t ws_size, hipStream_t stream) {
    static int grid = 0;
    if (grid == 0) {
        if (n_in != 38 || out_size != MTOK * DM || ws_size < WS_END) { fprintf(stderr, "kernel_launch: unexpected shapes (n_in %d out %d ws %zu)\n", n_in, out_size, ws_size); grid = -1; return; }
        int dev = 0, cus = 0;
        if (hipGetDevice(&dev) != hipSuccess || hipDeviceGetAttribute(&cus, hipDeviceAttributeMultiprocessorCount, dev) != hipSuccess) { grid = -1; return; }
        if (hipFuncSetAttribute((const void*)fwd_kernel, hipFuncAttributeMaxDynamicSharedMemorySize, LDS_BYTES) != hipSuccess) { grid = -1; return; }
        int per_cu = 0;
        (void)hipOccupancyMaxActiveBlocksPerMultiprocessor(&per_cu, (const void*)fwd_kernel, NTHR, LDS_BYTES);
        (void)hipGetLastError();
        grid = cus;
    }
    if (grid < 0) return;
    (void)hipMemsetAsync((char*)d_ws + WS_CTL, 0, CTL_ZERO_BYTES, stream);
    Args a{};
    for (int i = 0; i < 38; ++i) a.in[i] = d_in[i];
    a.out = (float*)d_out; a.ws = (unsigned char*)d_ws;
#if MK_ONE_LAUNCH
    a.ph_lo = 0; a.ph_hi = N_PHASES;
    hipLaunchKernelGGL(fwd_kernel, dim3(grid), dim3(NTHR), LDS_BYTES, stream, a);
#else
    for (int p = 0; p < N_PHASES; ++p) { a.ph_lo = p; a.ph_hi = p + 1; hipLaunchKernelGGL(fwd_kernel, dim3(grid), dim3(NTHR), LDS_BYTES, stream, a); }
#endif
}
```

```cpp
#include <hip/hip_runtime.h>
#include <cstdio>
#include <cstdint>

#ifndef MK_ONE_LAUNCH
#define MK_ONE_LAUNCH 1
#endif

namespace pg8 {
#define PG8_LAS __attribute__((address_space(3)))
typedef unsigned short bf16_t;
typedef short bf16x8 __attribute__((ext_vector_type(8)));
typedef float f32x4 __attribute__((ext_vector_type(4)));
typedef unsigned u32x4 __attribute__((ext_vector_type(4)));
constexpr int BM = 256, BK = 64, HALF = 128, HTB = HALF * BK * 2, STAGE_BYTES = 8 * HTB, NXCD = 8, WGM = 8;

__host__ __device__ __forceinline__ int lds_byte(int r, int c) { const int st = (r >> 4) * 2 + (c >> 5), rr = r & 15, cc = c & 31, ob = rr * 64 + cc * 2; return st * 1024 + (ob ^ (((ob >> 9) & 1) << 5)); }
__host__ __device__ __forceinline__ void stage_rc(int b, int& R, int& C) { const int st = b / 1024, sb = b % 1024, swz = sb ^ (((sb >> 9) & 1) << 5); R = (st >> 1) * 16 + swz / 64; C = (st & 1) * 32 + (swz % 64) / 2; }
__host__ __device__ __forceinline__ int perm32(int rho) { const int n = rho >> 4, i = rho & 15; return 8 * (i >> 2) + 4 * n + (i & 3); }

struct Unit { int pm, pn; int kt0 = 0, knt = 0, ks = 0; };

struct StaticOrder {
    int nM, nN, nwg, G, c; const char* Bt; size_t tstepB;
    __device__ void init(int M, int N, int G_, int c_, const bf16_t* Bt_, int ldb) { nM = M / BM; nN = N / BM; nwg = nM * nN; G = G_; c = c_; Bt = (const char*)Bt_; tstepB = (size_t)BM * ldb * 2; }
    __device__ bool next(int i, Unit& u) const {
        const long L = (long)i * G + c; if (L >= nwg) return false;
        int wgid = (int)L; { const int q = nwg / NXCD, r = nwg % NXCD, xcd = wgid % NXCD, off = wgid / NXCD; wgid = (xcd < r ? xcd * (q + 1) : r * (q + 1) + (xcd - r) * q) + off; }
        const int nig = WGM * nN, gid = wgid / nig, fm = gid * WGM, gsz = (nM - fm) < WGM ? (nM - fm) : WGM;
        u.pm = fm + ((wgid % nig) % gsz); u.pn = (wgid % nig) / gsz; return true;
    }
    __device__ __forceinline__ const char* b_base(const Unit& u) const { return Bt + (size_t)u.pn * tstepB; }
    __device__ __forceinline__ const int* a_rows(const Unit&) const { return nullptr; }
};

__device__ __forceinline__ unsigned cvt_pk_bf16(float lo, float hi) { unsigned r; asm volatile("v_cvt_pk_bf16_f32 %0, %1, %2" : "=v"(r) : "v"(lo), "v"(hi)); return r; }
__device__ __forceinline__ float silu_f(float x) { return x * __builtin_amdgcn_rcpf(1.0f + __expf(-x)); }

struct EpiStore {
    static constexpr bool PERM = true, AFTER_DRAIN = false;
    bf16_t* O; int ldc;
    __device__ __forceinline__ void operator()(const f32x4 (&acc)[2][2][4][2], const Unit& u, int wr, int wc, int fr, int fq) const {
        const int row0 = u.pm * BM + wr * 64 + fr, col0 = u.pn * BM + wc * 32 + 8 * fq;
#pragma unroll
        for (int ai = 0; ai < 2; ++ai)
#pragma unroll
            for (int m = 0; m < 4; ++m) { bf16_t* rowp = O + (size_t)(row0 + ai * HALF + m * 16) * ldc + col0;
#pragma unroll
                for (int bj = 0; bj < 2; ++bj) { const f32x4 v0 = acc[ai][bj][m][0], v1 = acc[ai][bj][m][1];
                    u32x4 w; w.x = cvt_pk_bf16(v0[0], v0[1]); w.y = cvt_pk_bf16(v0[2], v0[3]); w.z = cvt_pk_bf16(v1[0], v1[1]); w.w = cvt_pk_bf16(v1[2], v1[3]);
                    *(u32x4*)(rowp + bj * HALF) = w; } }
    }
};
struct EpiStoreRot {
    static constexpr bool PERM = true, AFTER_DRAIN = false;
    bf16_t* O; int ldc; const float* cs;
    __device__ __forceinline__ void operator()(const f32x4 (&acc)[2][2][4][2], const Unit& u, int wr, int wc, int fr, int fq) const {
        const int row0 = u.pm * BM + wr * 64 + fr, col0 = u.pn * BM + wc * 32 + 8 * fq;
        const bool rot = u.pn < 8; const float sc = u.pn >= 4 ? 0.0625f : 1.0f;
#pragma unroll
        for (int ai = 0; ai < 2; ++ai)
#pragma unroll
            for (int m = 0; m < 4; ++m) { const int row = row0 + ai * HALF + m * 16; bf16_t* rowp = O + (size_t)row * ldc + col0;
#pragma unroll
                for (int bj = 0; bj < 2; ++bj) { f32x4 v0 = acc[ai][bj][m][0], v1 = acc[ai][bj][m][1];
                    if (rot) { const int i0 = ((col0 + bj * HALF) & 255) >> 1; const float* cp = cs + ((size_t)row * 128 + i0) * 2;
                        const f32x4 c01 = *(const f32x4*)cp, c23 = *(const f32x4*)(cp + 4);
                        const f32x4 r0 = (f32x4){v0[0] * c01[0] - v0[1] * c01[1], v0[1] * c01[0] + v0[0] * c01[1], v0[2] * c01[2] - v0[3] * c01[3], v0[3] * c01[2] + v0[2] * c01[3]};
                        const f32x4 r1 = (f32x4){v1[0] * c23[0] - v1[1] * c23[1], v1[1] * c23[0] + v1[0] * c23[1], v1[2] * c23[2] - v1[3] * c23[3], v1[3] * c23[2] + v1[2] * c23[3]};
                        v0 = r0 * sc; v1 = r1 * sc; }
                    u32x4 w; w.x = cvt_pk_bf16(v0[0], v0[1]); w.y = cvt_pk_bf16(v0[2], v0[3]); w.z = cvt_pk_bf16(v1[0], v1[1]); w.w = cvt_pk_bf16(v1[2], v1[3]);
                    *(u32x4*)(rowp + bj * HALF) = w; } }
    }
};
struct EpiRoute0 {
    static constexpr bool PERM = true, AFTER_DRAIN = false;
    bf16_t* base; size_t o_xbc, o_rkvh, o_smb;
    __device__ __forceinline__ void operator()(const f32x4 (&acc)[2][2][4][2], const Unit& u, int wr, int wc, int fr, int fq) const {
        const int row0 = u.pm * BM + wr * 64 + fr, col0 = u.pn * BM + wc * 32 + 8 * fq, pn = u.pn;
#pragma unroll
        for (int ai = 0; ai < 2; ++ai)
#pragma unroll
            for (int m = 0; m < 4; ++m) { const int row = row0 + ai * HALF + m * 16, b = row >> 11, t = row & 2047;
#pragma unroll
                for (int bj = 0; bj < 2; ++bj) { const int col = col0 + bj * HALF; bf16_t* dst; bool ok = true;
                    if (pn < 4) dst = base + ((size_t)(b * 16 + (col >> 6)) * 2048 + t) * 64 + (col & 63);
                    else if (pn < 10) dst = base + o_xbc + (size_t)row * 1536 + (col - 1024);
                    else if (pn < 22) { const int cc = col - 2560; dst = base + o_rkvh + ((size_t)(b * 16 + ((cc & 1023) >> 6)) * 2048 + t) * 192 + (cc >> 10) * 64 + (cc & 63); }
                    else { const int cc = col - 5632; ok = cc < 320; dst = base + o_smb + (size_t)row * 320 + cc; }
                    const f32x4 v0 = acc[ai][bj][m][0], v1 = acc[ai][bj][m][1];
                    u32x4 w; w.x = cvt_pk_bf16(v0[0], v0[1]); w.y = cvt_pk_bf16(v0[2], v0[3]); w.z = cvt_pk_bf16(v1[0], v1[1]); w.w = cvt_pk_bf16(v1[2], v1[3]);
                    if (ok) *(u32x4*)dst = w; } }
    }
};
struct EpiRoute1 {
    static constexpr bool PERM = true, AFTER_DRAIN = false;
    bf16_t* base; size_t o_vh, o_gb; const int* pos;
    __device__ __forceinline__ void operator()(const f32x4 (&acc)[2][2][4][2], const Unit& u, int wr, int wc, int fr, int fq) const {
        const int row0 = u.pm * BM + wr * 64 + fr, col0 = u.pn * BM + wc * 32 + 8 * fq, pn = u.pn;
        const bool rot = pn < 8; const float sc = pn >= 4 ? 0.0625f : 1.0f;
        float frq[2][4];
#pragma unroll
        for (int bj = 0; bj < 2; ++bj)
#pragma unroll
            for (int q = 0; q < 4; ++q) frq[bj][q] = __builtin_amdgcn_exp2f((float)((((col0 + bj * HALF) & 255) >> 1) + q) * (-13.287712379549449f / 127.0f)) * 0.15915494309189535f;
#pragma unroll
        for (int ai = 0; ai < 2; ++ai)
#pragma unroll
            for (int m = 0; m < 4; ++m) { const int row = row0 + ai * HALF + m * 16, b = row >> 11, t = row & 2047; const float ps = rot ? (float)pos[row] : 0.f;
#pragma unroll
                for (int bj = 0; bj < 2; ++bj) { const int col = col0 + bj * HALF; f32x4 v0 = acc[ai][bj][m][0], v1 = acc[ai][bj][m][1]; bf16_t* dst;
                    if (rot) { const int cc = col & 1023;
                        float cs_[8];
#pragma unroll
                        for (int q = 0; q < 4; ++q) { const float rev = __builtin_amdgcn_fractf(ps * frq[bj][q]); cs_[2 * q] = __builtin_amdgcn_cosf(rev); cs_[2 * q + 1] = __builtin_amdgcn_sinf(rev); }
                        const f32x4 c01 = (f32x4){cs_[0], cs_[1], cs_[2], cs_[3]}, c23 = (f32x4){cs_[4], cs_[5], cs_[6], cs_[7]};
                        const f32x4 r0 = (f32x4){v0[0] * c01[0] - v0[1] * c01[1], v0[1] * c01[0] + v0[0] * c01[1], v0[2] * c01[2] - v0[3] * c01[3], v0[3] * c01[2] + v0[2] * c01[3]};
                        const f32x4 r1 = (f32x4){v1[0] * c23[0] - v1[1] * c23[1], v1[1] * c23[0] + v1[0] * c23[1], v1[2] * c23[2] - v1[3] * c23[3], v1[3] * c23[2] + v1[2] * c23[3]};
                        v0 = r0 * sc; v1 = r1 * sc;
                        dst = base + ((size_t)(b * 4 + (cc >> 8)) * 2048 + t) * 512 + (pn >> 2) * 256 + (cc & 255); }
                    else if (pn < 16) { const int cc = col - 2048; dst = base + o_vh + ((size_t)((b * 4 + (cc >> 9)) * 4 + ((cc & 511) >> 7)) * 2048 + t) * 128 + (cc & 127); }
                    else dst = base + o_gb + (size_t)row * 2048 + (col - 4096);
                    u32x4 w; w.x = cvt_pk_bf16(v0[0], v0[1]); w.y = cvt_pk_bf16(v0[2], v0[3]); w.z = cvt_pk_bf16(v1[0], v1[1]); w.w = cvt_pk_bf16(v1[2], v1[3]);
                    *(u32x4*)dst = w; } }
    }
};
struct EpiSwiGLU {
    static constexpr bool PERM = true, AFTER_DRAIN = false;
    bf16_t* H; int ldc;
    __device__ __forceinline__ void operator()(const f32x4 (&acc)[2][2][4][2], const Unit& u, int wr, int wc, int fr, int fq) const {
        const int row0 = u.pm * BM + wr * 64 + fr, col0 = u.pn * HALF + wc * 32 + 8 * fq;
#pragma unroll
        for (int ai = 0; ai < 2; ++ai)
#pragma unroll
            for (int m = 0; m < 4; ++m) { bf16_t* rowp = H + (size_t)(row0 + ai * HALF + m * 16) * ldc + col0;
                float o[8];
#pragma unroll
                for (int n = 0; n < 2; ++n)
#pragma unroll
                    for (int j = 0; j < 4; ++j) o[n * 4 + j] = silu_f(acc[ai][0][m][n][j]) * acc[ai][1][m][n][j];
                u32x4 w; w.x = cvt_pk_bf16(o[0], o[1]); w.y = cvt_pk_bf16(o[2], o[3]); w.z = cvt_pk_bf16(o[4], o[5]); w.w = cvt_pk_bf16(o[6], o[7]);
                __builtin_nontemporal_store(w, (u32x4*)rowp); }
    }
};
struct EpiSlab {
    static constexpr bool PERM = true, AFTER_DRAIN = false;
    float* slab; int ldc, nslice;
    __device__ __forceinline__ void operator()(const f32x4 (&acc)[2][2][4][2], const Unit& u, int wr, int wc, int fr, int fq) const {
        float* base = slab + (size_t)(u.pm * nslice + u.ks) * BM * ldc + (size_t)(wr * 64 + fr) * ldc + u.pn * BM + wc * 32 + 8 * fq;
#pragma unroll
        for (int ai = 0; ai < 2; ++ai)
#pragma unroll
            for (int m = 0; m < 4; ++m) { float* rowp = base + (size_t)(ai * HALF + m * 16) * ldc;
#pragma unroll
                for (int bj = 0; bj < 2; ++bj) { *(f32x4*)(rowp + bj * HALF) = acc[ai][bj][m][0]; *(f32x4*)(rowp + bj * HALF + 4) = acc[ai][bj][m][1]; } }
    }
};
struct EpiMoeOut {
    static constexpr bool PERM = true, AFTER_DRAIN = false;
    bf16_t* Y0; bf16_t* Y1; int ldc; int nhalf; const int* rowdst; const float* rowp;
    __device__ __forceinline__ void operator()(const f32x4 (&acc)[2][2][4][2], const Unit& u, int wr, int wc, int fr, int fq) const {
        const int row0 = u.pm * BM + wr * 64 + fr, col0 = u.pn * BM + wc * 32 + 8 * fq;
#pragma unroll
        for (int ai = 0; ai < 2; ++ai)
#pragma unroll
            for (int m = 0; m < 4; ++m) { const int slot = row0 + ai * HALF + m * 16; const int dst = rowdst[slot]; const float p = rowp[slot];
                if (dst >= 0) { bf16_t* rowpt = (dst >= nhalf ? Y1 + (size_t)(dst - nhalf) * ldc : Y0 + (size_t)dst * ldc) + col0;
#pragma unroll
                    for (int bj = 0; bj < 2; ++bj) { const f32x4 v0 = acc[ai][bj][m][0] * p, v1 = acc[ai][bj][m][1] * p;
                        u32x4 w; w.x = cvt_pk_bf16(v0[0], v0[1]); w.y = cvt_pk_bf16(v0[2], v0[3]); w.z = cvt_pk_bf16(v1[0], v1[1]); w.w = cvt_pk_bf16(v1[2], v1[3]);
                        *(u32x4*)(rowpt + bj * HALF) = w; } }
                asm volatile("" ::: "memory"); }
    }
};

template <class Epi, class Sched, bool ALIGN_EPI, bool GATHER>
__device__ __forceinline__ void gemm_phase(PG8_LAS unsigned char* lds, const bf16_t* Abase, int lda, int ldb, int K, const Sched& S, const Epi& E) {
    const int tid = threadIdx.x, wid = __builtin_amdgcn_readfirstlane(tid >> 6), lane = tid & 63, wr = wid >> 2, wc = wid & 3, fr = lane & 15, fq = lane >> 4;
    const int nt = K / BK;
    int RA[2], CA[2]; unsigned voffB[2];
#pragma unroll
    for (int i = 0; i < 2; ++i) { int R, C; stage_rc(tid * 16 + i * 8192, R, C); const int Rb = Epi::PERM ? ((R & ~31) + perm32(R & 31)) : R;
        RA[i] = R; CA[i] = C; voffB[i] = (unsigned)(Rb * ldb + C) * 2u; }
    const size_t kstep = (size_t)(BK * 2);
    const size_t hstepB = (size_t)HALF * ldb * 2;
    const size_t tstepA = (size_t)BM * lda * 2;
    const unsigned ldsw = (unsigned)wid * 1024u;
    const int aoff = lds_byte(wr * 64 + fr, fq * 8), boff = lds_byte(wc * 32 + fr, fq * 8);
#define PG8_SA(b, h) (((b) * 2 + (h)) * HTB)
#define PG8_SB(b, h) ((4 + (b) * 2 + (h)) * HTB)
#define PG8_STAGE(bufoff, gbase, voff) do { _Pragma("unroll") for (int _i = 0; _i < 2; ++_i) \
        __builtin_amdgcn_global_load_lds((const unsigned*)((const char*)(gbase) + (voff)[_i]), (PG8_LAS unsigned*)(lds + (bufoff) + ldsw + _i * 8192), 16, 0, 0); } while (0)
#define PG8_LDA(dst, b, h) do { _Pragma("unroll") for (int m = 0; m < 4; ++m) _Pragma("unroll") for (int k = 0; k < 2; ++k) dst[m][k] = *(const PG8_LAS bf16x8*)(lds + PG8_SA(b, h) + aoff + m * 2048 + k * 1024); } while (0)
#define PG8_LDB(dst, b, h) do { _Pragma("unroll") for (int n = 0; n < 2; ++n) _Pragma("unroll") for (int k = 0; k < 2; ++k) dst[n][k] = *(const PG8_LAS bf16x8*)(lds + PG8_SB(b, h) + boff + n * 2048 + k * 1024); } while (0)
#define PG8_MMA(ai, bj, At, Bt) do { __builtin_amdgcn_s_setprio(1); _Pragma("unroll") for (int m = 0; m < 4; ++m) _Pragma("unroll") for (int n = 0; n < 2; ++n) _Pragma("unroll") for (int k = 0; k < 2; ++k) \
        acc[ai][bj][m][n] = __builtin_amdgcn_mfma_f32_16x16x32_bf16(Bt[n][k], At[m][k], acc[ai][bj][m][n], 0, 0, 0); __builtin_amdgcn_s_setprio(0); } while (0)
#define PG8_WAIT_V(n) asm volatile("s_waitcnt vmcnt(" #n ")" ::: "memory")
#define PG8_WAIT_L(n) asm volatile("s_waitcnt lgkmcnt(" #n ")" ::: "memory")
#define PG8_BAR __builtin_amdgcn_s_barrier()
#define PG8_SCHED __builtin_amdgcn_sched_barrier(0)
    Unit cur, nxt; int ui = 0;
    if (!S.next(0, cur)) return;
    f32x4 acc[2][2][4][2];
#pragma unroll
    for (int a = 0; a < 2; ++a)
#pragma unroll
        for (int b = 0; b < 2; ++b)
#pragma unroll
            for (int m = 0; m < 4; ++m)
#pragma unroll
                for (int n = 0; n < 2; ++n) acc[a][b][m][n] = (f32x4){0.f, 0.f, 0.f, 0.f};
    bf16x8 At[4][2], B0[2][2], B1[2][2];
    unsigned vA[2][2];
    int knt = cur.knt ? cur.knt : nt;
    const char* cA; const char* cB = S.b_base(cur) + (size_t)cur.kt0 * kstep;
    PG8_LAS int* const rowslot = (PG8_LAS int*)(lds + STAGE_BYTES + 4096);
#define PG8_ROWS_DMA(slot, rows) do { if (wid < 4) __builtin_amdgcn_global_load_lds((const unsigned*)((rows) + tid), (PG8_LAS unsigned*)(rowslot + (slot) * 256 + wid * 64), 4, 0, 0); } while (0)
#define PG8_GOFF(dst, slot) do { _Pragma("unroll") for (int _h = 0; _h < 2; ++_h) _Pragma("unroll") for (int _i = 0; _i < 2; ++_i) dst[_h][_i] = (unsigned)(rowslot[(slot) * 256 + _h * HALF + RA[_i]] * lda + CA[_i]) * 2u; } while (0)
    if constexpr (GATHER) { cA = (const char*)Abase + (size_t)cur.kt0 * kstep; PG8_ROWS_DMA(0, S.a_rows(cur)); PG8_WAIT_V(0); PG8_BAR; PG8_GOFF(vA, 0); }
    else { cA = (const char*)Abase + (size_t)cur.pm * tstepA + (size_t)cur.kt0 * kstep;
#pragma unroll
        for (int h = 0; h < 2; ++h)
#pragma unroll
            for (int i = 0; i < 2; ++i) vA[h][i] = (unsigned)((h * HALF + RA[i]) * lda + CA[i]) * 2u;
    }
    PG8_STAGE(PG8_SB(0, 0), cB, voffB); PG8_STAGE(PG8_SB(0, 1), cB + hstepB, voffB); PG8_STAGE(PG8_SA(0, 0), cA, vA[0]); PG8_STAGE(PG8_SA(0, 1), cA, vA[1]);
    if (wr == 1) PG8_BAR;
    PG8_WAIT_V(2); PG8_BAR;
    PG8_STAGE(PG8_SB(1, 0), cB + kstep, voffB); PG8_STAGE(PG8_SA(1, 0), cA + kstep, vA[0]); PG8_STAGE(PG8_SB(1, 1), cB + hstepB + kstep, voffB);
    PG8_WAIT_V(6); PG8_BAR;
    for (;;) {
        const bool has_next = S.next(ui + 1, nxt);
        const char* nA; const char* nB = has_next ? S.b_base(nxt) + (size_t)nxt.kt0 * kstep : cB;
        if constexpr (GATHER) { nA = has_next ? (const char*)Abase + (size_t)nxt.kt0 * kstep : cA; if (has_next) PG8_ROWS_DMA((ui + 1) & 1, S.a_rows(nxt)); }
        else nA = has_next ? (const char*)Abase + (size_t)nxt.pm * tstepA + (size_t)nxt.kt0 * kstep : cA;
        for (int t = 0; t < knt; t += 2) {
            const bool last = (t == knt - 2);
            const char* a1 = cA + (size_t)(t + 1) * kstep;
            const char* a2 = last ? nA : cA + (size_t)(t + 2) * kstep; const char* b2 = last ? nB : cB + (size_t)(t + 2) * kstep;
            const char* a3 = a2 + kstep; const char* b3 = b2 + kstep;
            unsigned v2[2][2];
            if constexpr (GATHER) { if (last && has_next) PG8_GOFF(v2, (ui + 1) & 1); else PG8_GOFF(v2, ui & 1); PG8_GOFF(vA, ui & 1); }
            else {
#pragma unroll
                for (int h = 0; h < 2; ++h)
#pragma unroll
                    for (int i = 0; i < 2; ++i) v2[h][i] = vA[h][i];
            }
            PG8_LDB(B0, 0, 0); PG8_LDB(B1, 0, 1); PG8_SCHED; PG8_LDA(At, 0, 0); PG8_STAGE(PG8_SA(1, 1), a1, vA[1]);
            PG8_WAIT_V(8); PG8_WAIT_L(0); PG8_BAR; PG8_MMA(0, 0, At, B0); PG8_MMA(0, 1, At, B1); PG8_BAR; PG8_SCHED;
            PG8_LDA(At, 0, 1); PG8_STAGE(PG8_SB(0, 0), b2, voffB); PG8_STAGE(PG8_SB(0, 1), b2 + hstepB, voffB); PG8_STAGE(PG8_SA(0, 0), a2, v2[0]);
            PG8_WAIT_V(8); PG8_WAIT_L(0); PG8_BAR; PG8_MMA(1, 0, At, B0); PG8_MMA(1, 1, At, B1); PG8_BAR; PG8_SCHED;
            PG8_LDB(B0, 1, 0); PG8_LDB(B1, 1, 1); PG8_SCHED; PG8_LDA(At, 1, 0); PG8_STAGE(PG8_SA(0, 1), a2, v2[1]);
            PG8_WAIT_V(8); PG8_WAIT_L(0); PG8_BAR; PG8_MMA(0, 0, At, B0); PG8_MMA(0, 1, At, B1); PG8_BAR; PG8_SCHED;
            PG8_LDA(At, 1, 1); PG8_STAGE(PG8_SB(1, 0), b3, voffB); PG8_STAGE(PG8_SB(1, 1), b3 + hstepB, voffB); PG8_STAGE(PG8_SA(1, 0), a3, v2[0]);
            PG8_WAIT_V(8); PG8_WAIT_L(0); PG8_BAR; PG8_MMA(1, 0, At, B0); PG8_MMA(1, 1, At, B1); PG8_BAR; PG8_SCHED;
        }
        if constexpr (ALIGN_EPI) { if (wr == 0) PG8_BAR; }
        E(acc, cur, wr, wc, fr, fq);
        if (!has_next) break;
#pragma unroll
        for (int a = 0; a < 2; ++a)
#pragma unroll
            for (int b = 0; b < 2; ++b)
#pragma unroll
                for (int m = 0; m < 4; ++m)
#pragma unroll
                    for (int n = 0; n < 2; ++n) acc[a][b][m][n] = (f32x4){0.f, 0.f, 0.f, 0.f};
        cur = nxt; cA = nA; cB = nB; ++ui; knt = cur.knt ? cur.knt : nt;
        if constexpr (ALIGN_EPI) { if (wr == 1) PG8_BAR; }
    }
    PG8_WAIT_V(0);
    if constexpr (!ALIGN_EPI) { if (wr == 0) PG8_BAR; }
    PG8_BAR;
#undef PG8_SA
#undef PG8_SB
#undef PG8_STAGE
#undef PG8_LDA
#undef PG8_LDB
#undef PG8_MMA
#undef PG8_WAIT_V
#undef PG8_WAIT_L
#undef PG8_BAR
#undef PG8_SCHED
#undef PG8_ROWS_DMA
#undef PG8_GOFF
}
}

constexpr int NWAVES = 8, NTHR = 512;
constexpr int BATCH = 16, SEQ = 2048, DM = 1024, MTOK = BATCH * SEQ;
constexpr int PW = 6144;
constexpr int DFF = 3584, NEXP = 8;
constexpr int MOE_P1 = 128, MOE_ROWS = (MTOK * 2 / 256 - MOE_P1 + NEXP) * 256, MOE_SLOTS = MTOK * 2 + NEXP * 256;
constexpr float ALPHA = 1.4142135623730951f;
constexpr float LN_EPS = 1e-5f;
constexpr int PC_Z = 0, PC_XBC = 1024, PC_RKV = 2560, PC_SM = 5632, PC_DT = 5920;
constexpr size_t L0_ZH = 0, L0_XBC = (size_t)MTOK * 1024, L0_RKVH = (size_t)MTOK * 2560, L0_SMB = (size_t)MTOK * 5632;
constexpr size_t L1_QKH = 0, L1_VH = (size_t)MTOK * 2048, L1_GB = (size_t)MTOK * 4096;

constexpr size_t MiB = 1u << 20;
constexpr size_t WS_CTL = 0, CTL_ZERO_BYTES = 1 * MiB;
constexpr size_t WS_W0IN = 1 * MiB, WS_W0OUT = 13 * MiB, WS_W0GU = 17 * MiB, WS_W0D = 31 * MiB, WS_W1IN = 38 * MiB, WS_W1OUT = 50 * MiB;
constexpr size_t WS_XB = 54 * MiB;
constexpr size_t WS_P = 118 * MiB;
constexpr size_t WS_X1 = 118 * MiB;
constexpr size_t WS_HID = 246 * MiB;
constexpr size_t WS_H = 502 * MiB;
constexpr size_t WS_MOED = 118 * MiB;
constexpr size_t WS_Y0 = 174 * MiB, WS_Y1 = 238 * MiB, WS_MHID = 302 * MiB;
constexpr size_t WS_CS = 1 * MiB;
constexpr size_t WS_SLAB = 1 * MiB;
constexpr int MOE_TAIL0 = 256, MOE_KS = 4;
constexpr size_t WS_TAB = 34 * MiB;
constexpr size_t TAB_E = 0, TAB_P = 128 * 1024, TAB_POS = 256 * 1024, TAB_ROWTOK = 512 * 1024, TAB_ROWDST = 1024 * 1024, TAB_ROWP = 1536 * 1024;
constexpr size_t WS_END = 566 * MiB;
constexpr int CW_TMO = 0, CW_BAR = 4096, CW_CNT = 8192;

constexpr int RING_BYTES = 131072, MISC_OFF = RING_BYTES + 320, LCNT_OFF = RING_BYTES + 512, PEXP_OFF = RING_BYTES + 1024, LDS_BYTES = 147456;

#define GAS __attribute__((address_space(1)))
#define LAS __attribute__((address_space(3)))
typedef unsigned short bf16;
typedef unsigned v4u __attribute__((ext_vector_type(4)));
typedef unsigned v2u __attribute__((ext_vector_type(2)));
typedef float f32x4 __attribute__((ext_vector_type(4)));
typedef GAS unsigned gu32;
#define RLX_AGENT __ATOMIC_RELAXED, __HIP_MEMORY_SCOPE_AGENT
#define LDS_WAIT() asm volatile("s_waitcnt lgkmcnt(0)" ::: "memory")
__device__ __forceinline__ unsigned f2bf(float f) { unsigned u = __builtin_bit_cast(unsigned, f); return (u + 0x7fffu + ((u >> 16) & 1u)) >> 16; }
__device__ __forceinline__ unsigned pk2(float lo, float hi) { return f2bf(lo) | (f2bf(hi) << 16); }
__device__ __forceinline__ float bf2f(bf16 v) { return __builtin_bit_cast(float, (unsigned)v << 16); }
__device__ __forceinline__ float bflo(unsigned w) { return __builtin_bit_cast(float, w << 16); }
__device__ __forceinline__ float bfhi(unsigned w) { return __builtin_bit_cast(float, w & 0xffff0000u); }
__device__ __forceinline__ float sigmoid_f(float x) { return 1.0f / (1.0f + __expf(-x)); }
__device__ __forceinline__ float silu_f(float x) { return x / (1.0f + __expf(-x)); }
__device__ __forceinline__ float softplus_f(float x) { return x > 20.f ? x : log1pf(__expf(x)); }
__device__ __forceinline__ float wave_sum(float v) {
    v += __builtin_bit_cast(float, __builtin_amdgcn_update_dpp(0, __builtin_bit_cast(int, v), 0x128, 0xf, 0xf, true));
    v += __builtin_bit_cast(float, __builtin_amdgcn_update_dpp(0, __builtin_bit_cast(int, v), 0x124, 0xf, 0xf, true));
    v += __builtin_bit_cast(float, __builtin_amdgcn_update_dpp(0, __builtin_bit_cast(int, v), 0x122, 0xf, 0xf, true));
    v += __builtin_bit_cast(float, __builtin_amdgcn_update_dpp(0, __builtin_bit_cast(int, v), 0x121, 0xf, 0xf, true));
    const float r0 = __builtin_bit_cast(float, __builtin_amdgcn_readlane(__builtin_bit_cast(int, v), 0)), r1 = __builtin_bit_cast(float, __builtin_amdgcn_readlane(__builtin_bit_cast(int, v), 16));
    const float r2 = __builtin_bit_cast(float, __builtin_amdgcn_readlane(__builtin_bit_cast(int, v), 32)), r3 = __builtin_bit_cast(float, __builtin_amdgcn_readlane(__builtin_bit_cast(int, v), 48));
    return (r0 + r1) + (r2 + r3);
}

#define LDS_BARRIER() asm volatile("s_waitcnt lgkmcnt(0)\n\ts_barrier" ::: "memory")
#define XB_TMO      128
#define XB_XCNT(j)  (256  + 64 * (j))
#define XB_XSUB(j)  (1280 + 64 * (j))
#define XB_XGEN(j)  (2304 + 64 * (j))
#define XB_TOP      3328
#define XB_TOPGEN   3392
#define XCD_BAR_WORDS 3456
#define XB_SPIN_CAP (1u << 18)
__device__ __forceinline__ unsigned xb_ld(unsigned* p)              { return __hip_atomic_load(p, __ATOMIC_RELAXED, __HIP_MEMORY_SCOPE_AGENT); }
__device__ __forceinline__ unsigned xb_add(unsigned* p, unsigned v) { return __hip_atomic_fetch_add(p, v, __ATOMIC_RELAXED, __HIP_MEMORY_SCOPE_AGENT); }
__device__ __forceinline__ unsigned xb_xcc_id() { return (unsigned)__builtin_amdgcn_s_getreg((3 << 11) | 20) & 0xFu; }
#define XB_SPIN(cond, bar) do { unsigned _sp = 0; while (cond) { __builtin_amdgcn_s_sleep(1); \
    if ((++_sp & 255u) == 0u) { if (xb_ld(&(bar)[XB_TMO])) break; if (_sp > XB_SPIN_CAP) { atomicAdd(&(bar)[XB_TMO], 1u); break; } } } } while (0)
struct XcdBarrier { unsigned* bar; unsigned x; volatile LAS unsigned* st; };
__device__ __forceinline__ XcdBarrier xcd_barrier_post(unsigned* bar, volatile LAS unsigned* st) {
    XcdBarrier b; b.bar = bar; b.x = xb_xcc_id(); b.st = st;
    if (threadIdx.x == 0) (void)xb_add(&bar[XB_XCNT(b.x)], 1u);
    return b;
}
__device__ __forceinline__ void xcd_barrier_complete(unsigned* bar, unsigned x, unsigned& nloc, unsigned& nx) {
    const unsigned G = gridDim.x * gridDim.y * gridDim.z;
    unsigned sum, cnt, mine, sp = 0u;
    for (;;) {
        sum = 0u; cnt = 0u; mine = 0u;
#pragma unroll
        for (unsigned j = 0; j < 16; ++j) { const unsigned c = xb_ld(&bar[XB_XCNT(j)]); sum += c; cnt += (c > 0u) ? 1u : 0u; mine = (j == x) ? c : mine; }
        if (sum == G) break;
        __builtin_amdgcn_s_sleep(1);
        if ((++sp & 255u) == 0u) { if (xb_ld(&bar[XB_TMO])) break; if (sp > XB_SPIN_CAP) { atomicAdd(&bar[XB_TMO], 1u); break; } }
    }
    nloc = mine > 0u ? mine : 1u; nx = cnt > 0u ? cnt : 1u;
}
__device__ __forceinline__ void xcd_barrier(const XcdBarrier& b) {
    asm volatile("s_waitcnt vmcnt(0)" ::: "memory");
    __syncthreads();
    if (threadIdx.x == 0) {
        unsigned* bar = b.bar;
        __builtin_amdgcn_s_waitcnt(0);
        unsigned nloc = b.st[0], nx = b.st[1];
        if (nloc == 0u) { xcd_barrier_complete(bar, b.x, nloc, nx); b.st[0] = nloc; b.st[1] = nx; }
        const unsigned old = xb_add(&bar[XB_XSUB(b.x)], 1u);
        const unsigned gen = old / nloc;
        if (old + 1u == (gen + 1u) * nloc) {
            __builtin_amdgcn_fence(__ATOMIC_RELEASE, "agent");
            asm volatile("s_waitcnt vmcnt(0)" ::: "memory");
            const unsigned og = xb_add(&bar[XB_TOP], 1u);
            const unsigned tg = og / nx;
            if (og + 1u == (tg + 1u) * nx) xb_add(&bar[XB_TOPGEN], 1u);
            else XB_SPIN(xb_ld(&bar[XB_TOPGEN]) == tg, bar);
            __builtin_amdgcn_fence(__ATOMIC_ACQUIRE, "agent");
            xb_add(&bar[XB_XGEN(b.x)], 1u);
            asm volatile("s_waitcnt vmcnt(0)" ::: "memory");
        } else {
            XB_SPIN(xb_ld(&bar[XB_XGEN(b.x)]) == gen, bar);
            __builtin_amdgcn_fence(__ATOMIC_ACQUIRE, "agent");
            asm volatile("s_waitcnt vmcnt(0)" ::: "memory");
        }
    }
    __syncthreads();
}

struct Args { const void* in[38]; float* out; unsigned char* ws; int ph_lo, ph_hi; };
enum { I_X = 0, I_POS, I_EV_WIN, I_CONVW, I_CONVB, I_DTB, I_ALOG, I_DSKIP, I_MNORM, I_MU, I_W0, I_WUP, I_A0, I_AUP, I_GUP, I_KK, I_KA, I_RK, I_RLNW, I_RLNB, I_EV_WOUT,
       I_EV_LN1G, I_EV_LN1B, I_FFN_WG, I_FFN_WU, I_FFN_WD, I_EV_LN2G, I_EV_LN2B, I_OD_WIN, I_OD_WOUT, I_OD_LN1G, I_OD_LN1B, I_ROUTER, I_MOE_WG, I_MOE_WU, I_MOE_WD, I_OD_LN2G, I_OD_LN2B };

struct Frame {
    LAS unsigned char* lds;
    int tid, lane, wave, G, bid;
};

template <int TYPE>
__device__ __forceinline__ void transpose_job(const float* W, const float* W2, int ldw, int K, bf16* WT, int nrows, LAS float* scr_f, int gw, int NGW, int lane) {
    LAS unsigned char* scr = (LAS unsigned char*)scr_f;
    const int nblk = nrows / 64, nitems = (K / 64) * nblk;
    const int l16 = lane & 15, lq = lane >> 4;
    for (int item = gw; item < nitems; item += NGW) {
        const int kb = item / nblk, nb = item % nblk, k0 = 64 * kb, n0 = 64 * nb;
        const int np = n0 + 4 * l16;
        const float* src = W; int col = np;
        if (TYPE == 1) { if (np < 2560) col = np; else if (np < 5920) col = np + 16; else if (np < 5936) col = 2560 + (np - 5920); else col = -1; }
        if (TYPE == 2) { const int pn = np >> 8, j = np & 255; if (j < 128) col = 128 * pn + j; else { src = W2; col = 128 * pn + j - 128; } }
#pragma unroll
        for (int i = 0; i < 8; ++i) { const int kk = 8 * i + 2 * lq;
            f32x4 va = (f32x4){0.f, 0.f, 0.f, 0.f}, vb = va;
            if (col >= 0) { va = __builtin_nontemporal_load((const f32x4*)(src + (size_t)(k0 + kk) * ldw + col)); vb = __builtin_nontemporal_load((const f32x4*)(src + (size_t)(k0 + kk + 1) * ldw + col)); }
#pragma unroll
            for (int j = 0; j < 4; ++j) *(LAS unsigned*)(scr + (4 * l16 + j) * 136 + kk * 2) = pk2(va[j], vb[j]); }
        LDS_WAIT(); asm volatile("" ::: "memory");
#pragma unroll
        for (int j = 0; j < 8; ++j) { const int ch = lane + 64 * j, n = ch >> 3, kc = ch & 7;
            const v2u lo = *(const LAS v2u*)(scr + n * 136 + kc * 16), hi = *(const LAS v2u*)(scr + n * 136 + kc * 16 + 8);
            *(v4u*)(WT + (size_t)(n0 + n) * K + k0 + 8 * kc) = (v4u){lo.x, lo.y, hi.x, hi.y}; }
        LDS_WAIT(); asm volatile("" ::: "memory");
    }
}

template <bool ROUTER, bool MOE_COMBINE, bool CSTAB = false>
__device__ __forceinline__ void ln_rows(const Frame& F, const float* xi, const bf16* xib, const bf16* hb, const bf16* hb2, const float* gam, const float* bet, float* xo, bf16* xbo,
                                        int row_lo, int row_hi, const float* wr, unsigned* cnt, int* tok_e, float* tok_p, int* tok_pos, const int* positions = nullptr, float* cstab = nullptr, const float* slab = nullptr) {
    const int gw = F.bid * NWAVES + F.wave, NGW = F.G * NWAVES, lane = F.lane;
    float invf0 = 0.f, invf1 = 0.f;
    if (CSTAB) { invf0 = (float)pow(10000.0, -(double)lane / 127.0); invf1 = (float)pow(10000.0, -(double)(lane + 64) / 127.0); }
    f32x4 gv[4], bv[4];
#pragma unroll
    for (int j = 0; j < 4; ++j) { gv[j] = *(const f32x4*)(gam + 4 * lane + 256 * j); bv[j] = *(const f32x4*)(bet + 4 * lane + 256 * j); }
    float mylg[8] = {0.f, 0.f, 0.f, 0.f, 0.f, 0.f, 0.f, 0.f};
    f32x4 rw0[16], rw1[16];
    if (ROUTER) {
#pragma unroll
        for (int j = 0; j < 4; ++j)
#pragma unroll
            for (int q = 0; q < 4; ++q) { const int c = 4 * lane + 256 * j + q; rw0[4 * j + q] = *(const f32x4*)(wr + c * 8); rw1[4 * j + q] = *(const f32x4*)(wr + c * 8 + 4); }
    }
    for (int row = row_lo + gw; row < row_hi; row += NGW) {
        f32x4 v[4]; float s = 0.f;
        int s0_ = 0, s1_ = 0; float p0_ = 0.f;
        if (MOE_COMBINE) { s0_ = __builtin_amdgcn_readfirstlane(tok_pos[2 * row]); s1_ = __builtin_amdgcn_readfirstlane(tok_pos[2 * row + 1]); if (s0_ >= MOE_TAIL0 * 256 || s1_ >= MOE_TAIL0 * 256) p0_ = tok_p[row]; }
#pragma unroll
        for (int j = 0; j < 4; ++j) {
            f32x4 x;
            if (xi) x = *(const f32x4*)(xi + (size_t)row * DM + 4 * lane + 256 * j);
            else { const v2u xw = *(const v2u*)(xib + (size_t)row * DM + 4 * lane + 256 * j); x = (f32x4){bflo(xw.x), bfhi(xw.x), bflo(xw.y), bfhi(xw.y)}; }
            const size_t hrow = MOE_COMBINE ? (size_t)(row - row_lo) : (size_t)row;
            const v2u hw = *(const v2u*)(hb + hrow * DM + 4 * lane + 256 * j);
            f32x4 h = (f32x4){bflo(hw.x), bfhi(hw.x), bflo(hw.y), bfhi(hw.y)};
            if (MOE_COMBINE) {
                if (s0_ >= MOE_TAIL0 * 256) { const float* sp = slab + ((size_t)((s0_ >> 8) - MOE_TAIL0) * MOE_KS * 256 + (s0_ & 255)) * DM + 4 * lane + 256 * j; f32x4 a = *(const f32x4*)sp;
#pragma unroll
                    for (int q = 1; q < MOE_KS; ++q) a += *(const f32x4*)(sp + (size_t)q * 256 * DM);
                    h = a * p0_; }
                f32x4 hh;
                if (s1_ >= MOE_TAIL0 * 256) { const float* sp = slab + ((size_t)((s1_ >> 8) - MOE_TAIL0) * MOE_KS * 256 + (s1_ & 255)) * DM + 4 * lane + 256 * j; f32x4 a = *(const f32x4*)sp;
#pragma unroll
                    for (int q = 1; q < MOE_KS; ++q) a += *(const f32x4*)(sp + (size_t)q * 256 * DM);
                    hh = a * (1.f - p0_); }
                else { const v2u h2 = *(const v2u*)(hb2 + hrow * DM + 4 * lane + 256 * j); hh = (f32x4){bflo(h2.x), bfhi(h2.x), bflo(h2.y), bfhi(h2.y)}; }
                h += hh; }
            v[j] = x * ALPHA + h; s += (v[j].x + v[j].y) + (v[j].z + v[j].w);
        }
        const float mean = wave_sum(s) * (1.f / DM); float s2 = 0.f;
#pragma unroll
        for (int j = 0; j < 4; ++j) { v[j] = v[j] - mean; s2 += (v[j].x * v[j].x + v[j].y * v[j].y) + (v[j].z * v[j].z + v[j].w * v[j].w); }
        const float rstd = 1.f / sqrtf(wave_sum(s2) * (1.f / DM) + LN_EPS);
#pragma unroll
        for (int j = 0; j < 4; ++j) { v[j] = v[j] * rstd * gv[j] + bv[j];
            if (xo) *(f32x4*)(xo + (size_t)row * DM + 4 * lane + 256 * j) = v[j];
            if (xbo) { v2u w; w.x = pk2(v[j].x, v[j].y); w.y = pk2(v[j].z, v[j].w); *(v2u*)(xbo + (size_t)row * DM + 4 * lane + 256 * j) = w; } }
        if (CSTAB) { const float pos = (float)positions[row]; float sn, cs_; typedef float f32x2v __attribute__((ext_vector_type(2)));
            sincosf(pos * invf0, &sn, &cs_); *(f32x2v*)(cstab + ((size_t)row * 128 + lane) * 2) = (f32x2v){cs_, sn};
            sincosf(pos * invf1, &sn, &cs_); *(f32x2v*)(cstab + ((size_t)row * 128 + lane + 64) * 2) = (f32x2v){cs_, sn}; }
        if (ROUTER) {
            float lg[8];
#pragma unroll
            for (int e = 0; e < 8; ++e) lg[e] = 0.f;
#pragma unroll
            for (int j = 0; j < 4; ++j)
#pragma unroll
                for (int q = 0; q < 4; ++q) { const f32x4 w0 = rw0[4 * j + q], w1 = rw1[4 * j + q]; const float xv = v[j][q];
                    lg[0] += xv * w0.x; lg[1] += xv * w0.y; lg[2] += xv * w0.z; lg[3] += xv * w0.w; lg[4] += xv * w1.x; lg[5] += xv * w1.y; lg[6] += xv * w1.z; lg[7] += xv * w1.w; }
            {
                float a4[4];
#pragma unroll
                for (int e = 0; e < 4; ++e) { const float mine = (lane & 32) ? lg[4 + e] : lg[e], send = (lane & 32) ? lg[e] : lg[4 + e]; a4[e] = mine + __shfl_xor(send, 32); }
                float a2[2];
#pragma unroll
                for (int e = 0; e < 2; ++e) { const float mine = (lane & 16) ? a4[2 + e] : a4[e], send = (lane & 16) ? a4[e] : a4[2 + e]; a2[e] = mine + __shfl_xor(send, 16); }
                float a1; { const float mine = (lane & 8) ? a2[1] : a2[0], send = (lane & 8) ? a2[0] : a2[1]; a1 = mine + __shfl_xor(send, 8); }
                a1 += __shfl_xor(a1, 4); a1 += __shfl_xor(a1, 2); a1 += __shfl_xor(a1, 1);
#pragma unroll
                for (int e = 0; e < 8; ++e) lg[e] = __shfl(a1, ((e >> 2) & 1) * 32 + ((e >> 1) & 1) * 16 + (e & 1) * 8);
            }
            const int it_ = (row - row_lo - gw) / NGW;
#pragma unroll
            for (int e = 0; e < 8; ++e) mylg[e] = (lane == it_) ? lg[e] : mylg[e];
        }
    }
    if (ROUTER) {
        LAS unsigned* lc = (LAS unsigned*)(F.lds + LCNT_OFF);
        const int row = row_lo + gw + lane * NGW; const bool act = row < row_hi;
        int i0 = 0, i1 = -1, pos0 = 0, pos1 = 0;
        if (act) { float v0 = mylg[0];
#pragma unroll
            for (int e = 1; e < 8; ++e) if (mylg[e] > v0) { v0 = mylg[e]; i0 = e; }
            float v1 = -3.0e38f;
#pragma unroll
            for (int e = 0; e < 8; ++e) if (e != i0 && mylg[e] > v1) { v1 = mylg[e]; i1 = e; }
            pos0 = (int)__hip_atomic_fetch_add(lc + i0, 1u, __ATOMIC_RELAXED, __HIP_MEMORY_SCOPE_WORKGROUP); pos1 = (int)__hip_atomic_fetch_add(lc + i1, 1u, __ATOMIC_RELAXED, __HIP_MEMORY_SCOPE_WORKGROUP);
            tok_e[row] = i0 | (i1 << 8); tok_p[row] = 1.f / (1.f + __expf(v1 - v0)); }
        __syncthreads();
        if (F.tid < 8) lc[16 + F.tid] = __hip_atomic_fetch_add(cnt + F.tid, lc[F.tid], RLX_AGENT);
        __syncthreads();
        if (act) { tok_pos[2 * row] = pos0 + (int)lc[16 + i0]; tok_pos[2 * row + 1] = pos1 + (int)lc[16 + i1]; }
    }
}

typedef short bf16x8 __attribute__((ext_vector_type(8)));
typedef short s16x4 __attribute__((ext_vector_type(4)));
typedef __attribute__((address_space(3))) const unsigned char* lds_cptr;
__device__ __forceinline__ s16x4 lds_tr(lds_cptr p) { return __builtin_bit_cast(s16x4, __builtin_amdgcn_ds_read_tr16_b64_v4i16((LAS s16x4*)p)); }
__device__ __forceinline__ bf16x8 cat8(s16x4 lo, s16x4 hi) { return (bf16x8){lo[0], lo[1], lo[2], lo[3], hi[0], hi[1], hi[2], hi[3]}; }
typedef float f32x2_t __attribute__((ext_vector_type(2))); typedef __bf16 bf16x2_t __attribute__((ext_vector_type(2)));
__device__ __forceinline__ unsigned cvtpk(float lo, float hi) { f32x2_t v = {lo, hi}; bf16x2_t b = __builtin_convertvector(v, bf16x2_t); return __builtin_bit_cast(unsigned, b); }
__device__ __forceinline__ bf16x8 pack8(f32x4 a, f32x4 b) { v4u w; w.x = cvtpk(a[0], a[1]); w.y = cvtpk(a[2], a[3]); w.z = cvtpk(b[0], b[1]); w.w = cvtpk(b[2], b[3]); return __builtin_bit_cast(bf16x8, w); }
#define MFMA16(a, b, c) __builtin_amdgcn_mfma_f32_16x16x32_bf16(a, b, c, 0, 0, 0)
__device__ __forceinline__ void conv_prepass(const Frame& F, const bf16* P, const float* convw, const float* convb, bf16* XA, bf16* BCA) {
    constexpr int CR = 16;
    const int gt = F.bid * NTHR + F.tid, NGT = F.G * NTHR;
    for (int task = gt; task < (MTOK / CR) * 192; task += NGT) {
        const int cg = task % 192, rb = task / 192, ch = cg * 8, row0 = rb * CR, t0 = row0 & (SEQ - 1);
        float wk[4][8], bias[8], x0[8], x1[8], x2[8];
#pragma unroll
        for (int k = 0; k < 4; ++k) { const f32x4 a = *(const f32x4*)(convw + k * 1536 + ch), b = *(const f32x4*)(convw + k * 1536 + ch + 4);
#pragma unroll
            for (int j = 0; j < 4; ++j) { wk[k][j] = a[j]; wk[k][4 + j] = b[j]; } }
        { const f32x4 a = *(const f32x4*)(convb + ch), b = *(const f32x4*)(convb + ch + 4);
#pragma unroll
            for (int j = 0; j < 4; ++j) { bias[j] = a[j]; bias[4 + j] = b[j]; } }
        const bf16* src = P + L0_XBC + (size_t)row0 * 1536 + ch; const int bb_ = row0 >> 11;
#define CONV_LD(dst, ptr) do { const v4u r_ = *(const v4u*)(ptr); dst[0] = bflo(r_.x); dst[1] = bfhi(r_.x); dst[2] = bflo(r_.y); dst[3] = bfhi(r_.y); dst[4] = bflo(r_.z); dst[5] = bfhi(r_.z); dst[6] = bflo(r_.w); dst[7] = bfhi(r_.w); } while (0)
        if (t0 > 0) { CONV_LD(x0, src - 3 * 1536); CONV_LD(x1, src - 2 * 1536); CONV_LD(x2, src - 1536); }
        else {
#pragma unroll
            for (int j = 0; j < 8; ++j) { x0[j] = 0.f; x1[j] = 0.f; x2[j] = 0.f; } }
        const int cc_ = ch - 1024;
        bf16* dst = ch < 1024 ? XA + ((size_t)(bb_ * 16 + (ch >> 6)) * 2048 + t0) * 64 + (ch & 63) : BCA + ((size_t)(bb_ * 2 + ((cc_ & 255) >> 7)) * 2048 + t0) * 256 + (cc_ >> 8) * 128 + (cc_ & 127);
        const int dpitch = ch < 1024 ? 64 : 256;
#pragma unroll 4
        for (int r = 0; r < CR; ++r) {
            float cur[8], o[8]; CONV_LD(cur, src + (size_t)r * 1536);
#pragma unroll
            for (int j = 0; j < 8; ++j) { o[j] = silu_f(bias[j] + wk[0][j] * x0[j] + wk[1][j] * x1[j] + wk[2][j] * x2[j] + wk[3][j] * cur[j]); x0[j] = x1[j]; x1[j] = x2[j]; x2[j] = cur[j]; }
            v4u ow; ow.x = pk2(o[0], o[1]); ow.y = pk2(o[2], o[3]); ow.z = pk2(o[4], o[5]); ow.w = pk2(o[6], o[7]);
            *(v4u*)(dst + (size_t)r * dpitch) = ow;
        }
#undef CONV_LD
    }
}

__device__ __forceinline__ void small_prepass(const Frame& F, const bf16* SMBp, const float* mu, bf16* SMS) {
    const int gt = F.bid * NTHR + F.tid, NGT = F.G * NTHR;
    for (int idx = gt; idx < MTOK * 36; idx += NGT) {
        const int row = idx / 36, j = idx % 36; const bf16* src = SMBp + (size_t)row * 320 + j * 8;
        const v4u cw = *(const v4u*)src; const v4u pw = (row & (SEQ - 1)) ? *(const v4u*)(src - 320) : (v4u){0u, 0u, 0u, 0u};
        const f32x4 m0 = *(const f32x4*)(mu + 3072 + j * 8), m1 = *(const f32x4*)(mu + 3072 + j * 8 + 4);
        const float c_[8] = {bflo(cw.x), bfhi(cw.x), bflo(cw.y), bfhi(cw.y), bflo(cw.z), bfhi(cw.z), bflo(cw.w), bfhi(cw.w)};
        const float p_[8] = {bflo(pw.x), bfhi(pw.x), bflo(pw.y), bfhi(pw.y), bflo(pw.z), bfhi(pw.z), bflo(pw.w), bfhi(pw.w)};
        float v[8];
#pragma unroll
        for (int q = 0; q < 8; ++q) { const float x = c_[q] + (p_[q] - c_[q]) * (q < 4 ? m0[q & 3] : m1[q & 3]);
            v[q] = j < 8 ? 1.f - 2.f * __builtin_amdgcn_rcpf(1.f + __expf(2.f * x)) : (j < 16 ? x : __builtin_amdgcn_rcpf(1.f + __expf(-x))); }
        v4u o; o.x = pk2(v[0], v[1]); o.y = pk2(v[2], v[3]); o.z = pk2(v[4], v[5]); o.w = pk2(v[6], v[7]);
        *(v4u*)(SMS + (size_t)row * 320 + j * 8) = o;
    }
}

__device__ __forceinline__ float wave_scan_incl(float v, int lane) {
#pragma unroll
    for (int o = 1; o < 64; o <<= 1) { const float t = __shfl_up(v, o); if (lane >= o) v += t; }
    return v;
}
__device__ __forceinline__ void ssd_mfma(const Frame& F, const bf16* P, const bf16* XA, const bf16* BCA, const float* dtb, const float* alog, const float* dskip, bf16* mix) {
    constexpr int XST = 144, BST = 272;
    constexpr int XOFF = 0, XWOFF = 128 * XST, BOFF = 2 * 128 * XST, COFF = BOFF + 128 * BST, SOFF = COFF + 128 * BST, DTOFF = SOFF + 64 * BST, ACSOFF = DTOFF + 512;
    static_assert(ACSOFF + 512 <= RING_BYTES, "SSD LDS map");
    LAS unsigned char* const L = F.lds;
    LAS float* const DT = (LAS float*)(L + DTOFF); LAS float* const ACS = (LAS float*)(L + ACSOFF);
    const int tid = F.tid, lane = F.lane, w = F.wave, g = lane >> 4, lr = lane & 15, q4 = lr >> 2, p4 = lane & 3;
    for (int item = F.bid; item < BATCH * 16; item += F.G) {
        const int b = item >> 4, h = item & 15, grp = h >> 3;
        const float A_h = -__expf(alog[h]), dtbias = dtb[h], dsk = dskip[h];
        const bf16* xg = XA + (size_t)(b * 16 + h) * 2048 * 64;
        const bf16* bg = BCA + (size_t)(b * 2 + grp) * 2048 * 256;
        const bf16* cg = bg + 128;
        const bf16* dg = P + L0_SMB + (size_t)(b * SEQ) * 320 + 288 + h;
        const bf16* zg = P + L0_ZH + (size_t)(b * 16 + h) * 2048 * 64;
        bf16* og = mix + (size_t)(b * SEQ) * 2048 + h * 64;
        f32x4 stT[4];
#pragma unroll
        for (int pt = 0; pt < 4; ++pt) stT[pt] = (f32x4){0.f, 0.f, 0.f, 0.f};
        __syncthreads();
        for (int i = tid; i < 64 * BST / 16; i += NTHR) *(LAS v4u*)(L + SOFF + i * 16) = (v4u){0u, 0u, 0u, 0u};
        v4u xp[2], bp[4], cp[4]; float raw0 = 0.f, raw1 = 0.f;
#define SSD_LOAD(c) do { const size_t r0_ = (size_t)(128 * (c)); \
            _Pragma("unroll") for (int i_ = 0; i_ < 2; ++i_) { const int p_ = tid + NTHR * i_; xp[i_] = *(const v4u*)(xg + (r0_ + (p_ >> 3)) * 64 + (p_ & 7) * 8); } \
            _Pragma("unroll") for (int i_ = 0; i_ < 4; ++i_) { const int p_ = tid + NTHR * i_; bp[i_] = *(const v4u*)(bg + (r0_ + (p_ >> 4)) * 256 + (p_ & 15) * 8); cp[i_] = *(const v4u*)(cg + (r0_ + (p_ >> 4)) * 256 + (p_ & 15) * 8); } \
            if (w < 2) { raw0 = bf2f(dg[(r0_ + lane) * 320]); raw1 = bf2f(dg[(r0_ + 64 + lane) * 320]); } } while (0)
        SSD_LOAD(0);
        for (int c = 0; c < SEQ / 128; ++c) {
#pragma unroll
            for (int i = 0; i < 2; ++i) { const int p = tid + NTHR * i; *(LAS v4u*)(L + XOFF + (p >> 3) * XST + (p & 7) * 16) = xp[i]; }
#pragma unroll
            for (int i = 0; i < 4; ++i) { const int p = tid + NTHR * i; *(LAS v4u*)(L + BOFF + (p >> 4) * BST + (p & 15) * 16) = bp[i]; *(LAS v4u*)(L + COFF + (p >> 4) * BST + (p & 15) * 16) = cp[i]; }
            if (w < 2) {
                const float d0 = softplus_f(raw0 + dtbias), d1 = softplus_f(raw1 + dtbias);
                const float s0 = wave_scan_incl(d0 * A_h, lane); const float tot0 = __shfl(s0, 63); const float s1 = wave_scan_incl(d1 * A_h, lane) + tot0;
                if (w == 0) { DT[lane] = d0; ACS[lane] = s0; } else { DT[64 + lane] = d1; ACS[64 + lane] = s1; }
            }
            __syncthreads();
            const float acs_end = ACS[127];
#pragma unroll
            for (int i = 0; i < 2; ++i) { const int p = tid + NTHR * i, j = p >> 3; const float f = __expf(acs_end - ACS[j]) * DT[j]; const v4u x = xp[i]; v4u o;
                o.x = cvtpk(bflo(x.x) * f, bfhi(x.x) * f); o.y = cvtpk(bflo(x.y) * f, bfhi(x.y) * f); o.z = cvtpk(bflo(x.z) * f, bfhi(x.z) * f); o.w = cvtpk(bflo(x.w) * f, bfhi(x.w) * f);
                *(LAS v4u*)(L + XWOFF + j * XST + (p & 7) * 16) = o; }
            if (c + 1 < SEQ / 128) SSD_LOAD(c + 1);
            bf16x8 cf[4];
#pragma unroll
            for (int ks = 0; ks < 4; ++ks) cf[ks] = *(const LAS bf16x8*)(L + COFF + (16 * w + lr) * BST + (32 * ks + 8 * g) * 2);
            const float acs_i = ACS[16 * w + lr];
            bf16x8 mf[4];
#pragma unroll
            for (int s2 = 0; s2 < 4; ++s2) { f32x4 mm[2];
#pragma unroll
                for (int e = 0; e < 2; ++e) { const int jt = 2 * s2 + e; mm[e] = (f32x4){0.f, 0.f, 0.f, 0.f};
                    if (jt <= w) {
#pragma unroll
                        for (int ks = 0; ks < 4; ++ks) { const bf16x8 a = *(const LAS bf16x8*)(L + BOFF + (16 * jt + lr) * BST + (32 * ks + 8 * g) * 2); mm[e] = MFMA16(a, cf[ks], mm[e]); }
                        const f32x4 aj = *(const LAS f32x4*)(ACS + 16 * jt + 4 * g), dj = *(const LAS f32x4*)(DT + 16 * jt + 4 * g);
#pragma unroll
                        for (int r = 0; r < 4; ++r) { const float v = mm[e][r] * __expf(acs_i - aj[r]) * dj[r]; mm[e][r] = (jt < w || 4 * g + r <= lr) ? v : 0.f; }
                    } }
                mf[s2] = pack8(mm[0], mm[1]); }
            __builtin_amdgcn_sched_barrier(0);
            const float e_i = __expf(acs_i);
#pragma unroll
            for (int pt = 0; pt < 4; ++pt) { f32x4 y = (f32x4){0.f, 0.f, 0.f, 0.f};
#pragma unroll
                for (int ks = 0; ks < 4; ++ks) { const bf16x8 a = *(const LAS bf16x8*)(L + SOFF + (16 * pt + lr) * BST + (32 * ks + 8 * g) * 2); y = MFMA16(a, cf[ks], y); }
                y = y * e_i;
#pragma unroll
                for (int s2 = 0; s2 < 4; ++s2) if (2 * s2 <= w) {
                    const s16x4 lo = lds_tr(L + XOFF + (32 * s2 + 4 * g + q4) * XST + (16 * pt + 4 * p4) * 2), hi = lds_tr(L + XOFF + (32 * s2 + 16 + 4 * g + q4) * XST + (16 * pt + 4 * p4) * 2);
                    y = MFMA16(cat8(lo, hi), mf[s2], y); }
                const int tok = 128 * c + 16 * w + lr, p0 = 16 * pt + 4 * g;
                const v2u xw = *(const LAS v2u*)(L + XOFF + (16 * w + lr) * XST + p0 * 2); const v2u zw = *(const v2u*)(zg + (size_t)tok * 64 + p0);
                const float o0 = (y[0] + dsk * bflo(xw.x)) * silu_f(bflo(zw.x)), o1 = (y[1] + dsk * bfhi(xw.x)) * silu_f(bfhi(zw.x)), o2 = (y[2] + dsk * bflo(xw.y)) * silu_f(bflo(zw.y)), o3 = (y[3] + dsk * bfhi(xw.y)) * silu_f(bfhi(zw.y));
                v2u o; o.x = cvtpk(o0, o1); o.y = cvtpk(o2, o3); *(v2u*)(og + (size_t)tok * 2048 + p0) = o; }
            __syncthreads();
            { const float e_end = __expf(acs_end);
#pragma unroll
              for (int pt = 0; pt < 4; ++pt) stT[pt] = stT[pt] * e_end; }
#pragma unroll
            for (int s2 = 0; s2 < 4; ++s2) {
                const s16x4 lo = lds_tr(L + BOFF + (32 * s2 + 8 * g + q4) * BST + (16 * w + 4 * p4) * 2), hi = lds_tr(L + BOFF + (32 * s2 + 8 * g + 4 + q4) * BST + (16 * w + 4 * p4) * 2); const bf16x8 a = cat8(lo, hi);
#pragma unroll
                for (int pt = 0; pt < 4; ++pt) { const s16x4 xl = lds_tr(L + XWOFF + (32 * s2 + 8 * g + q4) * XST + (16 * pt + 4 * p4) * 2), xh = lds_tr(L + XWOFF + (32 * s2 + 8 * g + 4 + q4) * XST + (16 * pt + 4 * p4) * 2);
                    stT[pt] = MFMA16(a, cat8(xl, xh), stT[pt]); } }
#pragma unroll
            for (int pt = 0; pt < 4; ++pt) { v2u o; o.x = cvtpk(stT[pt][0], stT[pt][1]); o.y = cvtpk(stT[pt][2], stT[pt][3]); *(LAS v2u*)(L + SOFF + (16 * pt + lr) * BST + (16 * w + 4 * g) * 2) = o; }
            __syncthreads();
        }
#undef SSD_LOAD
    }
}

__device__ __forceinline__ void ssd_norm(const Frame& F, bf16* mix, const float* mnorm) {
    const int gw = F.bid * NWAVES + F.wave, NGW = F.G * NWAVES, lane = F.lane;
    for (int it = gw; it < MTOK * 2; it += NGW) {
        const int row = it >> 1, g = it & 1; bf16* p = mix + (size_t)row * 2048 + g * 512 + 8 * lane;
        const v4u w = *(const v4u*)p; float v[8] = {bflo(w.x), bfhi(w.x), bflo(w.y), bfhi(w.y), bflo(w.z), bfhi(w.z), bflo(w.w), bfhi(w.w)};
        float s = 0.f;
#pragma unroll
        for (int j = 0; j < 8; ++j) s += v[j] * v[j];
        const float r = 1.f / sqrtf(wave_sum(s) * (1.f / 512.f) + LN_EPS);
        const f32x4 m0 = *(const f32x4*)(mnorm + g * 512 + 8 * lane), m1 = *(const f32x4*)(mnorm + g * 512 + 8 * lane + 4);
        v4u o; o.x = pk2(v[0] * r * m0.x, v[1] * r * m0.y); o.y = pk2(v[2] * r * m0.z, v[3] * r * m0.w); o.z = pk2(v[4] * r * m1.x, v[5] * r * m1.y); o.w = pk2(v[6] * r * m1.z, v[7] * r * m1.w);
        *(v4u*)p = o;
    }
}

struct RwkvW { const float *mu, *w0, *wup, *a0, *aup, *gup, *kk, *ka, *rk, *rlnw, *rlnb; };
typedef float f32x2 __attribute__((ext_vector_type(2)));
#define MFMA16K(a, b, c) __builtin_amdgcn_mfma_f32_16x16x32_bf16(cat8(a, (s16x4){0, 0, 0, 0}), cat8(b, (s16x4){0, 0, 0, 0}), c, 0, 0, 0)
__device__ __forceinline__ s16x4 pack4(f32x4 a) { v2u w; w.x = cvtpk(a[0], a[1]); w.y = cvtpk(a[2], a[3]); return __builtin_bit_cast(s16x4, w); }
__device__ __forceinline__ float fast_sigmoid(float x) { return __builtin_amdgcn_rcpf(1.f + __expf(-x)); }
__device__ __forceinline__ float fast_tanh(float x) { return 1.f - 2.f * __builtin_amdgcn_rcpf(1.f + __expf(2.f * x)); }
__device__ __forceinline__ bf16x8 pack8f(const float* v) { v4u w; w.x = cvtpk(v[0], v[1]); w.y = cvtpk(v[2], v[3]); w.z = cvtpk(v[4], v[5]); w.w = cvtpk(v[6], v[7]); return __builtin_bit_cast(bf16x8, w); }
__device__ __forceinline__ void rwkv_items(const Frame& F, const bf16* P, const bf16* SMS, const RwkvW W, bf16* mix) {
    constexpr int TC = 32, TST = 144, GST = 336, FST = 272, FSZ = TC * FST;
    constexpr int RS = 0, KS = FSZ, VB = 2 * FSZ, OPS = VB + 2 * TC * TST;
    constexpr int AT = OPS, RT = OPS + 4608, BH = OPS + 9216, KH = OPS + 13824, BBAR = OPS + 18432, KBAR = OPS + 23040;
    constexpr int TWD = OPS, SAD = OPS + 4608, SGD = OPS + 9216;
    constexpr int LW = OPS + 27648, ICL = LW + FSZ, GT = ICL + FSZ, AAF = GT + FSZ, SM = AAF + FSZ, MABF = SM + 4096, PCO = MABF + 2048, BON = PCO + 512, N2 = BON + 1024, YR = N2 + 128, MU = YR + FSZ;
    static_assert(SGD + TC * GST <= LW && MU + 1920 <= RING_BYTES, "RWKV LDS map");
    LAS unsigned char* const L = F.lds;
    const int tid0 = F.tid, wave = F.wave;
#define RW_LANES() int tid = tid0; asm volatile("" : "+v"(tid)); const int lane = tid & 63, g = lane >> 4, lr = lane & 15, q4 = lr >> 2, p4 = lane & 3; (void)g; (void)lr; (void)q4; (void)p4
    for (int item = F.bid; item < BATCH * 16; item += F.G) {
        RW_LANES();
        const int b = item >> 4, h = item & 15, hc = h * 64 + lane;
        const bf16* Pr = P + L0_RKVH + (size_t)(b * 16 + h) * 2048 * 192;
        const bf16* Ps = SMS + (size_t)(b * SEQ) * 320;
        const int ct = wave & 3, c0 = h * 64 + 16 * ct + 4 * g;
        __syncthreads();
        if (tid < 480) { const int pc = tid >> 3, q = tid & 7; *(LAS float*)(L + MU + tid * 4) = W.mu[pc < 24 ? (pc >> 3) * 1024 + h * 64 + (pc & 7) * 8 + q : 3072 + (pc - 24) * 8 + q]; }
        bf16x8 wf[5];
        if (wave < 4) {
#pragma unroll
            for (int ks = 0; ks < 2; ++ks) { float t0_[8], t1_[8];
#pragma unroll
                for (int jj = 0; jj < 8; ++jj) { const size_t o = (size_t)(32 * ks + 8 * g + jj) * 1024 + h * 64 + 16 * ct + lr; t0_[jj] = W.wup[o]; t1_[jj] = W.aup[o]; }
                wf[ks] = pack8f(t0_); wf[2 + ks] = pack8f(t1_); asm volatile("" ::: "memory"); }
            wf[4] = wf[0];
        } else {
#pragma unroll
            for (int ks = 0; ks < 5; ++ks) { float t0_[8];
#pragma unroll
                for (int jj = 0; jj < 8; ++jj) t0_[jj] = W.gup[(size_t)(32 * ks + 8 * g + jj) * 1024 + h * 64 + 16 * ct + lr];
                wf[ks] = pack8f(t0_); asm volatile("" ::: "memory"); }
        }
        const float rlw = W.rlnw[hc], rlb = W.rlnb[hc];
        const f32x4 w0v = *(const f32x4*)(W.w0 + c0), a0v = *(const f32x4*)(W.a0 + c0), kk4 = *(const f32x4*)(W.kk + c0), ka4 = *(const f32x4*)(W.ka + c0), rk4 = *(const f32x4*)(W.rk + c0);
        const f32x4 kkp0 = *(const f32x4*)(W.kk + h * 64 + (tid & 7) * 8), kkp1 = *(const f32x4*)(W.kk + h * 64 + (tid & 7) * 8 + 4);
        f32x4 sT[4];
#pragma unroll
        for (int kt = 0; kt < 4; ++kt) sT[kt] = (f32x4){0.f, 0.f, 0.f, 0.f};
        v4u cur[4], prv[4];
#define RW_SLOTS() const int u8 = tid & 255, tt1 = u8 >> 3, pc1 = u8 & 7, ix2 = 256 + tid, tt2g = ix2 / 20, pc2g = ix2 % 20, tt3 = tid / 20, pc3 = tid % 20; \
        const int mu0 = tid & 15, mu1 = wave < 4 ? 16 + pc1 : 24 + pc1, mu2 = wave < 4 ? 32 + pc1 : 40 + pc2g, mu3 = 40 + pc3, ttb2 = wave < 4 ? tt1 : tt2g; \
        const int off0 = ((tid >> 3) & 1) * 64 + (tid & 7) * 8, off1 = wave < 4 ? 128 + pc1 * 8 : pc1 * 8, off2 = wave < 4 ? 64 + pc1 * 8 : 128 + pc2g * 8, off3 = 128 + pc3 * 8; (void)mu0; (void)mu1; (void)mu2; (void)mu3
#define RW_LD1(i_, tt_, base_, pitch_, off_) do { const int t_ = t0n_ + (tt_); cur[i_] = *(const v4u*)((base_) + (size_t)t_ * (pitch_) + (off_)); prv[i_] = t_ > 0 ? *(const v4u*)((base_) + (size_t)(t_ - 1) * (pitch_) + (off_)) : (v4u){0u, 0u, 0u, 0u}; } while (0)
#define RW_LD0(i_, tt_, off_) do { cur[i_] = *(const v4u*)(Ps + (size_t)(t0n_ + (tt_)) * 320 + (off_)); } while (0)
#define RW_LOAD(t0_) do { RW_LANES(); RW_SLOTS(); const int t0n_ = (t0_); RW_LD1(0, tid >> 4, Pr, 192, off0); if (wave < 4) RW_LD1(1, tt1, Pr, 192, off1); else RW_LD0(1, tt1, off1); if (wave < 6) RW_LD0(2, ttb2, off2); RW_LD0(3, tt3, off3); } while (0)
#define RW_SHIFT(v_, i_, mu_) do { const f32x4 m0_ = *(const LAS f32x4*)(L + MU + (mu_) * 32), m1_ = *(const LAS f32x4*)(L + MU + (mu_) * 32 + 16); const v4u cw_ = cur[i_], pw_ = prv[i_]; \
            const float c_[8] = {bflo(cw_.x), bfhi(cw_.x), bflo(cw_.y), bfhi(cw_.y), bflo(cw_.z), bfhi(cw_.z), bflo(cw_.w), bfhi(cw_.w)}; \
            const float p_[8] = {bflo(pw_.x), bfhi(pw_.x), bflo(pw_.y), bfhi(pw_.y), bflo(pw_.z), bfhi(pw_.z), bflo(pw_.w), bfhi(pw_.w)}; \
            _Pragma("unroll") for (int q_ = 0; q_ < 8; ++q_) v_[q_] = c_[q_] + (p_[q_] - c_[q_]) * (q_ < 4 ? m0_[q_ & 3] : m1_[q_ & 3]); } while (0)
#define RW_PASS_E(te_, par_) do { _Pragma("unroll") for (int rep = 0; rep < TC / NWAVES; ++rep) { const int tt = wave + NWAVES * rep, o = tt * FST + lane * 4; const size_t row = (size_t)(b * SEQ + (te_) + tt); \
                const float y = *(LAS float*)(L + YR + o); const float mu = wave_sum(y) * (1.f / 64.f); const float d = y - mu; const float var = wave_sum(d * d) * (1.f / 64.f); \
                const float yn = d * (1.f / sqrtf(var + 64e-5f)) * rlw + rlb; \
                const LAS float* bp_ = (const LAS float*)(L + BON + (par_) * 512 + tt * 4); const float bonus = ((bp_[0] + bp_[32]) + (bp_[64] + bp_[96])) * bf2f(*(LAS bf16*)(L + VB + (par_) * TC * TST + tt * TST + lane * 2)); \
                mix[row * 2048 + 1024 + hc] = (bf16)f2bf((yn + bonus) * *(LAS float*)(L + GT + o)); } } while (0)
        RW_LOAD(0);
        for (int t0 = 0; t0 < SEQ; t0 += TC) {
            const int par = (t0 >> 5) & 1;
            LDS_BARRIER();
            { RW_LANES(); RW_SLOTS();
            { float v[8]; RW_SHIFT(v, 0, mu0); const int base = ((tid & 8) ? KS : RS) + (tid >> 4) * FST + (tid & 7) * 32;
              *(LAS f32x4*)(L + base) = (f32x4){v[0], v[1], v[2], v[3]}; *(LAS f32x4*)(L + base + 16) = (f32x4){v[4], v[5], v[6], v[7]};
              float n2 = 0.f;
#pragma unroll
              for (int q = 0; q < 8; ++q) { const float x = v[q] * (q < 4 ? kkp0[q & 3] : kkp1[q & 3]); n2 += x * x; }
              n2 += __shfl_xor(n2, 1); n2 += __shfl_xor(n2, 2); n2 += __shfl_xor(n2, 4);
              if ((tid & 15) == 8) *(LAS float*)(L + N2 + (tid >> 4) * 4) = n2; }
            if (wave < 4) { float v[8]; RW_SHIFT(v, 1, mu1); *(LAS bf16x8*)(L + VB + par * TC * TST + tt1 * TST + pc1 * 16) = pack8f(v); }
            else *(LAS v4u*)(L + TWD + tt1 * TST + pc1 * 16) = cur[1];
            if (wave < 4) *(LAS v4u*)(L + SAD + tt1 * TST + pc1 * 16) = cur[2];
            else if (wave < 6) *(LAS v4u*)(L + SGD + tt2g * GST + pc2g * 16) = cur[2];
            *(LAS v4u*)(L + SGD + tt3 * GST + pc3 * 16) = cur[3];
            if (t0 > 0) RW_PASS_E(t0 - TC, par ^ 1);
            }
            LDS_BARRIER();
            if (t0 + TC < SEQ) RW_LOAD(t0 + TC);
            { RW_LANES();
#pragma unroll
            for (int tt2 = 0; tt2 < 2; ++tt2) {
                if (wave < 4) { f32x4 dw = (f32x4){0.f, 0.f, 0.f, 0.f}, da = (f32x4){0.f, 0.f, 0.f, 0.f};
#pragma unroll
                    for (int ks = 0; ks < 2; ++ks) {
                        const bf16x8 bw = *(const LAS bf16x8*)(L + TWD + (16 * tt2 + lr) * TST + (32 * ks + 8 * g) * 2), ba = *(const LAS bf16x8*)(L + SAD + (16 * tt2 + lr) * TST + (32 * ks + 8 * g) * 2);
                        dw = MFMA16(wf[ks], bw, dw); da = MFMA16(wf[2 + ks], ba, da); }
                    const int o = (16 * tt2 + lr) * FST + (16 * ct + 4 * g) * 4;
                    const f32x4 kv = *(const LAS f32x4*)(L + KS + o), rv = *(const LAS f32x4*)(L + RS + o);
                    const float inv = 1.f / fmaxf(sqrtf(*(const LAS float*)(L + N2 + (16 * tt2 + lr) * 4)), 1e-12f);
                    f32x4 lw, kp, av, bv; float bon = 0.f;
#pragma unroll
                    for (int r = 0; r < 4; ++r) { lw[r] = -0.6065306597126334f * fast_sigmoid(w0v[r] + dw[r]); const float icl = fast_sigmoid(a0v[r] + da[r]);
                        const float kkn = kv[r] * kk4[r] * inv; kp[r] = kv[r] * (1.f + (icl - 1.f) * ka4[r]); av[r] = -kkn; bv[r] = kkn * icl; bon += rv[r] * kp[r] * rk4[r]; }
                    *(LAS f32x4*)(L + LW + o) = lw; *(LAS f32x4*)(L + KS + o) = kp; *(LAS f32x4*)(L + AAF + o) = av; *(LAS f32x4*)(L + ICL + o) = bv;
                    bon += __shfl_xor(bon, 16); bon += __shfl_xor(bon, 32);
                    if (g == 0) *(LAS float*)(L + BON + par * 512 + ct * 128 + (16 * tt2 + lr) * 4) = bon;
                } else { f32x4 dg = (f32x4){0.f, 0.f, 0.f, 0.f};
#pragma unroll
                    for (int ks = 0; ks < 5; ++ks) { const bf16x8 bg = *(const LAS bf16x8*)(L + SGD + (16 * tt2 + lr) * GST + (32 * ks + 8 * g) * 2); dg = MFMA16(wf[ks], bg, dg); }
                    *(LAS f32x4*)(L + GT + (16 * tt2 + lr) * FST + (16 * ct + 4 * g) * 4) = dg; } }
            }
            LDS_BARRIER();
            { RW_LANES();
            { const int ch = tid >> 8, q = (tid >> 6) & 3, c = lane; float lp[16]; float run = 0.f;
#pragma unroll
              for (int t = 0; t < 16; ++t) { run += *(LAS float*)(L + LW + (16 * ch + t) * FST + c * 4); lp[t] = run; }
              const float lend = lp[15];
#pragma unroll
              for (int t = 0; t < 16; ++t) if ((t >> 2) == q) { const int tok = 16 * ch + t, o = tok * FST + c * 4, ob = tok * TST + c * 2;
                  const float av = *(LAS float*)(L + AAF + o), bv = *(LAS float*)(L + ICL + o), kp = *(LAS float*)(L + KS + o), rv = *(LAS float*)(L + RS + o);
                  const float em1 = t ? __expf(lp[t ? t - 1 : 0]) : 1.f, et = __expf(lp[t]), iet = __expf(-lp[t]), ee = __expf(lend - lp[t]);
                  *(LAS bf16*)(L + AT + ob) = (bf16)f2bf(av * em1); *(LAS bf16*)(L + RT + ob) = (bf16)f2bf(rv * et); *(LAS bf16*)(L + BH + ob) = (bf16)f2bf(bv * iet);
                  *(LAS bf16*)(L + KH + ob) = (bf16)f2bf(kp * iet); *(LAS bf16*)(L + BBAR + ob) = (bf16)f2bf(bv * ee); *(LAS bf16*)(L + KBAR + ob) = (bf16)f2bf(kp * ee); }
              if (q == 0) *(LAS float*)(L + PCO + (ch * 64 + c) * 4) = __expf(lend); }
            }
            LDS_BARRIER();
            { RW_LANES();
            { const int mi = wave & 3, ch = wave >> 2; const int lhs = (mi & 1) ? KH : BH, rhs = (mi & 2) ? RT : AT; f32x4 acc = (f32x4){0.f, 0.f, 0.f, 0.f};
#pragma unroll
              for (int ks = 0; ks < 2; ++ks) { const bf16x8 a_ = *(const LAS bf16x8*)(L + lhs + (16 * ch + lr) * TST + (32 * ks + 8 * g) * 2), b_ = *(const LAS bf16x8*)(L + rhs + (16 * ch + lr) * TST + (32 * ks + 8 * g) * 2);
                  acc = MFMA16(a_, b_, acc); }
#pragma unroll
              for (int r = 0; r < 4; ++r) { const int s_ = 4 * g + r; acc[r] = ((mi < 2) ? (s_ < lr) : (s_ <= lr)) ? acc[r] : 0.f; }
              if (mi != 0) *(LAS s16x4*)(L + SM + ch * 2048 + (mi - 1) * 512 + lr * 32 + 8 * g) = pack4(acc);
              else {
#pragma unroll
                  for (int r = 0; r < 4; ++r) *(LAS float*)(L + MABF + ch * 1024 + ((4 * g + r) * 16 + lr) * 4) = acc[r];
                  float m[16];
#pragma unroll
                  for (int s_ = 15; s_ >= 0; --s_) { float row[16];
#pragma unroll
                      for (int u4 = 0; u4 < 4; ++u4) { const f32x4 rv = *(const LAS f32x4*)(L + MABF + ch * 1024 + s_ * 64 + u4 * 16); row[4 * u4] = rv[0]; row[4 * u4 + 1] = rv[1]; row[4 * u4 + 2] = rv[2]; row[4 * u4 + 3] = rv[3]; }
                      float sum = (s_ == lr) ? 1.f : 0.f;
#pragma unroll
                      for (int u = s_ + 1; u < 16; ++u) sum += row[u] * m[u];
                      m[s_] = sum; asm volatile("" ::: "memory"); }
                  if (lane < 16) { *(LAS bf16x8*)(L + SM + ch * 2048 + 1536 + lr * 32) = pack8f(m); *(LAS bf16x8*)(L + SM + ch * 2048 + 1536 + lr * 32 + 16) = pack8f(m + 8); }
              } }
            }
            LDS_BARRIER();
            { RW_LANES();
            if (wave < 4) {
#pragma unroll 1
                for (int ch = 0; ch < 2; ++ch) {
                    const bf16x8 sf0 = pack8(sT[0], sT[1]), sf1 = pack8(sT[2], sT[3]);
                    const s16x4 vf = lds_tr(L + VB + par * TC * TST + (16 * ch + 4 * g + q4) * TST + (16 * wave + 4 * p4) * 2);
                    const int rowb = (16 * ch + lr) * TST, smb = SM + ch * 2048 + lr * 32 + 8 * g;
                    f32x4 x = (f32x4){0.f, 0.f, 0.f, 0.f}, y = (f32x4){0.f, 0.f, 0.f, 0.f};
                    x = MFMA16(cat8(*(const LAS s16x4*)(L + AT + rowb + (4 * g) * 2), *(const LAS s16x4*)(L + AT + rowb + (16 + 4 * g) * 2)), sf0, x);
                    x = MFMA16(cat8(*(const LAS s16x4*)(L + AT + rowb + (32 + 4 * g) * 2), *(const LAS s16x4*)(L + AT + rowb + (48 + 4 * g) * 2)), sf1, x);
                    x = MFMA16K(*(const LAS s16x4*)(L + smb), vf, x);
                    const s16x4 xf = pack4(x);
                    const f32x4 sa = MFMA16K(*(const LAS s16x4*)(L + smb + 1536), xf, ((f32x4){0.f, 0.f, 0.f, 0.f}));
                    const s16x4 saf = pack4(sa);
                    y = MFMA16(cat8(*(const LAS s16x4*)(L + RT + rowb + (4 * g) * 2), *(const LAS s16x4*)(L + RT + rowb + (16 + 4 * g) * 2)), sf0, y);
                    y = MFMA16(cat8(*(const LAS s16x4*)(L + RT + rowb + (32 + 4 * g) * 2), *(const LAS s16x4*)(L + RT + rowb + (48 + 4 * g) * 2)), sf1, y);
                    y = MFMA16K(*(const LAS s16x4*)(L + smb + 512), saf, y);
                    y = MFMA16K(*(const LAS s16x4*)(L + smb + 1024), vf, y);
#pragma unroll
                    for (int kt = 0; kt < 4; ++kt) { const f32x4 pc = *(const LAS f32x4*)(L + PCO + (ch * 64 + 16 * kt + 4 * g) * 4);
                        const s16x4 bb = lds_tr(L + BBAR + (16 * ch + 4 * g + q4) * TST + (16 * kt + 4 * p4) * 2), kb = lds_tr(L + KBAR + (16 * ch + 4 * g + q4) * TST + (16 * kt + 4 * p4) * 2);
                        f32x4 sn = sT[kt] * pc; sn = MFMA16K(bb, saf, sn); sn = MFMA16K(kb, vf, sn); sT[kt] = sn; }
#pragma unroll
                    for (int r = 0; r < 4; ++r) *(LAS float*)(L + YR + (16 * ch + 4 * g + r) * FST + (16 * wave + lr) * 4) = y[r];
                }
            }
            }
        }
        LDS_BARRIER();
        { RW_LANES(); RW_PASS_E(SEQ - TC, ((SEQ - TC) >> 5) & 1); }
#undef RW_LOAD
#undef RW_LD1
#undef RW_LD0
#undef RW_SHIFT
#undef RW_LANES
#undef RW_SLOTS
#undef RW_PASS_E
    }
}

__device__ __forceinline__ void retention_mfma(const Frame& F, bf16* Q) {
    constexpr int KST = 528, VST = 272, SST = 528;
    constexpr int KOFF = 0, VOFF = 64 * KST, SOFF = VOFF + 64 * VST;
    LAS unsigned char* const L = F.lds;
    const int tid = F.tid, lane0 = F.lane, w = F.wave;
    const int it = w & 3, vh = w >> 2;
#define RT_LANES() int lane = lane0; asm volatile("" : "+v"(lane)); const int g = lane >> 4, lr = lane & 15, q4 = lr >> 2, p4 = lane & 3; (void)g; (void)lr; (void)q4; (void)p4
    const int lr0 = lane0 & 15;
    for (int item = F.bid; item < BATCH * 16; item += F.G) {
        const int b = item >> 4, h = (item >> 2) & 3, sl = item & 3;
        const float lg2 = log2f(1.f - exp2f(-5.f - (float)h));
        const float g64 = exp2f(64.f * lg2);
        const float vf0 = exp2f(-(float)((tid >> 4) + 1) * lg2), vf1 = exp2f(-(float)((tid >> 4) + 33) * lg2);
        const float ysc = exp2f((float)(16 * it + lr0 + 1) * lg2);
        const bf16* qg = Q + L1_QKH + (size_t)(b * 4 + h) * 2048 * 512;
        const bf16* kg = qg + 256;
        bf16* vg = Q + L1_VH + (size_t)((b * 4 + h) * 4 + sl) * 2048 * 128;
        f32x4 st[2][8];
#pragma unroll
        for (int a = 0; a < 2; ++a)
#pragma unroll
            for (int c = 0; c < 8; ++c) st[a][c] = (f32x4){0.f, 0.f, 0.f, 0.f};
        __syncthreads();
        for (int i = tid; i < 128 * SST / 16; i += NTHR) *(LAS v4u*)(L + SOFF + i * 16) = (v4u){0u, 0u, 0u, 0u};
        v4u kp[4], vp[2];
#define RET_LOAD(c) do { const size_t r0_ = (size_t)(64 * (c)); \
            _Pragma("unroll") for (int i_ = 0; i_ < 4; ++i_) { const int p_ = tid + NTHR * i_; kp[i_] = *(const v4u*)(kg + (r0_ + (p_ >> 5)) * 512 + (p_ & 31) * 8); } \
            _Pragma("unroll") for (int i_ = 0; i_ < 2; ++i_) { const int p_ = tid + NTHR * i_; vp[i_] = *(const v4u*)(vg + (r0_ + (p_ >> 4)) * 128 + (p_ & 15) * 8); } } while (0)
        RET_LOAD(0);
        bf16x8 qc[8];
#define RET_QLOAD(c_) do { RT_LANES(); _Pragma("unroll") for (int ks = 0; ks < 8; ++ks) qc[ks] = *(const bf16x8*)(qg + (size_t)(64 * (c_) + 16 * it + lr) * 512 + 32 * ks + 8 * g); } while (0)
        RET_QLOAD(0);
        for (int c = 0; c < SEQ / 64; ++c) {
#pragma unroll
            for (int i = 0; i < 4; ++i) { const int p = tid + NTHR * i; *(LAS v4u*)(L + KOFF + (p >> 5) * KST + (p & 31) * 16) = kp[i]; }
#pragma unroll
            for (int i = 0; i < 2; ++i) { const int p = tid + NTHR * i; const float f = i ? vf1 : vf0; const v4u x = vp[i]; v4u o;
                o.x = cvtpk(bflo(x.x) * f, bfhi(x.x) * f); o.y = cvtpk(bflo(x.y) * f, bfhi(x.y) * f); o.z = cvtpk(bflo(x.z) * f, bfhi(x.z) * f); o.w = cvtpk(bflo(x.w) * f, bfhi(x.w) * f);
                *(LAS v4u*)(L + VOFF + (p >> 4) * VST + (p & 15) * 16) = o; }
            LDS_BARRIER();
            if (c + 1 < SEQ / 64) RET_LOAD(c + 1);
            { RT_LANES();
#pragma unroll
            for (int s2 = 0; s2 < 2; ++s2) { bf16x8 ka[2];
#pragma unroll
                for (int dt = 0; dt < 2; ++dt) { const s16x4 lo = lds_tr(L + KOFF + (32 * s2 + 8 * g + q4) * KST + (32 * w + 16 * dt + 4 * p4) * 2), hi = lds_tr(L + KOFF + (32 * s2 + 8 * g + 4 + q4) * KST + (32 * w + 16 * dt + 4 * p4) * 2); ka[dt] = cat8(lo, hi); }
#pragma unroll
                for (int vq = 0; vq < 2; ++vq) { bf16x8 vb[4];
#pragma unroll
                    for (int v4 = 0; v4 < 4; ++v4) { const int vt = 4 * vq + v4; const s16x4 lo = lds_tr(L + VOFF + (32 * s2 + 8 * g + q4) * VST + (16 * vt + 4 * p4) * 2), hi = lds_tr(L + VOFF + (32 * s2 + 8 * g + 4 + q4) * VST + (16 * vt + 4 * p4) * 2); vb[v4] = cat8(lo, hi); }
                    __builtin_amdgcn_sched_barrier(0);
#pragma unroll
                    for (int v4 = 0; v4 < 4; ++v4) { st[0][4 * vq + v4] = MFMA16(ka[0], vb[v4], st[0][4 * vq + v4]); st[1][4 * vq + v4] = MFMA16(ka[1], vb[v4], st[1][4 * vq + v4]); }
                    __builtin_amdgcn_sched_barrier(0); } }
#pragma unroll
            for (int dt = 0; dt < 2; ++dt)
#pragma unroll
                for (int vt = 0; vt < 8; ++vt) st[dt][vt] = st[dt][vt] * g64;
            }
            __builtin_amdgcn_sched_barrier(0);
            { RT_LANES();
            f32x4 sacc[4];
#pragma unroll
            for (int jt = 0; jt < 4; ++jt) { sacc[jt] = (f32x4){0.f, 0.f, 0.f, 0.f};
                if (jt <= it) { bf16x8 kr[8];
#pragma unroll
                    for (int ks = 0; ks < 8; ++ks) kr[ks] = *(const LAS bf16x8*)(L + KOFF + (16 * jt + lr) * KST + (32 * ks + 8 * g) * 2);
                    __builtin_amdgcn_sched_barrier(0);
#pragma unroll
                    for (int ks = 0; ks < 8; ++ks) sacc[jt] = MFMA16(kr[ks], qc[ks], sacc[jt]);
                    if (jt == it) {
#pragma unroll
                        for (int r = 0; r < 4; ++r) sacc[jt][r] = (4 * g + r <= lr) ? sacc[jt][r] : 0.f; }
                    __builtin_amdgcn_sched_barrier(0);
                } }
            bf16x8 sf[2]; sf[0] = pack8(sacc[0], sacc[1]); sf[1] = pack8(sacc[2], sacc[3]); __builtin_amdgcn_sched_barrier(0);
#pragma unroll
            for (int x = 0; x < 4; ++x) { const int vt = 4 * vh + x; f32x4 y = (f32x4){0.f, 0.f, 0.f, 0.f};
#pragma unroll
                for (int kh = 0; kh < 2; ++kh) { bf16x8 sr[4];
#pragma unroll
                    for (int k4 = 0; k4 < 4; ++k4) sr[k4] = *(const LAS bf16x8*)(L + SOFF + (16 * vt + lr) * SST + (32 * (4 * kh + k4) + 8 * g) * 2);
                    __builtin_amdgcn_sched_barrier(0);
#pragma unroll
                    for (int k4 = 0; k4 < 4; ++k4) y = MFMA16(sr[k4], qc[4 * kh + k4], y);
                    __builtin_amdgcn_sched_barrier(0); }
#pragma unroll
                for (int s2 = 0; s2 < 2; ++s2) if (2 * s2 <= it) {
                    const s16x4 lo = lds_tr(L + VOFF + (32 * s2 + 4 * g + q4) * VST + (16 * vt + 4 * p4) * 2), hi = lds_tr(L + VOFF + (32 * s2 + 16 + 4 * g + q4) * VST + (16 * vt + 4 * p4) * 2);
                    y = MFMA16(cat8(lo, hi), sf[s2], y); }
                v2u o; o.x = cvtpk(y[0] * ysc, y[1] * ysc); o.y = cvtpk(y[2] * ysc, y[3] * ysc);
                *(v2u*)(vg + (size_t)(64 * c + 16 * it + lr) * 128 + 16 * vt + 4 * g) = o; __builtin_amdgcn_sched_barrier(0); }
            }
            if (c + 1 < SEQ / 64) RET_QLOAD(c + 1);
            LDS_BARRIER();
            { RT_LANES();
#pragma unroll
            for (int dt = 0; dt < 2; ++dt)
#pragma unroll
                for (int vt = 0; vt < 8; ++vt) { v2u o; o.x = cvtpk(st[dt][vt][0], st[dt][vt][1]); o.y = cvtpk(st[dt][vt][2], st[dt][vt][3]);
                    *(LAS v2u*)(L + SOFF + (16 * vt + lr) * SST + (32 * w + 16 * dt + 4 * g) * 2) = o; }
            }
        }
#undef RET_LOAD
#undef RET_QLOAD
#undef RT_LANES
    }
}

__device__ __forceinline__ void retention_norm(const Frame& F, bf16* Q) {
    const int gw = F.bid * NWAVES + F.wave, NGW = F.G * NWAVES, lane = F.lane;
    for (int it = gw; it < MTOK * 4; it += NGW) {
        const int row = it >> 2, h = it & 3, c8 = 8 * lane; const bf16* yp = Q + L1_VH + ((size_t)(((row >> 11) * 4 + h) * 4 + (c8 >> 7)) * 2048 + (row & 2047)) * 128 + (c8 & 127); bf16* gp = Q + L1_GB + (size_t)row * 2048 + h * 512 + c8;
        const v4u w = *(const v4u*)yp; const v4u gq = *(const v4u*)gp;
        float v[8] = {bflo(w.x), bfhi(w.x), bflo(w.y), bfhi(w.y), bflo(w.z), bfhi(w.z), bflo(w.w), bfhi(w.w)};
        const float g[8] = {bflo(gq.x), bfhi(gq.x), bflo(gq.y), bfhi(gq.y), bflo(gq.z), bfhi(gq.z), bflo(gq.w), bfhi(gq.w)};
        float s = 0.f;
#pragma unroll
        for (int j = 0; j < 8; ++j) s += v[j];
        const float mean = wave_sum(s) * (1.f / 512.f); float s2 = 0.f;
#pragma unroll
        for (int j = 0; j < 8; ++j) { v[j] -= mean; s2 += v[j] * v[j]; }
        const float r = 1.f / sqrtf(wave_sum(s2) * (1.f / 512.f) + LN_EPS);
        float o[8];
#pragma unroll
        for (int j = 0; j < 8; ++j) o[j] = silu_f(g[j]) * v[j] * r;
        v4u ow; ow.x = pk2(o[0], o[1]); ow.y = pk2(o[2], o[3]); ow.z = pk2(o[4], o[5]); ow.w = pk2(o[6], o[7]);
        *(v4u*)gp = ow;
    }
}

__device__ __forceinline__ int pad256(int n) { return (n + 255) & ~255; }
__device__ __forceinline__ void moe_slots(const Frame& F, const unsigned* cnt, const int* tok_e, const float* tok_p, const int* tok_pos, int* tok_slot, int* rowtok, int* rowdst, float* rowp) {
    const int gt = F.bid * NTHR + F.tid, NGT = F.G * NTHR;
    for (int row = gt; row < MTOK; row += NGT) {
        const int e01 = tok_e[row], e0 = e01 & 255, e1 = e01 >> 8; const float p0 = tok_p[row];
        int base0 = 0, base1 = 0;
#pragma unroll
        for (int e = 0; e < 8; ++e) { const int pc = pad256((int)cnt[e]); if (e < e0) base0 += pc; if (e < e1) base1 += pc; }
        const int s0 = base0 + tok_pos[2 * row], s1 = base1 + tok_pos[2 * row + 1];
        rowtok[s0] = row; rowdst[s0] = row; rowp[s0] = p0;
        rowtok[s1] = row; rowdst[s1] = MTOK + row; rowp[s1] = 1.f - p0;
        tok_slot[2 * row] = s0; tok_slot[2 * row + 1] = s1;
    }
    for (int it = gt; it < 8 * 256; it += NGT) {
        const int e = it >> 8, i = it & 255;
        int base = 0;
#pragma unroll
        for (int q = 0; q < 8; ++q) if (q < e) base += pad256((int)cnt[q]);
        const int n = (int)cnt[e];
        if (n + i < pad256(n)) { const int s = base + n + i; rowtok[s] = 0; rowdst[s] = -1; rowp[s] = 0.f; }
    }
}
struct MoeOrder {
    int npan, nN, G, c; const char* W; size_t estride, tstepB; const int* rows; const LAS int* pexp; int p0;
    __device__ bool next(int i, pg8::Unit& u) const {
        const int nwg = npan * nN; const long L = (long)i * G + c; if (L >= nwg) return false;
        int wgid = (int)L; { const int q = nwg / pg8::NXCD, r = nwg % pg8::NXCD, xcd = wgid % pg8::NXCD, off = wgid / pg8::NXCD; wgid = (xcd < r ? xcd * (q + 1) : r * (q + 1) + (xcd - r) * q) + off; }
        const int nig = pg8::WGM * nN, gid = wgid / nig, fm = gid * pg8::WGM, gsz = (npan - fm) < pg8::WGM ? (npan - fm) : pg8::WGM;
        u.pm = fm + ((wgid % nig) % gsz); u.pn = (wgid % nig) / gsz; return true; }
    __device__ __forceinline__ const char* b_base(const pg8::Unit& u) const { const int e = __builtin_amdgcn_readfirstlane(pexp[p0 + u.pm]); return W + (size_t)e * estride + (size_t)u.pn * tstepB; }
    __device__ __forceinline__ const int* a_rows(const pg8::Unit& u) const { return rows + (p0 + u.pm) * 256; }
};
struct MoeTailOrder {
    int ntail, G, c, kslice; const char* W; size_t estride, tstepB; const LAS int* pexp;
    __device__ bool next(int i, pg8::Unit& u) const { const int L = i * G + c; if (L >= ntail * 4 * MOE_KS) return false;
        u.ks = L % MOE_KS; u.pn = (L / MOE_KS) & 3; u.pm = L / (4 * MOE_KS); u.kt0 = u.ks * kslice; u.knt = kslice; return true; }
    __device__ __forceinline__ const char* b_base(const pg8::Unit& u) const { const int e = __builtin_amdgcn_readfirstlane(pexp[MOE_TAIL0 + u.pm]); return W + (size_t)e * estride + (size_t)u.pn * tstepB; }
    __device__ __forceinline__ const int* a_rows(const pg8::Unit&) const { return nullptr; }
};
__device__ __forceinline__ int moe_panels(const unsigned* cnt, LAS int* pexp, int tid) {
    int pb[9]; pb[0] = 0;
#pragma unroll
    for (int e = 0; e < 8; ++e) pb[e + 1] = pb[e] + pad256((int)cnt[e]) / 256;
    if (tid < MOE_SLOTS / 256) { int e = 0;
#pragma unroll
        for (int q = 1; q < 8; ++q) e += (tid >= pb[q]) ? 1 : 0;
        pexp[tid] = e; }
    __syncthreads();
    return pb[8];
}

__global__ void __launch_bounds__(NTHR, 2) fwd_kernel(Args args) {
    extern __shared__ __attribute__((aligned(16))) unsigned char lds_raw[];
    Frame F;
    F.lds = (LAS unsigned char*)lds_raw;
    F.tid = threadIdx.x; F.lane = F.tid & 63; F.wave = __builtin_amdgcn_readfirstlane(F.tid >> 6); F.G = gridDim.x; F.bid = blockIdx.x;
    typedef const unsigned char __attribute__((address_space(4))) kseg_t;
    kseg_t* kp0 = (kseg_t*)__builtin_amdgcn_kernarg_segment_ptr();
#define KARG(T, off) (*(T const __attribute__((address_space(4)))*)(kp + (off)))
#define PHASE_ENTER { int l_; asm volatile("v_mbcnt_lo_u32_b32 %0, -1, 0\n\tv_mbcnt_hi_u32_b32 %0, -1, %0" : "=v"(l_)); F.lane = l_; F.tid = F.wave * 64 + l_; } kseg_t* kp = kp0; asm volatile("" : "+s"(kp)); unsigned char* const ws = KARG(unsigned char*, 38 * 8 + 8); gu32* const ctl = (gu32*)(ws + WS_CTL); (void)ctl
#define INP(i) KARG(const float*, 8 * (i))
#define OUTP KARG(float*, 38 * 8)
#define WSP(T, off) ((T*)(ws + (off)))
    int lo, hi;
    { kseg_t* kp = kp0; lo = KARG(int, 38 * 8 + 16); hi = KARG(int, 38 * 8 + 20); }
    volatile LAS unsigned* MISC = (volatile LAS unsigned*)(F.lds + MISC_OFF);
    for (int u = F.tid; u < (LDS_BYTES - RING_BYTES) / 4; u += NTHR) ((LAS unsigned*)(F.lds + RING_BYTES))[u] = 0u;
    __syncthreads();
    const bool multi = (hi - lo) > 1;
    XcdBarrier bar; bar.x = 0; bar.st = nullptr;
    { PHASE_ENTER; bar.bar = (unsigned*)(ctl + CW_BAR); if (multi) bar = xcd_barrier_post((unsigned*)(ctl + CW_BAR), MISC + 8); }
#ifndef PH_MASK
#define PH_MASK 0xFFFFFFu
#endif
#define IN(k) (((PH_MASK >> (k)) & 1u) && lo <= (k) && (k) < hi)
#define SEAM(k) do { if (IN(k) && IN((k) + 1)) xcd_barrier(bar); } while (0)
#define W0IN WSP(bf16, WS_W0IN)
#define W0OUT WSP(bf16, WS_W0OUT)
#define W0GU WSP(bf16, WS_W0GU)
#define W0D WSP(bf16, WS_W0D)
#define W1IN WSP(bf16, WS_W1IN)
#define W1OUT WSP(bf16, WS_W1OUT)
#define XB WSP(bf16, WS_XB)
#define P WSP(bf16, WS_P)
#define X1 WSP(float, WS_X1)
#define HID WSP(bf16, WS_HID)
#define HB WSP(bf16, WS_H)
#define MIX ((bf16*)OUTP)
#define OUT OUTP
#define MOEGU ((bf16*)OUTP)
#define MOED WSP(bf16, WS_MOED)
#define Y0 WSP(bf16, WS_Y0)
#define Y1 WSP(bf16, WS_Y1)
#define MHID WSP(bf16, WS_MHID)
#define TOK_E WSP(int, WS_TAB + TAB_E)
#define TOK_P WSP(float, WS_TAB + TAB_P)
#define TOK_POS WSP(int, WS_TAB + TAB_POS)
#define ROWTOK WSP(int, WS_TAB + TAB_ROWTOK)
#define ROWDST WSP(int, WS_TAB + TAB_ROWDST)
#define ROWP WSP(float, WS_TAB + TAB_ROWP)
#define CNT ((unsigned*)(ctl + CW_CNT))
#define CSTAB WSP(float, WS_CS)
#define XA WSP(bf16, WS_H)
#define BCA WSP(bf16, WS_XB)
#define SMSB WSP(bf16, WS_XB + 32 * MiB)
    const int gw = F.bid * NWAVES + F.wave, NGW = F.G * NWAVES;
    LAS float* const scr = (LAS float*)(F.lds + F.wave * 16384);

    if (IN(0)) { PHASE_ENTER;
        transpose_job<1>(INP(I_EV_WIN), nullptr, 5936, 1024, W0IN, 6144, scr, gw, NGW, F.lane);
        transpose_job<0>(INP(I_EV_WOUT), nullptr, 1024, 2048, W0OUT, 1024, scr, gw, NGW, F.lane);
        transpose_job<2>(INP(I_FFN_WG), INP(I_FFN_WU), 3584, 1024, W0GU, 7168, scr, gw, NGW, F.lane);
        transpose_job<0>(INP(I_FFN_WD), nullptr, 1024, 3584, W0D, 1024, scr, gw, NGW, F.lane);
        transpose_job<0>(INP(I_OD_WIN), nullptr, 6144, 1024, W1IN, 6144, scr, gw, NGW, F.lane);
        transpose_job<0>(INP(I_OD_WOUT), nullptr, 1024, 2048, W1OUT, 1024, scr, gw, NGW, F.lane);
        const float* x = INP(I_X);
        for (size_t i = (size_t)(F.bid * NTHR + F.tid) * 8; i < (size_t)MTOK * DM; i += (size_t)F.G * NTHR * 8) {
            const f32x4 a = __builtin_nontemporal_load((const f32x4*)(x + i)), b = __builtin_nontemporal_load((const f32x4*)(x + i + 4));
            v4u o; o.x = pk2(a.x, a.y); o.y = pk2(a.z, a.w); o.z = pk2(b.x, b.y); o.w = pk2(b.z, b.w); *(v4u*)(XB + i) = o; }
    }
    SEAM(0);
    if (IN(1)) { PHASE_ENTER; pg8::StaticOrder S; S.init(MTOK, PW, F.G, F.bid, W0IN, 1024); pg8::EpiRoute0 E{P, L0_XBC, L0_RKVH, L0_SMB};
        pg8::gemm_phase<pg8::EpiRoute0, pg8::StaticOrder, true, false>(F.lds, XB, 1024, 1024, 1024, S, E); }
    SEAM(1);
    if (IN(2)) { PHASE_ENTER; conv_prepass(F, P, INP(I_CONVW), INP(I_CONVB), XA, BCA); small_prepass(F, P + L0_SMB, INP(I_MU), SMSB); }
    SEAM(2);
    if (IN(3)) { PHASE_ENTER;
        ssd_mfma(F, P, XA, BCA, INP(I_DTB), INP(I_ALOG), INP(I_DSKIP), MIX);
        __syncthreads();
        RwkvW W{INP(I_MU), INP(I_W0), INP(I_WUP), INP(I_A0), INP(I_AUP), INP(I_GUP), INP(I_KK), INP(I_KA), INP(I_RK), INP(I_RLNW), INP(I_RLNB)};
        rwkv_items(F, P, SMSB, W, MIX);
    }
    SEAM(3);
    if (IN(4)) { PHASE_ENTER; ssd_norm(F, MIX, INP(I_MNORM)); }
    SEAM(4);
    if (IN(5)) { PHASE_ENTER; pg8::StaticOrder S; S.init(MTOK, 1024, F.G, F.bid, W0OUT, 2048); pg8::EpiStore E{HB, 1024};
        pg8::gemm_phase<pg8::EpiStore, pg8::StaticOrder, true, false>(F.lds, MIX, 2048, 2048, 2048, S, E); }
    SEAM(5);
    if (IN(6)) { PHASE_ENTER; ln_rows<false, false>(F, INP(I_X), nullptr, HB, nullptr, INP(I_EV_LN1G), INP(I_EV_LN1B), nullptr, XB, 0, MTOK, nullptr, nullptr, nullptr, nullptr, nullptr); }
    SEAM(6);
    if (IN(7)) { PHASE_ENTER; pg8::StaticOrder S; S.init(MTOK, 2 * DFF, F.G, F.bid, W0GU, 1024); pg8::EpiSwiGLU E{HID, DFF};
        pg8::gemm_phase<pg8::EpiSwiGLU, pg8::StaticOrder, true, false>(F.lds, XB, 1024, 1024, 1024, S, E); }
    SEAM(7);
    if (IN(8)) { PHASE_ENTER; pg8::StaticOrder S; S.init(MTOK, 1024, F.G, F.bid, W0D, DFF); pg8::EpiStore E{HB, 1024};
        pg8::gemm_phase<pg8::EpiStore, pg8::StaticOrder, true, false>(F.lds, HID, DFF, DFF, DFF, S, E); }
    SEAM(8);
    if (IN(9)) { PHASE_ENTER; ln_rows<false, false>(F, nullptr, XB, HB, nullptr, INP(I_EV_LN2G), INP(I_EV_LN2B), nullptr, XB, 0, MTOK, nullptr, nullptr, nullptr, nullptr, nullptr); }
    SEAM(9);
    if (IN(10)) { PHASE_ENTER; pg8::StaticOrder S; S.init(MTOK, PW, F.G, F.bid, W1IN, 1024); pg8::EpiRoute1 E{P, L1_VH, L1_GB, (const int*)INP(I_POS)};
        pg8::gemm_phase<pg8::EpiRoute1, pg8::StaticOrder, true, false>(F.lds, XB, 1024, 1024, 1024, S, E); }
    SEAM(10);
    if (IN(11)) { PHASE_ENTER; retention_mfma(F, P); }
    SEAM(11);
    if (IN(12)) { PHASE_ENTER; retention_norm(F, P); }
    SEAM(12);
    if (IN(13)) { PHASE_ENTER; pg8::StaticOrder S; S.init(MTOK, 1024, F.G, F.bid, W1OUT, 2048); pg8::EpiStore E{HB, 1024};
        pg8::gemm_phase<pg8::EpiStore, pg8::StaticOrder, true, false>(F.lds, P + L1_GB, 2048, 2048, 2048, S, E); }
    SEAM(13);
    if (IN(14)) { PHASE_ENTER; ln_rows<true, false>(F, nullptr, XB, HB, nullptr, INP(I_OD_LN1G), INP(I_OD_LN1B), nullptr, XB, 0, MTOK, INP(I_ROUTER), CNT, TOK_E, TOK_P, TOK_POS); }
    SEAM(14);
    if (IN(15)) { PHASE_ENTER;
        for (int e = 0; e < NEXP; ++e) transpose_job<0>(INP(I_MOE_WD) + (size_t)e * DFF * 1024, nullptr, 1024, DFF, MOED + (size_t)e * 1024 * DFF, 1024, scr, gw, NGW, F.lane);
        for (int e = NEXP - 1; e >= 0; --e)
            transpose_job<2>(INP(I_MOE_WG) + (size_t)e * 1024 * DFF, INP(I_MOE_WU) + (size_t)e * 1024 * DFF, DFF, 1024, MOEGU + (size_t)e * 7168 * 1024, 7168, scr, gw, NGW, F.lane);
        moe_slots(F, CNT, TOK_E, TOK_P, TOK_POS, TOK_POS, ROWTOK, ROWDST, ROWP);
    }
    SEAM(15);
#pragma unroll
    for (int part = 0; part < 2; ++part) {
        const int pa = 16 + 2 * part;
        if (IN(pa)) { PHASE_ENTER;
            LAS int* pexp = (LAS int*)(F.lds + PEXP_OFF);
            const int ptot = moe_panels(CNT, pexp, F.tid); const int p0 = part ? MOE_P1 : 0, np = part ? ptot - MOE_P1 : (ptot < MOE_P1 ? ptot : MOE_P1);
            MoeOrder S{np, 28, F.G, F.bid, (const char*)MOEGU, (size_t)7168 * 1024 * 2, (size_t)256 * 1024 * 2, ROWTOK, pexp, p0};
            pg8::EpiSwiGLU E{MHID, DFF};
            pg8::gemm_phase<pg8::EpiSwiGLU, MoeOrder, true, true>(F.lds, XB, 1024, 1024, 1024, S, E);
        }
        SEAM(pa);
        if (IN(pa + 1)) { PHASE_ENTER;
            LAS int* pexp = (LAS int*)(F.lds + PEXP_OFF);
            const int ptot = moe_panels(CNT, pexp, F.tid); const int p0 = part ? MOE_P1 : 0, pend = ptot < (part ? MOE_TAIL0 : MOE_P1) ? ptot : (part ? MOE_TAIL0 : MOE_P1);
            MoeOrder S{pend - p0, 4, F.G, F.bid, (const char*)MOED, (size_t)1024 * DFF * 2, (size_t)256 * DFF * 2, nullptr, pexp, p0};
            pg8::EpiMoeOut E{Y0, Y1, 1024, MTOK, ROWDST + p0 * 256, ROWP + p0 * 256};
            pg8::gemm_phase<pg8::EpiMoeOut, MoeOrder, true, false>(F.lds, MHID, DFF, DFF, DFF, S, E);
            if (part == 1 && ptot > MOE_TAIL0) {
                __syncthreads();
                MoeTailOrder T{ptot - MOE_TAIL0, F.G, F.bid, DFF / 64 / MOE_KS, (const char*)MOED, (size_t)1024 * DFF * 2, (size_t)256 * DFF * 2, pexp};
                pg8::EpiSlab ES{WSP(float, WS_SLAB), 1024, MOE_KS};
                pg8::gemm_phase<pg8::EpiSlab, MoeTailOrder, true, false>(F.lds, MHID + (size_t)(MOE_TAIL0 - MOE_P1) * 256 * DFF, DFF, DFF, DFF, T, ES);
            }
        }
        SEAM(pa + 1);
    }
    if (IN(20)) { PHASE_ENTER; ln_rows<false, true>(F, nullptr, XB, Y0, Y1, INP(I_OD_LN2G), INP(I_OD_LN2B), OUT, nullptr, 0, MTOK, nullptr, nullptr, nullptr, TOK_P, TOK_POS, nullptr, nullptr, WSP(float, WS_SLAB)); }
#undef IN
#undef SEAM
#undef INP
#undef P
}
constexpr int N_PHASES = 21;

extern "C" void kernel_launch(void* const* d_in, const int* in_sizes, int n_in, void* d_out, int out_size, void* d_ws, size_t ws_size, hipStream_t stream) {
    static int grid = 0;
    if (grid == 0) {
        if (n_in != 38 || out_size != MTOK * DM || ws_size < WS_END) { fprintf(stderr, "kernel_launch: unexpected shapes (n_in %d out %d ws %zu)\n", n_in, out_size, ws_size); grid = -1; return; }
        int dev = 0, cus = 0;
        if (hipGetDevice(&dev) != hipSuccess || hipDeviceGetAttribute(&cus, hipDeviceAttributeMultiprocessorCount, dev) != hipSuccess) { grid = -1; return; }
        if (hipFuncSetAttribute((const void*)fwd_kernel, hipFuncAttributeMaxDynamicSharedMemorySize, LDS_BYTES) != hipSuccess) { grid = -1; return; }
        int per_cu = 0;
        (void)hipOccupancyMaxActiveBlocksPerMultiprocessor(&per_cu, (const void*)fwd_kernel, NTHR, LDS_BYTES);
        (void)hipGetLastError();
        grid = cus;
    }
    if (grid < 0) return;
    (void)hipMemsetAsync((char*)d_ws + WS_CTL, 0, CTL_ZERO_BYTES, stream);
    Args a{};
    for (int i = 0; i < 38; ++i) a.in[i] = d_in[i];
    a.out = (float*)d_out; a.ws = (unsigned char*)d_ws;
#if MK_ONE_LAUNCH
    a.ph_lo = 0; a.ph_hi = N_PHASES;
    hipLaunchKernelGGL(fwd_kernel, dim3(grid), dim3(NTHR), LDS_BYTES, stream, a);
#else
    for (int p = 0; p < N_PHASES; ++p) { a.ph_lo = p; a.ph_hi = p + 1; hipLaunchKernelGGL(fwd_kernel, dim3(grid), dim3(NTHR), LDS_BYTES, stream, a); }
#endif
}
```

```cpp
#include <hip/hip_runtime.h>
#include <cstdio>
#include <cstdint>

#ifndef MK_ONE_LAUNCH
#define MK_ONE_LAUNCH 1
#endif

namespace pg8 {
#define PG8_LAS __attribute__((address_space(3)))
typedef unsigned short bf16_t;
typedef short bf16x8 __attribute__((ext_vector_type(8)));
typedef float f32x4 __attribute__((ext_vector_type(4)));
typedef unsigned u32x4 __attribute__((ext_vector_type(4)));
constexpr int BM = 256, BK = 64, HALF = 128, HTB = HALF * BK * 2, STAGE_BYTES = 8 * HTB, NXCD = 8, WGM = 8;

__host__ __device__ __forceinline__ int lds_byte(int r, int c) { const int st = (r >> 4) * 2 + (c >> 5), rr = r & 15, cc = c & 31, ob = rr * 64 + cc * 2; return st * 1024 + (ob ^ (((ob >> 9) & 1) << 5)); }
__host__ __device__ __forceinline__ void stage_rc(int b, int& R, int& C) { const int st = b / 1024, sb = b % 1024, swz = sb ^ (((sb >> 9) & 1) << 5); R = (st >> 1) * 16 + swz / 64; C = (st & 1) * 32 + (swz % 64) / 2; }
__host__ __device__ __forceinline__ int perm32(int rho) { const int n = rho >> 4, i = rho & 15; return 8 * (i >> 2) + 4 * n + (i & 3); }

struct Unit { int pm, pn; };

struct StaticOrder {
    int nM, nN, nwg, G, c; const char* Bt; size_t tstepB;
    __device__ void init(int M, int N, int G_, int c_, const bf16_t* Bt_, int ldb) { nM = M / BM; nN = N / BM; nwg = nM * nN; G = G_; c = c_; Bt = (const char*)Bt_; tstepB = (size_t)BM * ldb * 2; }
    __device__ bool next(int i, Unit& u) const {
        const long L = (long)i * G + c; if (L >= nwg) return false;
        int wgid = (int)L; { const int q = nwg / NXCD, r = nwg % NXCD, xcd = wgid % NXCD, off = wgid / NXCD; wgid = (xcd < r ? xcd * (q + 1) : r * (q + 1) + (xcd - r) * q) + off; }
        const int nig = WGM * nN, gid = wgid / nig, fm = gid * WGM, gsz = (nM - fm) < WGM ? (nM - fm) : WGM;
        u.pm = fm + ((wgid % nig) % gsz); u.pn = (wgid % nig) / gsz; return true;
    }
    __device__ __forceinline__ const char* b_base(const Unit& u) const { return Bt + (size_t)u.pn * tstepB; }
    __device__ __forceinline__ const int* a_rows(const Unit&) const { return nullptr; }
};

__device__ __forceinline__ unsigned cvt_pk_bf16(float lo, float hi) { unsigned r; asm volatile("v_cvt_pk_bf16_f32 %0, %1, %2" : "=v"(r) : "v"(lo), "v"(hi)); return r; }
__device__ __forceinline__ float silu_f(float x) { return x * __builtin_amdgcn_rcpf(1.0f + __expf(-x)); }

struct EpiStore {
    static constexpr bool PERM = true, AFTER_DRAIN = false;
    bf16_t* O; int ldc;
    __device__ __forceinline__ void operator()(const f32x4 (&acc)[2][2][4][2], const Unit& u, int wr, int wc, int fr, int fq) const {
        const int row0 = u.pm * BM + wr * 64 + fr, col0 = u.pn * BM + wc * 32 + 8 * fq;
#pragma unroll
        for (int ai = 0; ai < 2; ++ai)
#pragma unroll
            for (int m = 0; m < 4; ++m) { bf16_t* rowp = O + (size_t)(row0 + ai * HALF + m * 16) * ldc + col0;
#pragma unroll
                for (int bj = 0; bj < 2; ++bj) { const f32x4 v0 = acc[ai][bj][m][0], v1 = acc[ai][bj][m][1];
                    u32x4 w; w.x = cvt_pk_bf16(v0[0], v0[1]); w.y = cvt_pk_bf16(v0[2], v0[3]); w.z = cvt_pk_bf16(v1[0], v1[1]); w.w = cvt_pk_bf16(v1[2], v1[3]);
                    *(u32x4*)(rowp + bj * HALF) = w; } }
    }
};
struct EpiStoreRot {
    static constexpr bool PERM = true, AFTER_DRAIN = false;
    bf16_t* O; int ldc; const float* cs;
    __device__ __forceinline__ void operator()(const f32x4 (&acc)[2][2][4][2], const Unit& u, int wr, int wc, int fr, int fq) const {
        const int row0 = u.pm * BM + wr * 64 + fr, col0 = u.pn * BM + wc * 32 + 8 * fq;
        const bool rot = u.pn < 8; const float sc = u.pn >= 4 ? 0.0625f : 1.0f;
#pragma unroll
        for (int ai = 0; ai < 2; ++ai)
#pragma unroll
            for (int m = 0; m < 4; ++m) { const int row = row0 + ai * HALF + m * 16; bf16_t* rowp = O + (size_t)row * ldc + col0;
#pragma unroll
                for (int bj = 0; bj < 2; ++bj) { f32x4 v0 = acc[ai][bj][m][0], v1 = acc[ai][bj][m][1];
                    if (rot) { const int i0 = ((col0 + bj * HALF) & 255) >> 1; const float* cp = cs + ((size_t)row * 128 + i0) * 2;
                        const f32x4 c01 = *(const f32x4*)cp, c23 = *(const f32x4*)(cp + 4);
                        const f32x4 r0 = (f32x4){v0[0] * c01[0] - v0[1] * c01[1], v0[1] * c01[0] + v0[0] * c01[1], v0[2] * c01[2] - v0[3] * c01[3], v0[3] * c01[2] + v0[2] * c01[3]};
                        const f32x4 r1 = (f32x4){v1[0] * c23[0] - v1[1] * c23[1], v1[1] * c23[0] + v1[0] * c23[1], v1[2] * c23[2] - v1[3] * c23[3], v1[3] * c23[2] + v1[2] * c23[3]};
                        v0 = r0 * sc; v1 = r1 * sc; }
                    u32x4 w; w.x = cvt_pk_bf16(v0[0], v0[1]); w.y = cvt_pk_bf16(v0[2], v0[3]); w.z = cvt_pk_bf16(v1[0], v1[1]); w.w = cvt_pk_bf16(v1[2], v1[3]);
                    *(u32x4*)(rowp + bj * HALF) = w; } }
    }
};
struct EpiRoute0 {
    static constexpr bool PERM = true, AFTER_DRAIN = false;
    bf16_t* base; size_t o_xbc, o_rkvh, o_smb;
    __device__ __forceinline__ void operator()(const f32x4 (&acc)[2][2][4][2], const Unit& u, int wr, int wc, int fr, int fq) const {
        const int row0 = u.pm * BM + wr * 64 + fr, col0 = u.pn * BM + wc * 32 + 8 * fq, pn = u.pn;
#pragma unroll
        for (int ai = 0; ai < 2; ++ai)
#pragma unroll
            for (int m = 0; m < 4; ++m) { const int row = row0 + ai * HALF + m * 16, b = row >> 11, t = row & 2047;
#pragma unroll
                for (int bj = 0; bj < 2; ++bj) { const int col = col0 + bj * HALF; bf16_t* dst; bool ok = true;
                    if (pn < 4) dst = base + ((size_t)(b * 16 + (col >> 6)) * 2048 + t) * 64 + (col & 63);
                    else if (pn < 10) dst = base + o_xbc + (size_t)row * 1536 + (col - 1024);
                    else if (pn < 22) { const int cc = col - 2560; dst = base + o_rkvh + ((size_t)(b * 16 + ((cc & 1023) >> 6)) * 2048 + t) * 192 + (cc >> 10) * 64 + (cc & 63); }
                    else { const int cc = col - 5632; ok = cc < 320; dst = base + o_smb + (size_t)row * 320 + cc; }
                    const f32x4 v0 = acc[ai][bj][m][0], v1 = acc[ai][bj][m][1];
                    u32x4 w; w.x = cvt_pk_bf16(v0[0], v0[1]); w.y = cvt_pk_bf16(v0[2], v0[3]); w.z = cvt_pk_bf16(v1[0], v1[1]); w.w = cvt_pk_bf16(v1[2], v1[3]);
                    if (ok) *(u32x4*)dst = w; } }
    }
};
struct EpiRoute1 {
    static constexpr bool PERM = true, AFTER_DRAIN = false;
    bf16_t* base; size_t o_vh, o_gb; const int* pos;
    __device__ __forceinline__ void operator()(const f32x4 (&acc)[2][2][4][2], const Unit& u, int wr, int wc, int fr, int fq) const {
        const int row0 = u.pm * BM + wr * 64 + fr, col0 = u.pn * BM + wc * 32 + 8 * fq, pn = u.pn;
        const bool rot = pn < 8; const float sc = pn >= 4 ? 0.0625f : 1.0f;
        float frq[2][4];
#pragma unroll
        for (int bj = 0; bj < 2; ++bj)
#pragma unroll
            for (int q = 0; q < 4; ++q) frq[bj][q] = __builtin_amdgcn_exp2f((float)((((col0 + bj * HALF) & 255) >> 1) + q) * (-13.287712379549449f / 127.0f)) * 0.15915494309189535f;
#pragma unroll
        for (int ai = 0; ai < 2; ++ai)
#pragma unroll
            for (int m = 0; m < 4; ++m) { const int row = row0 + ai * HALF + m * 16, b = row >> 11, t = row & 2047; const float ps = rot ? (float)pos[row] : 0.f;
#pragma unroll
                for (int bj = 0; bj < 2; ++bj) { const int col = col0 + bj * HALF; f32x4 v0 = acc[ai][bj][m][0], v1 = acc[ai][bj][m][1]; bf16_t* dst;
                    if (rot) { const int cc = col & 1023;
                        float cs_[8];
#pragma unroll
                        for (int q = 0; q < 4; ++q) { const float rev = __builtin_amdgcn_fractf(ps * frq[bj][q]); cs_[2 * q] = __builtin_amdgcn_cosf(rev); cs_[2 * q + 1] = __builtin_amdgcn_sinf(rev); }
                        const f32x4 c01 = (f32x4){cs_[0], cs_[1], cs_[2], cs_[3]}, c23 = (f32x4){cs_[4], cs_[5], cs_[6], cs_[7]};
                        const f32x4 r0 = (f32x4){v0[0] * c01[0] - v0[1] * c01[1], v0[1] * c01[0] + v0[0] * c01[1], v0[2] * c01[2] - v0[3] * c01[3], v0[3] * c01[2] + v0[2] * c01[3]};
                        const f32x4 r1 = (f32x4){v1[0] * c23[0] - v1[1] * c23[1], v1[1] * c23[0] + v1[0] * c23[1], v1[2] * c23[2] - v1[3] * c23[3], v1[3] * c23[2] + v1[2] * c23[3]};
                        v0 = r0 * sc; v1 = r1 * sc;
                        dst = base + ((size_t)(b * 4 + (cc >> 8)) * 2048 + t) * 512 + (pn >> 2) * 256 + (cc & 255); }
                    else if (pn < 16) { const int cc = col - 2048; dst = base + o_vh + ((size_t)((b * 4 + (cc >> 9)) * 4 + ((cc & 511) >> 7)) * 2048 + t) * 128 + (cc & 127); }
                    else dst = base + o_gb + (size_t)row * 2048 + (col - 4096);
                    u32x4 w; w.x = cvt_pk_bf16(v0[0], v0[1]); w.y = cvt_pk_bf16(v0[2], v0[3]); w.z = cvt_pk_bf16(v1[0], v1[1]); w.w = cvt_pk_bf16(v1[2], v1[3]);
                    *(u32x4*)dst = w; } }
    }
};
struct EpiSwiGLU {
    static constexpr bool PERM = true, AFTER_DRAIN = false;
    bf16_t* H; int ldc;
    __device__ __forceinline__ void operator()(const f32x4 (&acc)[2][2][4][2], const Unit& u, int wr, int wc, int fr, int fq) const {
        const int row0 = u.pm * BM + wr * 64 + fr, col0 = u.pn * HALF + wc * 32 + 8 * fq;
#pragma unroll
        for (int ai = 0; ai < 2; ++ai)
#pragma unroll
            for (int m = 0; m < 4; ++m) { bf16_t* rowp = H + (size_t)(row0 + ai * HALF + m * 16) * ldc + col0;
                float o[8];
#pragma unroll
                for (int n = 0; n < 2; ++n)
#pragma unroll
                    for (int j = 0; j < 4; ++j) o[n * 4 + j] = silu_f(acc[ai][0][m][n][j]) * acc[ai][1][m][n][j];
                u32x4 w; w.x = cvt_pk_bf16(o[0], o[1]); w.y = cvt_pk_bf16(o[2], o[3]); w.z = cvt_pk_bf16(o[4], o[5]); w.w = cvt_pk_bf16(o[6], o[7]);
                __builtin_nontemporal_store(w, (u32x4*)rowp); }
    }
};
struct EpiMoeOut {
    static constexpr bool PERM = true, AFTER_DRAIN = false;
    bf16_t* Y0; bf16_t* Y1; int ldc; int nhalf; const int* rowdst; const float* rowp;
    __device__ __forceinline__ void operator()(const f32x4 (&acc)[2][2][4][2], const Unit& u, int wr, int wc, int fr, int fq) const {
        const int row0 = u.pm * BM + wr * 64 + fr, col0 = u.pn * BM + wc * 32 + 8 * fq;
#pragma unroll
        for (int ai = 0; ai < 2; ++ai)
#pragma unroll
            for (int m = 0; m < 4; ++m) { const int slot = row0 + ai * HALF + m * 16; const int dst = rowdst[slot]; const float p = rowp[slot];
                if (dst >= 0) { bf16_t* rowpt = (dst >= nhalf ? Y1 + (size_t)(dst - nhalf) * ldc : Y0 + (size_t)dst * ldc) + col0;
#pragma unroll
                    for (int bj = 0; bj < 2; ++bj) { const f32x4 v0 = acc[ai][bj][m][0] * p, v1 = acc[ai][bj][m][1] * p;
                        u32x4 w; w.x = cvt_pk_bf16(v0[0], v0[1]); w.y = cvt_pk_bf16(v0[2], v0[3]); w.z = cvt_pk_bf16(v1[0], v1[1]); w.w = cvt_pk_bf16(v1[2], v1[3]);
                        *(u32x4*)(rowpt + bj * HALF) = w; } }
                asm volatile("" ::: "memory"); }
    }
};

template <class Epi, class Sched, bool ALIGN_EPI, bool GATHER>
__device__ __forceinline__ void gemm_phase(PG8_LAS unsigned char* lds, const bf16_t* Abase, int lda, int ldb, int K, const Sched& S, const Epi& E) {
    const int tid = threadIdx.x, wid = __builtin_amdgcn_readfirstlane(tid >> 6), lane = tid & 63, wr = wid >> 2, wc = wid & 3, fr = lane & 15, fq = lane >> 4;
    const int nt = K / BK;
    int RA[2], CA[2]; unsigned voffB[2];
#pragma unroll
    for (int i = 0; i < 2; ++i) { int R, C; stage_rc(tid * 16 + i * 8192, R, C); const int Rb = Epi::PERM ? ((R & ~31) + perm32(R & 31)) : R;
        RA[i] = R; CA[i] = C; voffB[i] = (unsigned)(Rb * ldb + C) * 2u; }
    const size_t kstep = (size_t)(BK * 2);
    const size_t hstepB = (size_t)HALF * ldb * 2;
    const size_t tstepA = (size_t)BM * lda * 2;
    const unsigned ldsw = (unsigned)wid * 1024u;
    const int aoff = lds_byte(wr * 64 + fr, fq * 8), boff = lds_byte(wc * 32 + fr, fq * 8);
#define PG8_SA(b, h) (((b) * 2 + (h)) * HTB)
#define PG8_SB(b, h) ((4 + (b) * 2 + (h)) * HTB)
#define PG8_STAGE(bufoff, gbase, voff) do { _Pragma("unroll") for (int _i = 0; _i < 2; ++_i) \
        __builtin_amdgcn_global_load_lds((const unsigned*)((const char*)(gbase) + (voff)[_i]), (PG8_LAS unsigned*)(lds + (bufoff) + ldsw + _i * 8192), 16, 0, 0); } while (0)
#define PG8_LDA(dst, b, h) do { _Pragma("unroll") for (int m = 0; m < 4; ++m) _Pragma("unroll") for (int k = 0; k < 2; ++k) dst[m][k] = *(const PG8_LAS bf16x8*)(lds + PG8_SA(b, h) + aoff + m * 2048 + k * 1024); } while (0)
#define PG8_LDB(dst, b, h) do { _Pragma("unroll") for (int n = 0; n < 2; ++n) _Pragma("unroll") for (int k = 0; k < 2; ++k) dst[n][k] = *(const PG8_LAS bf16x8*)(lds + PG8_SB(b, h) + boff + n * 2048 + k * 1024); } while (0)
#define PG8_MMA(ai, bj, At, Bt) do { __builtin_amdgcn_s_setprio(1); _Pragma("unroll") for (int m = 0; m < 4; ++m) _Pragma("unroll") for (int n = 0; n < 2; ++n) _Pragma("unroll") for (int k = 0; k < 2; ++k) \
        acc[ai][bj][m][n] = __builtin_amdgcn_mfma_f32_16x16x32_bf16(Bt[n][k], At[m][k], acc[ai][bj][m][n], 0, 0, 0); __builtin_amdgcn_s_setprio(0); } while (0)
#define PG8_WAIT_V(n) asm volatile("s_waitcnt vmcnt(" #n ")" ::: "memory")
#define PG8_WAIT_L(n) asm volatile("s_waitcnt lgkmcnt(" #n ")" ::: "memory")
#define PG8_BAR __builtin_amdgcn_s_barrier()
#define PG8_SCHED __builtin_amdgcn_sched_barrier(0)
    Unit cur, nxt; int ui = 0;
    if (!S.next(0, cur)) return;
    f32x4 acc[2][2][4][2];
#pragma unroll
    for (int a = 0; a < 2; ++a)
#pragma unroll
        for (int b = 0; b < 2; ++b)
#pragma unroll
            for (int m = 0; m < 4; ++m)
#pragma unroll
                for (int n = 0; n < 2; ++n) acc[a][b][m][n] = (f32x4){0.f, 0.f, 0.f, 0.f};
    bf16x8 At[4][2], B0[2][2], B1[2][2];
    unsigned vA[2][2];
    const char* cA; const char* cB = S.b_base(cur);
    PG8_LAS int* const rowslot = (PG8_LAS int*)(lds + STAGE_BYTES + 4096);
#define PG8_ROWS_DMA(slot, rows) do { if (wid < 4) __builtin_amdgcn_global_load_lds((const unsigned*)((rows) + tid), (PG8_LAS unsigned*)(rowslot + (slot) * 256 + wid * 64), 4, 0, 0); } while (0)
#define PG8_GOFF(dst, slot) do { _Pragma("unroll") for (int _h = 0; _h < 2; ++_h) _Pragma("unroll") for (int _i = 0; _i < 2; ++_i) dst[_h][_i] = (unsigned)(rowslot[(slot) * 256 + _h * HALF + RA[_i]] * lda + CA[_i]) * 2u; } while (0)
    if constexpr (GATHER) { cA = (const char*)Abase; PG8_ROWS_DMA(0, S.a_rows(cur)); PG8_WAIT_V(0); PG8_BAR; PG8_GOFF(vA, 0); }
    else { cA = (const char*)Abase + (size_t)cur.pm * tstepA;
#pragma unroll
        for (int h = 0; h < 2; ++h)
#pragma unroll
            for (int i = 0; i < 2; ++i) vA[h][i] = (unsigned)((h * HALF + RA[i]) * lda + CA[i]) * 2u;
    }
    PG8_STAGE(PG8_SB(0, 0), cB, voffB); PG8_STAGE(PG8_SB(0, 1), cB + hstepB, voffB); PG8_STAGE(PG8_SA(0, 0), cA, vA[0]); PG8_STAGE(PG8_SA(0, 1), cA, vA[1]);
    if (wr == 1) PG8_BAR;
    PG8_WAIT_V(2); PG8_BAR;
    PG8_STAGE(PG8_SB(1, 0), cB + kstep, voffB); PG8_STAGE(PG8_SA(1, 0), cA + kstep, vA[0]); PG8_STAGE(PG8_SB(1, 1), cB + hstepB + kstep, voffB);
    PG8_WAIT_V(6); PG8_BAR;
    for (;;) {
        const bool has_next = S.next(ui + 1, nxt);
        const char* nA; const char* nB = has_next ? S.b_base(nxt) : cB;
        if constexpr (GATHER) { nA = cA; if (has_next) PG8_ROWS_DMA((ui + 1) & 1, S.a_rows(nxt)); }
        else nA = has_next ? (const char*)Abase + (size_t)nxt.pm * tstepA : cA;
        for (int t = 0; t < nt; t += 2) {
            const bool last = (t == nt - 2);
            const char* a1 = cA + (size_t)(t + 1) * kstep;
            const char* a2 = last ? nA : cA + (size_t)(t + 2) * kstep; const char* b2 = last ? nB : cB + (size_t)(t + 2) * kstep;
            const char* a3 = a2 + kstep; const char* b3 = b2 + kstep;
            unsigned v2[2][2];
            if constexpr (GATHER) { if (last && has_next) PG8_GOFF(v2, (ui + 1) & 1); else PG8_GOFF(v2, ui & 1); PG8_GOFF(vA, ui & 1); }
            else {
#pragma unroll
                for (int h = 0; h < 2; ++h)
#pragma unroll
                    for (int i = 0; i < 2; ++i) v2[h][i] = vA[h][i];
            }
            PG8_LDB(B0, 0, 0); PG8_LDB(B1, 0, 1); PG8_SCHED; PG8_LDA(At, 0, 0); PG8_STAGE(PG8_SA(1, 1), a1, vA[1]);
            PG8_WAIT_V(8); PG8_WAIT_L(0); PG8_BAR; PG8_MMA(0, 0, At, B0); PG8_MMA(0, 1, At, B1); PG8_BAR; PG8_SCHED;
            PG8_LDA(At, 0, 1); PG8_STAGE(PG8_SB(0, 0), b2, voffB); PG8_STAGE(PG8_SB(0, 1), b2 + hstepB, voffB); PG8_STAGE(PG8_SA(0, 0), a2, v2[0]);
            PG8_WAIT_V(8); PG8_WAIT_L(0); PG8_BAR; PG8_MMA(1, 0, At, B0); PG8_MMA(1, 1, At, B1); PG8_BAR; PG8_SCHED;
            PG8_LDB(B0, 1, 0); PG8_LDB(B1, 1, 1); PG8_SCHED; PG8_LDA(At, 1, 0); PG8_STAGE(PG8_SA(0, 1), a2, v2[1]);
            PG8_WAIT_V(8); PG8_WAIT_L(0); PG8_BAR; PG8_MMA(0, 0, At, B0); PG8_MMA(0, 1, At, B1); PG8_BAR; PG8_SCHED;
            PG8_LDA(At, 1, 1); PG8_STAGE(PG8_SB(1, 0), b3, voffB); PG8_STAGE(PG8_SB(1, 1), b3 + hstepB, voffB); PG8_STAGE(PG8_SA(1, 0), a3, v2[0]);
            PG8_WAIT_V(8); PG8_WAIT_L(0); PG8_BAR; PG8_MMA(1, 0, At, B0); PG8_MMA(1, 1, At, B1); PG8_BAR; PG8_SCHED;
        }
        if constexpr (ALIGN_EPI) { if (wr == 0) PG8_BAR; }
        E(acc, cur, wr, wc, fr, fq);
        if (!has_next) break;
#pragma unroll
        for (int a = 0; a < 2; ++a)
#pragma unroll
            for (int b = 0; b < 2; ++b)
#pragma unroll
                for (int m = 0; m < 4; ++m)
#pragma unroll
                    for (int n = 0; n < 2; ++n) acc[a][b][m][n] = (f32x4){0.f, 0.f, 0.f, 0.f};
        cur = nxt; cA = nA; cB = nB; ++ui;
        if constexpr (ALIGN_EPI) { if (wr == 1) PG8_BAR; }
    }
    PG8_WAIT_V(0);
    if constexpr (!ALIGN_EPI) { if (wr == 0) PG8_BAR; }
    PG8_BAR;
#undef PG8_SA
#undef PG8_SB
#undef PG8_STAGE
#undef PG8_LDA
#undef PG8_LDB
#undef PG8_MMA
#undef PG8_WAIT_V
#undef PG8_WAIT_L
#undef PG8_BAR
#undef PG8_SCHED
#undef PG8_ROWS_DMA
#undef PG8_GOFF
}
}

constexpr int NWAVES = 8, NTHR = 512;
constexpr int BATCH = 16, SEQ = 2048, DM = 1024, MTOK = BATCH * SEQ;
constexpr int PW = 6144;
constexpr int DFF = 3584, NEXP = 8;
constexpr int MOE_P1 = 128, MOE_ROWS = (MTOK * 2 / 256 - MOE_P1 + NEXP) * 256, MOE_SLOTS = MTOK * 2 + NEXP * 256;
constexpr float ALPHA = 1.4142135623730951f;
constexpr float LN_EPS = 1e-5f;
constexpr int PC_Z = 0, PC_XBC = 1024, PC_RKV = 2560, PC_SM = 5632, PC_DT = 5920;
constexpr size_t L0_ZH = 0, L0_XBC = (size_t)MTOK * 1024, L0_RKVH = (size_t)MTOK * 2560, L0_SMB = (size_t)MTOK * 5632;
constexpr size_t L1_QKH = 0, L1_VH = (size_t)MTOK * 2048, L1_GB = (size_t)MTOK * 4096;

constexpr size_t MiB = 1u << 20;
constexpr size_t WS_CTL = 0, CTL_ZERO_BYTES = 1 * MiB;
constexpr size_t WS_W0IN = 1 * MiB, WS_W0OUT = 13 * MiB, WS_W0GU = 17 * MiB, WS_W0D = 31 * MiB, WS_W1IN = 38 * MiB, WS_W1OUT = 50 * MiB;
constexpr size_t WS_XB = 54 * MiB;
constexpr size_t WS_P = 118 * MiB;
constexpr size_t WS_X1 = 118 * MiB;
constexpr size_t WS_HID = 246 * MiB;
constexpr size_t WS_H = 502 * MiB;
constexpr size_t WS_MOED = 118 * MiB;
constexpr size_t WS_Y0 = 174 * MiB, WS_Y1 = 238 * MiB, WS_MHID = 302 * MiB;
constexpr size_t WS_CS = 1 * MiB;
constexpr size_t WS_TAB = 34 * MiB;
constexpr size_t TAB_E = 0, TAB_P = 128 * 1024, TAB_POS = 256 * 1024, TAB_ROWTOK = 512 * 1024, TAB_ROWDST = 1024 * 1024, TAB_ROWP = 1536 * 1024;
constexpr size_t WS_END = 566 * MiB;
constexpr int CW_TMO = 0, CW_BAR = 4096, CW_CNT = 8192;

constexpr int RING_BYTES = 131072, MISC_OFF = RING_BYTES + 320, LCNT_OFF = RING_BYTES + 512, PEXP_OFF = RING_BYTES + 1024, LDS_BYTES = 147456;

#define GAS __attribute__((address_space(1)))
#define LAS __attribute__((address_space(3)))
typedef unsigned short bf16;
typedef unsigned v4u __attribute__((ext_vector_type(4)));
typedef unsigned v2u __attribute__((ext_vector_type(2)));
typedef float f32x4 __attribute__((ext_vector_type(4)));
typedef GAS unsigned gu32;
#define RLX_AGENT __ATOMIC_RELAXED, __HIP_MEMORY_SCOPE_AGENT
#define LDS_WAIT() asm volatile("s_waitcnt lgkmcnt(0)" ::: "memory")
__device__ __forceinline__ unsigned f2bf(float f) { unsigned u = __builtin_bit_cast(unsigned, f); return (u + 0x7fffu + ((u >> 16) & 1u)) >> 16; }
__device__ __forceinline__ unsigned pk2(float lo, float hi) { return f2bf(lo) | (f2bf(hi) << 16); }
__device__ __forceinline__ float bf2f(bf16 v) { return __builtin_bit_cast(float, (unsigned)v << 16); }
__device__ __forceinline__ float bflo(unsigned w) { return __builtin_bit_cast(float, w << 16); }
__device__ __forceinline__ float bfhi(unsigned w) { return __builtin_bit_cast(float, w & 0xffff0000u); }
__device__ __forceinline__ float sigmoid_f(float x) { return 1.0f / (1.0f + __expf(-x)); }
__device__ __forceinline__ float silu_f(float x) { return x / (1.0f + __expf(-x)); }
__device__ __forceinline__ float softplus_f(float x) { return x > 20.f ? x : log1pf(__expf(x)); }
__device__ __forceinline__ float wave_sum(float v) {
    v += __builtin_bit_cast(float, __builtin_amdgcn_update_dpp(0, __builtin_bit_cast(int, v), 0x128, 0xf, 0xf, true));
    v += __builtin_bit_cast(float, __builtin_amdgcn_update_dpp(0, __builtin_bit_cast(int, v), 0x124, 0xf, 0xf, true));
    v += __builtin_bit_cast(float, __builtin_amdgcn_update_dpp(0, __builtin_bit_cast(int, v), 0x122, 0xf, 0xf, true));
    v += __builtin_bit_cast(float, __builtin_amdgcn_update_dpp(0, __builtin_bit_cast(int, v), 0x121, 0xf, 0xf, true));
    const float r0 = __builtin_bit_cast(float, __builtin_amdgcn_readlane(__builtin_bit_cast(int, v), 0)), r1 = __builtin_bit_cast(float, __builtin_amdgcn_readlane(__builtin_bit_cast(int, v), 16));
    const float r2 = __builtin_bit_cast(float, __builtin_amdgcn_readlane(__builtin_bit_cast(int, v), 32)), r3 = __builtin_bit_cast(float, __builtin_amdgcn_readlane(__builtin_bit_cast(int, v), 48));
    return (r0 + r1) + (r2 + r3);
}

#define LDS_BARRIER() asm volatile("s_waitcnt lgkmcnt(0)\n\ts_barrier" ::: "memory")
#define XB_TMO      128
#define XB_XCNT(j)  (256  + 64 * (j))
#define XB_XSUB(j)  (1280 + 64 * (j))
#define XB_XGEN(j)  (2304 + 64 * (j))
#define XB_TOP      3328
#define XB_TOPGEN   3392
#define XCD_BAR_WORDS 3456
#define XB_SPIN_CAP (1u << 18)
__device__ __forceinline__ unsigned xb_ld(unsigned* p)              { return __hip_atomic_load(p, __ATOMIC_RELAXED, __HIP_MEMORY_SCOPE_AGENT); }
__device__ __forceinline__ unsigned xb_add(unsigned* p, unsigned v) { return __hip_atomic_fetch_add(p, v, __ATOMIC_RELAXED, __HIP_MEMORY_SCOPE_AGENT); }
__device__ __forceinline__ unsigned xb_xcc_id() { return (unsigned)__builtin_amdgcn_s_getreg((3 << 11) | 20) & 0xFu; }
#define XB_SPIN(cond, bar) do { unsigned _sp = 0; while (cond) { __builtin_amdgcn_s_sleep(1); \
    if ((++_sp & 255u) == 0u) { if (xb_ld(&(bar)[XB_TMO])) break; if (_sp > XB_SPIN_CAP) { atomicAdd(&(bar)[XB_TMO], 1u); break; } } } } while (0)
struct XcdBarrier { unsigned* bar; unsigned x; volatile LAS unsigned* st; };
__device__ __forceinline__ XcdBarrier xcd_barrier_post(unsigned* bar, volatile LAS unsigned* st) {
    XcdBarrier b; b.bar = bar; b.x = xb_xcc_id(); b.st = st;
    if (threadIdx.x == 0) (void)xb_add(&bar[XB_XCNT(b.x)], 1u);
    return b;
}
__device__ __forceinline__ void xcd_barrier_complete(unsigned* bar, unsigned x, unsigned& nloc, unsigned& nx) {
    const unsigned G = gridDim.x * gridDim.y * gridDim.z;
    unsigned sum, cnt, mine, sp = 0u;
    for (;;) {
        sum = 0u; cnt = 0u; mine = 0u;
#pragma unroll
        for (unsigned j = 0; j < 16; ++j) { const unsigned c = xb_ld(&bar[XB_XCNT(j)]); sum += c; cnt += (c > 0u) ? 1u : 0u; mine = (j == x) ? c : mine; }
        if (sum == G) break;
        __builtin_amdgcn_s_sleep(1);
        if ((++sp & 255u) == 0u) { if (xb_ld(&bar[XB_TMO])) break; if (sp > XB_SPIN_CAP) { atomicAdd(&bar[XB_TMO], 1u); break; } }
    }
    nloc = mine > 0u ? mine : 1u; nx = cnt > 0u ? cnt : 1u;
}
__device__ __forceinline__ void xcd_barrier(const XcdBarrier& b) {
    asm volatile("s_waitcnt vmcnt(0)" ::: "memory");
    __syncthreads();
    if (threadIdx.x == 0) {
        unsigned* bar = b.bar;
        __builtin_amdgcn_s_waitcnt(0);
        unsigned nloc = b.st[0], nx = b.st[1];
        if (nloc == 0u) { xcd_barrier_complete(bar, b.x, nloc, nx); b.st[0] = nloc; b.st[1] = nx; }
        const unsigned old = xb_add(&bar[XB_XSUB(b.x)], 1u);
        const unsigned gen = old / nloc;
        if (old + 1u == (gen + 1u) * nloc) {
            __builtin_amdgcn_fence(__ATOMIC_RELEASE, "agent");
            asm volatile("s_waitcnt vmcnt(0)" ::: "memory");
            const unsigned og = xb_add(&bar[XB_TOP], 1u);
            const unsigned tg = og / nx;
            if (og + 1u == (tg + 1u) * nx) xb_add(&bar[XB_TOPGEN], 1u);
            else XB_SPIN(xb_ld(&bar[XB_TOPGEN]) == tg, bar);
            __builtin_amdgcn_fence(__ATOMIC_ACQUIRE, "agent");
            xb_add(&bar[XB_XGEN(b.x)], 1u);
            asm volatile("s_waitcnt vmcnt(0)" ::: "memory");
        } else {
            XB_SPIN(xb_ld(&bar[XB_XGEN(b.x)]) == gen, bar);
            __builtin_amdgcn_fence(__ATOMIC_ACQUIRE, "agent");
            asm volatile("s_waitcnt vmcnt(0)" ::: "memory");
        }
    }
    __syncthreads();
}

struct Args { const void* in[38]; float* out; unsigned char* ws; int ph_lo, ph_hi; };
enum { I_X = 0, I_POS, I_EV_WIN, I_CONVW, I_CONVB, I_DTB, I_ALOG, I_DSKIP, I_MNORM, I_MU, I_W0, I_WUP, I_A0, I_AUP, I_GUP, I_KK, I_KA, I_RK, I_RLNW, I_RLNB, I_EV_WOUT,
       I_EV_LN1G, I_EV_LN1B, I_FFN_WG, I_FFN_WU, I_FFN_WD, I_EV_LN2G, I_EV_LN2B, I_OD_WIN, I_OD_WOUT, I_OD_LN1G, I_OD_LN1B, I_ROUTER, I_MOE_WG, I_MOE_WU, I_MOE_WD, I_OD_LN2G, I_OD_LN2B };

struct Frame {
    LAS unsigned char* lds;
    int tid, lane, wave, G, bid;
};

template <int TYPE>
__device__ __forceinline__ void transpose_job(const float* W, const float* W2, int ldw, int K, bf16* WT, int nrows, LAS float* scr_f, int gw, int NGW, int lane) {
    LAS unsigned char* scr = (LAS unsigned char*)scr_f;
    const int nblk = nrows / 64, nitems = (K / 64) * nblk;
    const int l16 = lane & 15, lq = lane >> 4;
    for (int item = gw; item < nitems; item += NGW) {
        const int kb = item / nblk, nb = item % nblk, k0 = 64 * kb, n0 = 64 * nb;
        const int np = n0 + 4 * l16;
        const float* src = W; int col = np;
        if (TYPE == 1) { if (np < 2560) col = np; else if (np < 5920) col = np + 16; else if (np < 5936) col = 2560 + (np - 5920); else col = -1; }
        if (TYPE == 2) { const int pn = np >> 8, j = np & 255; if (j < 128) col = 128 * pn + j; else { src = W2; col = 128 * pn + j - 128; } }
#pragma unroll
        for (int i = 0; i < 8; ++i) { const int kk = 8 * i + 2 * lq;
            f32x4 va = (f32x4){0.f, 0.f, 0.f, 0.f}, vb = va;
            if (col >= 0) { va = __builtin_nontemporal_load((const f32x4*)(src + (size_t)(k0 + kk) * ldw + col)); vb = __builtin_nontemporal_load((const f32x4*)(src + (size_t)(k0 + kk + 1) * ldw + col)); }
#pragma unroll
            for (int j = 0; j < 4; ++j) *(LAS unsigned*)(scr + (4 * l16 + j) * 136 + kk * 2) = pk2(va[j], vb[j]); }
        LDS_WAIT(); asm volatile("" ::: "memory");
#pragma unroll
        for (int j = 0; j < 8; ++j) { const int ch = lane + 64 * j, n = ch >> 3, kc = ch & 7;
            const v2u lo = *(const LAS v2u*)(scr + n * 136 + kc * 16), hi = *(const LAS v2u*)(scr + n * 136 + kc * 16 + 8);
            *(v4u*)(WT + (size_t)(n0 + n) * K + k0 + 8 * kc) = (v4u){lo.x, lo.y, hi.x, hi.y}; }
        LDS_WAIT(); asm volatile("" ::: "memory");
    }
}

template <bool ROUTER, bool MOE_COMBINE, bool CSTAB = false>
__device__ __forceinline__ void ln_rows(const Frame& F, const float* xi, const bf16* xib, const bf16* hb, const bf16* hb2, const float* gam, const float* bet, float* xo, bf16* xbo,
                                        int row_lo, int row_hi, const float* wr, unsigned* cnt, int* tok_e, float* tok_p, int* tok_pos, const int* positions = nullptr, float* cstab = nullptr) {
    const int gw = F.bid * NWAVES + F.wave, NGW = F.G * NWAVES, lane = F.lane;
    float invf0 = 0.f, invf1 = 0.f;
    if (CSTAB) { invf0 = (float)pow(10000.0, -(double)lane / 127.0); invf1 = (float)pow(10000.0, -(double)(lane + 64) / 127.0); }
    f32x4 gv[4], bv[4];
#pragma unroll
    for (int j = 0; j < 4; ++j) { gv[j] = *(const f32x4*)(gam + 4 * lane + 256 * j); bv[j] = *(const f32x4*)(bet + 4 * lane + 256 * j); }
    float mylg[8] = {0.f, 0.f, 0.f, 0.f, 0.f, 0.f, 0.f, 0.f};
    f32x4 rw0[16], rw1[16];
    if (ROUTER) {
#pragma unroll
        for (int j = 0; j < 4; ++j)
#pragma unroll
            for (int q = 0; q < 4; ++q) { const int c = 4 * lane + 256 * j + q; rw0[4 * j + q] = *(const f32x4*)(wr + c * 8); rw1[4 * j + q] = *(const f32x4*)(wr + c * 8 + 4); }
    }
    for (int row = row_lo + gw; row < row_hi; row += NGW) {
        f32x4 v[4]; float s = 0.f;
#pragma unroll
        for (int j = 0; j < 4; ++j) {
            f32x4 x;
            if (xi) x = *(const f32x4*)(xi + (size_t)row * DM + 4 * lane + 256 * j);
            else { const v2u xw = *(const v2u*)(xib + (size_t)row * DM + 4 * lane + 256 * j); x = (f32x4){bflo(xw.x), bfhi(xw.x), bflo(xw.y), bfhi(xw.y)}; }
            const size_t hrow = MOE_COMBINE ? (size_t)(row - row_lo) : (size_t)row;
            const v2u hw = *(const v2u*)(hb + hrow * DM + 4 * lane + 256 * j);
            f32x4 h = (f32x4){bflo(hw.x), bfhi(hw.x), bflo(hw.y), bfhi(hw.y)};
            if (MOE_COMBINE) { const v2u h2 = *(const v2u*)(hb2 + hrow * DM + 4 * lane + 256 * j); h += (f32x4){bflo(h2.x), bfhi(h2.x), bflo(h2.y), bfhi(h2.y)}; }
            v[j] = x * ALPHA + h; s += (v[j].x + v[j].y) + (v[j].z + v[j].w);
        }
        const float mean = wave_sum(s) * (1.f / DM); float s2 = 0.f;
#pragma unroll
        for (int j = 0; j < 4; ++j) { v[j] = v[j] - mean; s2 += (v[j].x * v[j].x + v[j].y * v[j].y) + (v[j].z * v[j].z + v[j].w * v[j].w); }
        const float rstd = 1.f / sqrtf(wave_sum(s2) * (1.f / DM) + LN_EPS);
#pragma unroll
        for (int j = 0; j < 4; ++j) { v[j] = v[j] * rstd * gv[j] + bv[j];
            if (xo) *(f32x4*)(xo + (size_t)row * DM + 4 * lane + 256 * j) = v[j];
            if (xbo) { v2u w; w.x = pk2(v[j].x, v[j].y); w.y = pk2(v[j].z, v[j].w); *(v2u*)(xbo + (size_t)row * DM + 4 * lane + 256 * j) = w; } }
        if (CSTAB) { const float pos = (float)positions[row]; float sn, cs_; typedef float f32x2v __attribute__((ext_vector_type(2)));
            sincosf(pos * invf0, &sn, &cs_); *(f32x2v*)(cstab + ((size_t)row * 128 + lane) * 2) = (f32x2v){cs_, sn};
            sincosf(pos * invf1, &sn, &cs_); *(f32x2v*)(cstab + ((size_t)row * 128 + lane + 64) * 2) = (f32x2v){cs_, sn}; }
        if (ROUTER) {
            float lg[8];
#pragma unroll
            for (int e = 0; e < 8; ++e) lg[e] = 0.f;
#pragma unroll
            for (int j = 0; j < 4; ++j)
#pragma unroll
                for (int q = 0; q < 4; ++q) { const f32x4 w0 = rw0[4 * j + q], w1 = rw1[4 * j + q]; const float xv = v[j][q];
                    lg[0] += xv * w0.x; lg[1] += xv * w0.y; lg[2] += xv * w0.z; lg[3] += xv * w0.w; lg[4] += xv * w1.x; lg[5] += xv * w1.y; lg[6] += xv * w1.z; lg[7] += xv * w1.w; }
            {
                float a4[4];
#pragma unroll
                for (int e = 0; e < 4; ++e) { const float mine = (lane & 32) ? lg[4 + e] : lg[e], send = (lane & 32) ? lg[e] : lg[4 + e]; a4[e] = mine + __shfl_xor(send, 32); }
                float a2[2];
#pragma unroll
                for (int e = 0; e < 2; ++e) { const float mine = (lane & 16) ? a4[2 + e] : a4[e], send = (lane & 16) ? a4[e] : a4[2 + e]; a2[e] = mine + __shfl_xor(send, 16); }
                float a1; { const float mine = (lane & 8) ? a2[1] : a2[0], send = (lane & 8) ? a2[0] : a2[1]; a1 = mine + __shfl_xor(send, 8); }
                a1 += __shfl_xor(a1, 4); a1 += __shfl_xor(a1, 2); a1 += __shfl_xor(a1, 1);
#pragma unroll
                for (int e = 0; e < 8; ++e) lg[e] = __shfl(a1, ((e >> 2) & 1) * 32 + ((e >> 1) & 1) * 16 + (e & 1) * 8);
            }
            const int it_ = (row - row_lo - gw) / NGW;
#pragma unroll
            for (int e = 0; e < 8; ++e) mylg[e] = (lane == it_) ? lg[e] : mylg[e];
        }
    }
    if (ROUTER) {
        LAS unsigned* lc = (LAS unsigned*)(F.lds + LCNT_OFF);
        const int row = row_lo + gw + lane * NGW; const bool act = row < row_hi;
        int i0 = 0, i1 = -1, pos0 = 0, pos1 = 0;
        if (act) { float v0 = mylg[0];
#pragma unroll
            for (int e = 1; e < 8; ++e) if (mylg[e] > v0) { v0 = mylg[e]; i0 = e; }
            float v1 = -3.0e38f;
#pragma unroll
            for (int e = 0; e < 8; ++e) if (e != i0 && mylg[e] > v1) { v1 = mylg[e]; i1 = e; }
            pos0 = (int)__hip_atomic_fetch_add(lc + i0, 1u, __ATOMIC_RELAXED, __HIP_MEMORY_SCOPE_WORKGROUP); pos1 = (int)__hip_atomic_fetch_add(lc + i1, 1u, __ATOMIC_RELAXED, __HIP_MEMORY_SCOPE_WORKGROUP);
            tok_e[row] = i0 | (i1 << 8); tok_p[row] = 1.f / (1.f + __expf(v1 - v0)); }
        __syncthreads();
        if (F.tid < 8) lc[16 + F.tid] = __hip_atomic_fetch_add(cnt + F.tid, lc[F.tid], RLX_AGENT);
        __syncthreads();
        if (act) { tok_pos[2 * row] = pos0 + (int)lc[16 + i0]; tok_pos[2 * row + 1] = pos1 + (int)lc[16 + i1]; }
    }
}

typedef short bf16x8 __attribute__((ext_vector_type(8)));
typedef short s16x4 __attribute__((ext_vector_type(4)));
typedef __attribute__((address_space(3))) const unsigned char* lds_cptr;
__device__ __forceinline__ s16x4 lds_tr(lds_cptr p) { return __builtin_bit_cast(s16x4, __builtin_amdgcn_ds_read_tr16_b64_v4i16((LAS s16x4*)p)); }
__device__ __forceinline__ bf16x8 cat8(s16x4 lo, s16x4 hi) { return (bf16x8){lo[0], lo[1], lo[2], lo[3], hi[0], hi[1], hi[2], hi[3]}; }
typedef float f32x2_t __attribute__((ext_vector_type(2))); typedef __bf16 bf16x2_t __attribute__((ext_vector_type(2)));
__device__ __forceinline__ unsigned cvtpk(float lo, float hi) { f32x2_t v = {lo, hi}; bf16x2_t b = __builtin_convertvector(v, bf16x2_t); return __builtin_bit_cast(unsigned, b); }
__device__ __forceinline__ bf16x8 pack8(f32x4 a, f32x4 b) { v4u w; w.x = cvtpk(a[0], a[1]); w.y = cvtpk(a[2], a[3]); w.z = cvtpk(b[0], b[1]); w.w = cvtpk(b[2], b[3]); return __builtin_bit_cast(bf16x8, w); }
#define MFMA16(a, b, c) __builtin_amdgcn_mfma_f32_16x16x32_bf16(a, b, c, 0, 0, 0)
__device__ __forceinline__ void conv_prepass(const Frame& F, const bf16* P, const float* convw, const float* convb, bf16* XA, bf16* BCA) {
    constexpr int CR = 16;
    const int gt = F.bid * NTHR + F.tid, NGT = F.G * NTHR;
    for (int task = gt; task < (MTOK / CR) * 192; task += NGT) {
        const int cg = task % 192, rb = task / 192, ch = cg * 8, row0 = rb * CR, t0 = row0 & (SEQ - 1);
        float wk[4][8], bias[8], x0[8], x1[8], x2[8];
#pragma unroll
        for (int k = 0; k < 4; ++k) { const f32x4 a = *(const f32x4*)(convw + k * 1536 + ch), b = *(const f32x4*)(convw + k * 1536 + ch + 4);
#pragma unroll
            for (int j = 0; j < 4; ++j) { wk[k][j] = a[j]; wk[k][4 + j] = b[j]; } }
        { const f32x4 a = *(const f32x4*)(convb + ch), b = *(const f32x4*)(convb + ch + 4);
#pragma unroll
            for (int j = 0; j < 4; ++j) { bias[j] = a[j]; bias[4 + j] = b[j]; } }
        const bf16* src = P + L0_XBC + (size_t)row0 * 1536 + ch; const int bb_ = row0 >> 11;
#define CONV_LD(dst, ptr) do { const v4u r_ = *(const v4u*)(ptr); dst[0] = bflo(r_.x); dst[1] = bfhi(r_.x); dst[2] = bflo(r_.y); dst[3] = bfhi(r_.y); dst[4] = bflo(r_.z); dst[5] = bfhi(r_.z); dst[6] = bflo(r_.w); dst[7] = bfhi(r_.w); } while (0)
        if (t0 > 0) { CONV_LD(x0, src - 3 * 1536); CONV_LD(x1, src - 2 * 1536); CONV_LD(x2, src - 1536); }
        else {
#pragma unroll
            for (int j = 0; j < 8; ++j) { x0[j] = 0.f; x1[j] = 0.f; x2[j] = 0.f; } }
        const int cc_ = ch - 1024;
        bf16* dst = ch < 1024 ? XA + ((size_t)(bb_ * 16 + (ch >> 6)) * 2048 + t0) * 64 + (ch & 63) : BCA + ((size_t)(bb_ * 2 + ((cc_ & 255) >> 7)) * 2048 + t0) * 256 + (cc_ >> 8) * 128 + (cc_ & 127);
        const int dpitch = ch < 1024 ? 64 : 256;
#pragma unroll 4
        for (int r = 0; r < CR; ++r) {
            float cur[8], o[8]; CONV_LD(cur, src + (size_t)r * 1536);
#pragma unroll
            for (int j = 0; j < 8; ++j) { o[j] = silu_f(bias[j] + wk[0][j] * x0[j] + wk[1][j] * x1[j] + wk[2][j] * x2[j] + wk[3][j] * cur[j]); x0[j] = x1[j]; x1[j] = x2[j]; x2[j] = cur[j]; }
            v4u ow; ow.x = pk2(o[0], o[1]); ow.y = pk2(o[2], o[3]); ow.z = pk2(o[4], o[5]); ow.w = pk2(o[6], o[7]);
            *(v4u*)(dst + (size_t)r * dpitch) = ow;
        }
#undef CONV_LD
    }
}

__device__ __forceinline__ void small_prepass(const Frame& F, const bf16* SMBp, const float* mu, bf16* SMS) {
    const int gt = F.bid * NTHR + F.tid, NGT = F.G * NTHR;
    for (int idx = gt; idx < MTOK * 36; idx += NGT) {
        const int row = idx / 36, j = idx % 36; const bf16* src = SMBp + (size_t)row * 320 + j * 8;
        const v4u cw = *(const v4u*)src; const v4u pw = (row & (SEQ - 1)) ? *(const v4u*)(src - 320) : (v4u){0u, 0u, 0u, 0u};
        const f32x4 m0 = *(const f32x4*)(mu + 3072 + j * 8), m1 = *(const f32x4*)(mu + 3072 + j * 8 + 4);
        const float c_[8] = {bflo(cw.x), bfhi(cw.x), bflo(cw.y), bfhi(cw.y), bflo(cw.z), bfhi(cw.z), bflo(cw.w), bfhi(cw.w)};
        const float p_[8] = {bflo(pw.x), bfhi(pw.x), bflo(pw.y), bfhi(pw.y), bflo(pw.z), bfhi(pw.z), bflo(pw.w), bfhi(pw.w)};
        float v[8];
#pragma unroll
        for (int q = 0; q < 8; ++q) { const float x = c_[q] + (p_[q] - c_[q]) * (q < 4 ? m0[q & 3] : m1[q & 3]);
            v[q] = j < 8 ? 1.f - 2.f * __builtin_amdgcn_rcpf(1.f + __expf(2.f * x)) : (j < 16 ? x : __builtin_amdgcn_rcpf(1.f + __expf(-x))); }
        v4u o; o.x = pk2(v[0], v[1]); o.y = pk2(v[2], v[3]); o.z = pk2(v[4], v[5]); o.w = pk2(v[6], v[7]);
        *(v4u*)(SMS + (size_t)row * 320 + j * 8) = o;
    }
}

__device__ __forceinline__ float wave_scan_incl(float v, int lane) {
#pragma unroll
    for (int o = 1; o < 64; o <<= 1) { const float t = __shfl_up(v, o); if (lane >= o) v += t; }
    return v;
}
__device__ __forceinline__ void ssd_mfma(const Frame& F, const bf16* P, const bf16* XA, const bf16* BCA, const float* dtb, const float* alog, const float* dskip, bf16* mix) {
    constexpr int XST = 144, BST = 272;
    constexpr int XOFF = 0, XWOFF = 128 * XST, BOFF = 2 * 128 * XST, COFF = BOFF + 128 * BST, SOFF = COFF + 128 * BST, DTOFF = SOFF + 64 * BST, ACSOFF = DTOFF + 512;
    static_assert(ACSOFF + 512 <= RING_BYTES, "SSD LDS map");
    LAS unsigned char* const L = F.lds;
    LAS float* const DT = (LAS float*)(L + DTOFF); LAS float* const ACS = (LAS float*)(L + ACSOFF);
    const int tid = F.tid, lane = F.lane, w = F.wave, g = lane >> 4, lr = lane & 15, q4 = lr >> 2, p4 = lane & 3;
    for (int item = F.bid; item < BATCH * 16; item += F.G) {
        const int b = item >> 4, h = item & 15, grp = h >> 3;
        const float A_h = -__expf(alog[h]), dtbias = dtb[h], dsk = dskip[h];
        const bf16* xg = XA + (size_t)(b * 16 + h) * 2048 * 64;
        const bf16* bg = BCA + (size_t)(b * 2 + grp) * 2048 * 256;
        const bf16* cg = bg + 128;
        const bf16* dg = P + L0_SMB + (size_t)(b * SEQ) * 320 + 288 + h;
        const bf16* zg = P + L0_ZH + (size_t)(b * 16 + h) * 2048 * 64;
        bf16* og = mix + (size_t)(b * SEQ) * 2048 + h * 64;
        f32x4 stT[4];
#pragma unroll
        for (int pt = 0; pt < 4; ++pt) stT[pt] = (f32x4){0.f, 0.f, 0.f, 0.f};
        __syncthreads();
        for (int i = tid; i < 64 * BST / 16; i += NTHR) *(LAS v4u*)(L + SOFF + i * 16) = (v4u){0u, 0u, 0u, 0u};
        v4u xp[2], bp[4], cp[4]; float raw0 = 0.f, raw1 = 0.f;
#define SSD_LOAD(c) do { const size_t r0_ = (size_t)(128 * (c)); \
            _Pragma("unroll") for (int i_ = 0; i_ < 2; ++i_) { const int p_ = tid + NTHR * i_; xp[i_] = *(const v4u*)(xg + (r0_ + (p_ >> 3)) * 64 + (p_ & 7) * 8); } \
            _Pragma("unroll") for (int i_ = 0; i_ < 4; ++i_) { const int p_ = tid + NTHR * i_; bp[i_] = *(const v4u*)(bg + (r0_ + (p_ >> 4)) * 256 + (p_ & 15) * 8); cp[i_] = *(const v4u*)(cg + (r0_ + (p_ >> 4)) * 256 + (p_ & 15) * 8); } \
            if (w < 2) { raw0 = bf2f(dg[(r0_ + lane) * 320]); raw1 = bf2f(dg[(r0_ + 64 + lane) * 320]); } } while (0)
        SSD_LOAD(0);
        for (int c = 0; c < SEQ / 128; ++c) {
#pragma unroll
            for (int i = 0; i < 2; ++i) { const int p = tid + NTHR * i; *(LAS v4u*)(L + XOFF + (p >> 3) * XST + (p & 7) * 16) = xp[i]; }
#pragma unroll
            for (int i = 0; i < 4; ++i) { const int p = tid + NTHR * i; *(LAS v4u*)(L + BOFF + (p >> 4) * BST + (p & 15) * 16) = bp[i]; *(LAS v4u*)(L + COFF + (p >> 4) * BST + (p & 15) * 16) = cp[i]; }
            if (w < 2) {
                const float d0 = softplus_f(raw0 + dtbias), d1 = softplus_f(raw1 + dtbias);
                const float s0 = wave_scan_incl(d0 * A_h, lane); const float tot0 = __shfl(s0, 63); const float s1 = wave_scan_incl(d1 * A_h, lane) + tot0;
                if (w == 0) { DT[lane] = d0; ACS[lane] = s0; } else { DT[64 + lane] = d1; ACS[64 + lane] = s1; }
            }
            __syncthreads();
            const float acs_end = ACS[127];
#pragma unroll
            for (int i = 0; i < 2; ++i) { const int p = tid + NTHR * i, j = p >> 3; const float f = __expf(acs_end - ACS[j]) * DT[j]; const v4u x = xp[i]; v4u o;
                o.x = cvtpk(bflo(x.x) * f, bfhi(x.x) * f); o.y = cvtpk(bflo(x.y) * f, bfhi(x.y) * f); o.z = cvtpk(bflo(x.z) * f, bfhi(x.z) * f); o.w = cvtpk(bflo(x.w) * f, bfhi(x.w) * f);
                *(LAS v4u*)(L + XWOFF + j * XST + (p & 7) * 16) = o; }
            if (c + 1 < SEQ / 128) SSD_LOAD(c + 1);
            bf16x8 cf[4];
#pragma unroll
            for (int ks = 0; ks < 4; ++ks) cf[ks] = *(const LAS bf16x8*)(L + COFF + (16 * w + lr) * BST + (32 * ks + 8 * g) * 2);
            const float acs_i = ACS[16 * w + lr];
            bf16x8 mf[4];
#pragma unroll
            for (int s2 = 0; s2 < 4; ++s2) { f32x4 mm[2];
#pragma unroll
                for (int e = 0; e < 2; ++e) { const int jt = 2 * s2 + e; mm[e] = (f32x4){0.f, 0.f, 0.f, 0.f};
                    if (jt <= w) {
#pragma unroll
                        for (int ks = 0; ks < 4; ++ks) { const bf16x8 a = *(const LAS bf16x8*)(L + BOFF + (16 * jt + lr) * BST + (32 * ks + 8 * g) * 2); mm[e] = MFMA16(a, cf[ks], mm[e]); }
                        const f32x4 aj = *(const LAS f32x4*)(ACS + 16 * jt + 4 * g), dj = *(const LAS f32x4*)(DT + 16 * jt + 4 * g);
#pragma unroll
                        for (int r = 0; r < 4; ++r) { const float v = mm[e][r] * __expf(acs_i - aj[r]) * dj[r]; mm[e][r] = (jt < w || 4 * g + r <= lr) ? v : 0.f; }
                    } }
                mf[s2] = pack8(mm[0], mm[1]); }
            __builtin_amdgcn_sched_barrier(0);
            const float e_i = __expf(acs_i);
#pragma unroll
            for (int pt = 0; pt < 4; ++pt) { f32x4 y = (f32x4){0.f, 0.f, 0.f, 0.f};
#pragma unroll
                for (int ks = 0; ks < 4; ++ks) { const bf16x8 a = *(const LAS bf16x8*)(L + SOFF + (16 * pt + lr) * BST + (32 * ks + 8 * g) * 2); y = MFMA16(a, cf[ks], y); }
                y = y * e_i;
#pragma unroll
                for (int s2 = 0; s2 < 4; ++s2) if (2 * s2 <= w) {
                    const s16x4 lo = lds_tr(L + XOFF + (32 * s2 + 4 * g + q4) * XST + (16 * pt + 4 * p4) * 2), hi = lds_tr(L + XOFF + (32 * s2 + 16 + 4 * g + q4) * XST + (16 * pt + 4 * p4) * 2);
                    y = MFMA16(cat8(lo, hi), mf[s2], y); }
                const int tok = 128 * c + 16 * w + lr, p0 = 16 * pt + 4 * g;
                const v2u xw = *(const LAS v2u*)(L + XOFF + (16 * w + lr) * XST + p0 * 2); const v2u zw = *(const v2u*)(zg + (size_t)tok * 64 + p0);
                const float o0 = (y[0] + dsk * bflo(xw.x)) * silu_f(bflo(zw.x)), o1 = (y[1] + dsk * bfhi(xw.x)) * silu_f(bfhi(zw.x)), o2 = (y[2] + dsk * bflo(xw.y)) * silu_f(bflo(zw.y)), o3 = (y[3] + dsk * bfhi(xw.y)) * silu_f(bfhi(zw.y));
                v2u o; o.x = cvtpk(o0, o1); o.y = cvtpk(o2, o3); *(v2u*)(og + (size_t)tok * 2048 + p0) = o; }
            __syncthreads();
            { const float e_end = __expf(acs_end);
#pragma unroll
              for (int pt = 0; pt < 4; ++pt) stT[pt] = stT[pt] * e_end; }
#pragma unroll
            for (int s2 = 0; s2 < 4; ++s2) {
                const s16x4 lo = lds_tr(L + BOFF + (32 * s2 + 8 * g + q4) * BST + (16 * w + 4 * p4) * 2), hi = lds_tr(L + BOFF + (32 * s2 + 8 * g + 4 + q4) * BST + (16 * w + 4 * p4) * 2); const bf16x8 a = cat8(lo, hi);
#pragma unroll
                for (int pt = 0; pt < 4; ++pt) { const s16x4 xl = lds_tr(L + XWOFF + (32 * s2 + 8 * g + q4) * XST + (16 * pt + 4 * p4) * 2), xh = lds_tr(L + XWOFF + (32 * s2 + 8 * g + 4 + q4) * XST + (16 * pt + 4 * p4) * 2);
                    stT[pt] = MFMA16(a, cat8(xl, xh), stT[pt]); } }
#pragma unroll
            for (int pt = 0; pt < 4; ++pt) { v2u o; o.x = cvtpk(stT[pt][0], stT[pt][1]); o.y = cvtpk(stT[pt][2], stT[pt][3]); *(LAS v2u*)(L + SOFF + (16 * pt + lr) * BST + (16 * w + 4 * g) * 2) = o; }
            __syncthreads();
        }
#undef SSD_LOAD
    }
}

__device__ __forceinline__ void ssd_norm(const Frame& F, bf16* mix, const float* mnorm) {
    const int gw = F.bid * NWAVES + F.wave, NGW = F.G * NWAVES, lane = F.lane;
    for (int it = gw; it < MTOK * 2; it += NGW) {
        const int row = it >> 1, g = it & 1; bf16* p = mix + (size_t)row * 2048 + g * 512 + 8 * lane;
        const v4u w = *(const v4u*)p; float v[8] = {bflo(w.x), bfhi(w.x), bflo(w.y), bfhi(w.y), bflo(w.z), bfhi(w.z), bflo(w.w), bfhi(w.w)};
        float s = 0.f;
#pragma unroll
        for (int j = 0; j < 8; ++j) s += v[j] * v[j];
        const float r = 1.f / sqrtf(wave_sum(s) * (1.f / 512.f) + LN_EPS);
        const f32x4 m0 = *(const f32x4*)(mnorm + g * 512 + 8 * lane), m1 = *(const f32x4*)(mnorm + g * 512 + 8 * lane + 4);
        v4u o; o.x = pk2(v[0] * r * m0.x, v[1] * r * m0.y); o.y = pk2(v[2] * r * m0.z, v[3] * r * m0.w); o.z = pk2(v[4] * r * m1.x, v[5] * r * m1.y); o.w = pk2(v[6] * r * m1.z, v[7] * r * m1.w);
        *(v4u*)p = o;
    }
}

struct RwkvW { const float *mu, *w0, *wup, *a0, *aup, *gup, *kk, *ka, *rk, *rlnw, *rlnb; };
typedef float f32x2 __attribute__((ext_vector_type(2)));
#define MFMA16K(a, b, c) __builtin_amdgcn_mfma_f32_16x16x32_bf16(cat8(a, (s16x4){0, 0, 0, 0}), cat8(b, (s16x4){0, 0, 0, 0}), c, 0, 0, 0)
__device__ __forceinline__ s16x4 pack4(f32x4 a) { v2u w; w.x = cvtpk(a[0], a[1]); w.y = cvtpk(a[2], a[3]); return __builtin_bit_cast(s16x4, w); }
__device__ __forceinline__ float fast_sigmoid(float x) { return __builtin_amdgcn_rcpf(1.f + __expf(-x)); }
__device__ __forceinline__ float fast_tanh(float x) { return 1.f - 2.f * __builtin_amdgcn_rcpf(1.f + __expf(2.f * x)); }
__device__ __forceinline__ bf16x8 pack8f(const float* v) { v4u w; w.x = cvtpk(v[0], v[1]); w.y = cvtpk(v[2], v[3]); w.z = cvtpk(v[4], v[5]); w.w = cvtpk(v[6], v[7]); return __builtin_bit_cast(bf16x8, w); }
__device__ __forceinline__ void rwkv_items(const Frame& F, const bf16* P, const bf16* SMS, const RwkvW W, bf16* mix) {
    constexpr int TC = 32, TST = 144, GST = 336, FST = 272, FSZ = TC * FST;
    constexpr int RS = 0, KS = FSZ, VB = 2 * FSZ, OPS = VB + 2 * TC * TST;
    constexpr int AT = OPS, RT = OPS + 4608, BH = OPS + 9216, KH = OPS + 13824, BBAR = OPS + 18432, KBAR = OPS + 23040;
    constexpr int TWD = OPS, SAD = OPS + 4608, SGD = OPS + 9216;
    constexpr int LW = OPS + 27648, ICL = LW + FSZ, GT = ICL + FSZ, AAF = GT + FSZ, SM = AAF + FSZ, MABF = SM + 4096, PCO = MABF + 2048, BON = PCO + 512, N2 = BON + 1024, YR = N2 + 128, MU = YR + FSZ;
    static_assert(SGD + TC * GST <= LW && MU + 1920 <= RING_BYTES, "RWKV LDS map");
    LAS unsigned char* const L = F.lds;
    const int tid0 = F.tid, wave = F.wave;
#define RW_LANES() int tid = tid0; asm volatile("" : "+v"(tid)); const int lane = tid & 63, g = lane >> 4, lr = lane & 15, q4 = lr >> 2, p4 = lane & 3; (void)g; (void)lr; (void)q4; (void)p4
    for (int item = F.bid; item < BATCH * 16; item += F.G) {
        RW_LANES();
        const int b = item >> 4, h = item & 15, hc = h * 64 + lane;
        const bf16* Pr = P + L0_RKVH + (size_t)(b * 16 + h) * 2048 * 192;
        const bf16* Ps = SMS + (size_t)(b * SEQ) * 320;
        const int ct = wave & 3, c0 = h * 64 + 16 * ct + 4 * g;
        __syncthreads();
        if (tid < 480) { const int pc = tid >> 3, q = tid & 7; *(LAS float*)(L + MU + tid * 4) = W.mu[pc < 24 ? (pc >> 3) * 1024 + h * 64 + (pc & 7) * 8 + q : 3072 + (pc - 24) * 8 + q]; }
        bf16x8 wf[5];
        if (wave < 4) {
#pragma unroll
            for (int ks = 0; ks < 2; ++ks) { float t0_[8], t1_[8];
#pragma unroll
                for (int jj = 0; jj < 8; ++jj) { const size_t o = (size_t)(32 * ks + 8 * g + jj) * 1024 + h * 64 + 16 * ct + lr; t0_[jj] = W.wup[o]; t1_[jj] = W.aup[o]; }
                wf[ks] = pack8f(t0_); wf[2 + ks] = pack8f(t1_); asm volatile("" ::: "memory"); }
            wf[4] = wf[0];
        } else {
#pragma unroll
            for (int ks = 0; ks < 5; ++ks) { float t0_[8];
#pragma unroll
                for (int jj = 0; jj < 8; ++jj) t0_[jj] = W.gup[(size_t)(32 * ks + 8 * g + jj) * 1024 + h * 64 + 16 * ct + lr];
                wf[ks] = pack8f(t0_); asm volatile("" ::: "memory"); }
        }
        const float rlw = W.rlnw[hc], rlb = W.rlnb[hc];
        const f32x4 w0v = *(const f32x4*)(W.w0 + c0), a0v = *(const f32x4*)(W.a0 + c0), kk4 = *(const f32x4*)(W.kk + c0), ka4 = *(const f32x4*)(W.ka + c0), rk4 = *(const f32x4*)(W.rk + c0);
        const f32x4 kkp0 = *(const f32x4*)(W.kk + h * 64 + (tid & 7) * 8), kkp1 = *(const f32x4*)(W.kk + h * 64 + (tid & 7) * 8 + 4);
        f32x4 sT[4];
#pragma unroll
        for (int kt = 0; kt < 4; ++kt) sT[kt] = (f32x4){0.f, 0.f, 0.f, 0.f};
        v4u cur[4], prv[4];
#define RW_SLOTS() const int u8 = tid & 255, tt1 = u8 >> 3, pc1 = u8 & 7, ix2 = 256 + tid, tt2g = ix2 / 20, pc2g = ix2 % 20, tt3 = tid / 20, pc3 = tid % 20; \
        const int mu0 = tid & 15, mu1 = wave < 4 ? 16 + pc1 : 24 + pc1, mu2 = wave < 4 ? 32 + pc1 : 40 + pc2g, mu3 = 40 + pc3, ttb2 = wave < 4 ? tt1 : tt2g; \
        const int off0 = ((tid >> 3) & 1) * 64 + (tid & 7) * 8, off1 = wave < 4 ? 128 + pc1 * 8 : pc1 * 8, off2 = wave < 4 ? 64 + pc1 * 8 : 128 + pc2g * 8, off3 = 128 + pc3 * 8; (void)mu0; (void)mu1; (void)mu2; (void)mu3
#define RW_LD1(i_, tt_, base_, pitch_, off_) do { const int t_ = t0n_ + (tt_); cur[i_] = *(const v4u*)((base_) + (size_t)t_ * (pitch_) + (off_)); prv[i_] = t_ > 0 ? *(const v4u*)((base_) + (size_t)(t_ - 1) * (pitch_) + (off_)) : (v4u){0u, 0u, 0u, 0u}; } while (0)
#define RW_LD0(i_, tt_, off_) do { cur[i_] = *(const v4u*)(Ps + (size_t)(t0n_ + (tt_)) * 320 + (off_)); } while (0)
#define RW_LOAD(t0_) do { RW_LANES(); RW_SLOTS(); const int t0n_ = (t0_); RW_LD1(0, tid >> 4, Pr, 192, off0); if (wave < 4) RW_LD1(1, tt1, Pr, 192, off1); else RW_LD0(1, tt1, off1); if (wave < 6) RW_LD0(2, ttb2, off2); RW_LD0(3, tt3, off3); } while (0)
#define RW_SHIFT(v_, i_, mu_) do { const f32x4 m0_ = *(const LAS f32x4*)(L + MU + (mu_) * 32), m1_ = *(const LAS f32x4*)(L + MU + (mu_) * 32 + 16); const v4u cw_ = cur[i_], pw_ = prv[i_]; \
            const float c_[8] = {bflo(cw_.x), bfhi(cw_.x), bflo(cw_.y), bfhi(cw_.y), bflo(cw_.z), bfhi(cw_.z), bflo(cw_.w), bfhi(cw_.w)}; \
            const float p_[8] = {bflo(pw_.x), bfhi(pw_.x), bflo(pw_.y), bfhi(pw_.y), bflo(pw_.z), bfhi(pw_.z), bflo(pw_.w), bfhi(pw_.w)}; \
            _Pragma("unroll") for (int q_ = 0; q_ < 8; ++q_) v_[q_] = c_[q_] + (p_[q_] - c_[q_]) * (q_ < 4 ? m0_[q_ & 3] : m1_[q_ & 3]); } while (0)
#define RW_PASS_E(te_, par_) do { _Pragma("unroll") for (int rep = 0; rep < TC / NWAVES; ++rep) { const int tt = wave + NWAVES * rep, o = tt * FST + lane * 4; const size_t row = (size_t)(b * SEQ + (te_) + tt); \
                const float y = *(LAS float*)(L + YR + o); const float mu = wave_sum(y) * (1.f / 64.f); const float d = y - mu; const float var = wave_sum(d * d) * (1.f / 64.f); \
                const float yn = d * (1.f / sqrtf(var + 64e-5f)) * rlw + rlb; \
                const LAS float* bp_ = (const LAS float*)(L + BON + (par_) * 512 + tt * 4); const float bonus = ((bp_[0] + bp_[32]) + (bp_[64] + bp_[96])) * bf2f(*(LAS bf16*)(L + VB + (par_) * TC * TST + tt * TST + lane * 2)); \
                mix[row * 2048 + 1024 + hc] = (bf16)f2bf((yn + bonus) * *(LAS float*)(L + GT + o)); } } while (0)
        RW_LOAD(0);
        for (int t0 = 0; t0 < SEQ; t0 += TC) {
            const int par = (t0 >> 5) & 1;
            LDS_BARRIER();
            { RW_LANES(); RW_SLOTS();
            { float v[8]; RW_SHIFT(v, 0, mu0); const int base = ((tid & 8) ? KS : RS) + (tid >> 4) * FST + (tid & 7) * 32;
              *(LAS f32x4*)(L + base) = (f32x4){v[0], v[1], v[2], v[3]}; *(LAS f32x4*)(L + base + 16) = (f32x4){v[4], v[5], v[6], v[7]};
              float n2 = 0.f;
#pragma unroll
              for (int q = 0; q < 8; ++q) { const float x = v[q] * (q < 4 ? kkp0[q & 3] : kkp1[q & 3]); n2 += x * x; }
              n2 += __shfl_xor(n2, 1); n2 += __shfl_xor(n2, 2); n2 += __shfl_xor(n2, 4);
              if ((tid & 15) == 8) *(LAS float*)(L + N2 + (tid >> 4) * 4) = n2; }
            if (wave < 4) { float v[8]; RW_SHIFT(v, 1, mu1); *(LAS bf16x8*)(L + VB + par * TC * TST + tt1 * TST + pc1 * 16) = pack8f(v); }
            else *(LAS v4u*)(L + TWD + tt1 * TST + pc1 * 16) = cur[1];
            if (wave < 4) *(LAS v4u*)(L + SAD + tt1 * TST + pc1 * 16) = cur[2];
            else if (wave < 6) *(LAS v4u*)(L + SGD + tt2g * GST + pc2g * 16) = cur[2];
            *(LAS v4u*)(L + SGD + tt3 * GST + pc3 * 16) = cur[3];
            if (t0 > 0) RW_PASS_E(t0 - TC, par ^ 1);
            }
            LDS_BARRIER();
            if (t0 + TC < SEQ) RW_LOAD(t0 + TC);
            { RW_LANES();
#pragma unroll
            for (int tt2 = 0; tt2 < 2; ++tt2) {
                if (wave < 4) { f32x4 dw = (f32x4){0.f, 0.f, 0.f, 0.f}, da = (f32x4){0.f, 0.f, 0.f, 0.f};
#pragma unroll
                    for (int ks = 0; ks < 2; ++ks) {
                        const bf16x8 bw = *(const LAS bf16x8*)(L + TWD + (16 * tt2 + lr) * TST + (32 * ks + 8 * g) * 2), ba = *(const LAS bf16x8*)(L + SAD + (16 * tt2 + lr) * TST + (32 * ks + 8 * g) * 2);
                        dw = MFMA16(wf[ks], bw, dw); da = MFMA16(wf[2 + ks], ba, da); }
                    const int o = (16 * tt2 + lr) * FST + (16 * ct + 4 * g) * 4;
                    const f32x4 kv = *(const LAS f32x4*)(L + KS + o), rv = *(const LAS f32x4*)(L + RS + o);
                    const float inv = 1.f / fmaxf(sqrtf(*(const LAS float*)(L + N2 + (16 * tt2 + lr) * 4)), 1e-12f);
                    f32x4 lw, kp, av, bv; float bon = 0.f;
#pragma unroll
                    for (int r = 0; r < 4; ++r) { lw[r] = -0.6065306597126334f * fast_sigmoid(w0v[r] + dw[r]); const float icl = fast_sigmoid(a0v[r] + da[r]);
                        const float kkn = kv[r] * kk4[r] * inv; kp[r] = kv[r] * (1.f + (icl - 1.f) * ka4[r]); av[r] = -kkn; bv[r] = kkn * icl; bon += rv[r] * kp[r] * rk4[r]; }
                    *(LAS f32x4*)(L + LW + o) = lw; *(LAS f32x4*)(L + KS + o) = kp; *(LAS f32x4*)(L + AAF + o) = av; *(LAS f32x4*)(L + ICL + o) = bv;
                    bon += __shfl_xor(bon, 16); bon += __shfl_xor(bon, 32);
                    if (g == 0) *(LAS float*)(L + BON + par * 512 + ct * 128 + (16 * tt2 + lr) * 4) = bon;
                } else { f32x4 dg = (f32x4){0.f, 0.f, 0.f, 0.f};
#pragma unroll
                    for (int ks = 0; ks < 5; ++ks) { const bf16x8 bg = *(const LAS bf16x8*)(L + SGD + (16 * tt2 + lr) * GST + (32 * ks + 8 * g) * 2); dg = MFMA16(wf[ks], bg, dg); }
                    *(LAS f32x4*)(L + GT + (16 * tt2 + lr) * FST + (16 * ct + 4 * g) * 4) = dg; } }
            }
            LDS_BARRIER();
            { RW_LANES();
            { const int ch = tid >> 8, q = (tid >> 6) & 3, c = lane; float lp[16]; float run = 0.f;
#pragma unroll
              for (int t = 0; t < 16; ++t) { run += *(LAS float*)(L + LW + (16 * ch + t) * FST + c * 4); lp[t] = run; }
              const float lend = lp[15];
#pragma unroll
              for (int t = 0; t < 16; ++t) if ((t >> 2) == q) { const int tok = 16 * ch + t, o = tok * FST + c * 4, ob = tok * TST + c * 2;
                  const float av = *(LAS float*)(L + AAF + o), bv = *(LAS float*)(L + ICL + o), kp = *(LAS float*)(L + KS + o), rv = *(LAS float*)(L + RS + o);
                  const float em1 = t ? __expf(lp[t ? t - 1 : 0]) : 1.f, et = __expf(lp[t]), iet = __expf(-lp[t]), ee = __expf(lend - lp[t]);
                  *(LAS bf16*)(L + AT + ob) = (bf16)f2bf(av * em1); *(LAS bf16*)(L + RT + ob) = (bf16)f2bf(rv * et); *(LAS bf16*)(L + BH + ob) = (bf16)f2bf(bv * iet);
                  *(LAS bf16*)(L + KH + ob) = (bf16)f2bf(kp * iet); *(LAS bf16*)(L + BBAR + ob) = (bf16)f2bf(bv * ee); *(LAS bf16*)(L + KBAR + ob) = (bf16)f2bf(kp * ee); }
              if (q == 0) *(LAS float*)(L + PCO + (ch * 64 + c) * 4) = __expf(lend); }
            }
            LDS_BARRIER();
            { RW_LANES();
            { const int mi = wave & 3, ch = wave >> 2; const int lhs = (mi & 1) ? KH : BH, rhs = (mi & 2) ? RT : AT; f32x4 acc = (f32x4){0.f, 0.f, 0.f, 0.f};
#pragma unroll
              for (int ks = 0; ks < 2; ++ks) { const bf16x8 a_ = *(const LAS bf16x8*)(L + lhs + (16 * ch + lr) * TST + (32 * ks + 8 * g) * 2), b_ = *(const LAS bf16x8*)(L + rhs + (16 * ch + lr) * TST + (32 * ks + 8 * g) * 2);
                  acc = MFMA16(a_, b_, acc); }
#pragma unroll
              for (int r = 0; r < 4; ++r) { const int s_ = 4 * g + r; acc[r] = ((mi < 2) ? (s_ < lr) : (s_ <= lr)) ? acc[r] : 0.f; }
              if (mi != 0) *(LAS s16x4*)(L + SM + ch * 2048 + (mi - 1) * 512 + lr * 32 + 8 * g) = pack4(acc);
              else {
#pragma unroll
                  for (int r = 0; r < 4; ++r) *(LAS float*)(L + MABF + ch * 1024 + ((4 * g + r) * 16 + lr) * 4) = acc[r];
                  float m[16];
#pragma unroll
                  for (int s_ = 15; s_ >= 0; --s_) { float row[16];
#pragma unroll
                      for (int u4 = 0; u4 < 4; ++u4) { const f32x4 rv = *(const LAS f32x4*)(L + MABF + ch * 1024 + s_ * 64 + u4 * 16); row[4 * u4] = rv[0]; row[4 * u4 + 1] = rv[1]; row[4 * u4 + 2] = rv[2]; row[4 * u4 + 3] = rv[3]; }
                      float sum = (s_ == lr) ? 1.f : 0.f;
#pragma unroll
                      for (int u = s_ + 1; u < 16; ++u) sum += row[u] * m[u];
                      m[s_] = sum; asm volatile("" ::: "memory"); }
                  if (lane < 16) { *(LAS bf16x8*)(L + SM + ch * 2048 + 1536 + lr * 32) = pack8f(m); *(LAS bf16x8*)(L + SM + ch * 2048 + 1536 + lr * 32 + 16) = pack8f(m + 8); }
              } }
            }
            LDS_BARRIER();
            { RW_LANES();
            if (wave < 4) {
#pragma unroll 1
                for (int ch = 0; ch < 2; ++ch) {
                    const bf16x8 sf0 = pack8(sT[0], sT[1]), sf1 = pack8(sT[2], sT[3]);
                    const s16x4 vf = lds_tr(L + VB + par * TC * TST + (16 * ch + 4 * g + q4) * TST + (16 * wave + 4 * p4) * 2);
                    const int rowb = (16 * ch + lr) * TST, smb = SM + ch * 2048 + lr * 32 + 8 * g;
                    f32x4 x = (f32x4){0.f, 0.f, 0.f, 0.f}, y = (f32x4){0.f, 0.f, 0.f, 0.f};
                    x = MFMA16(cat8(*(const LAS s16x4*)(L + AT + rowb + (4 * g) * 2), *(const LAS s16x4*)(L + AT + rowb + (16 + 4 * g) * 2)), sf0, x);
                    x = MFMA16(cat8(*(const LAS s16x4*)(L + AT + rowb + (32 + 4 * g) * 2), *(const LAS s16x4*)(L + AT + rowb + (48 + 4 * g) * 2)), sf1, x);
                    x = MFMA16K(*(const LAS s16x4*)(L + smb), vf, x);
                    const s16x4 xf = pack4(x);
                    const f32x4 sa = MFMA16K(*(const LAS s16x4*)(L + smb + 1536), xf, ((f32x4){0.f, 0.f, 0.f, 0.f}));
                    const s16x4 saf = pack4(sa);
                    y = MFMA16(cat8(*(const LAS s16x4*)(L + RT + rowb + (4 * g) * 2), *(const LAS s16x4*)(L + RT + rowb + (16 + 4 * g) * 2)), sf0, y);
                    y = MFMA16(cat8(*(const LAS s16x4*)(L + RT + rowb + (32 + 4 * g) * 2), *(const LAS s16x4*)(L + RT + rowb + (48 + 4 * g) * 2)), sf1, y);
                    y = MFMA16K(*(const LAS s16x4*)(L + smb + 512), saf, y);
                    y = MFMA16K(*(const LAS s16x4*)(L + smb + 1024), vf, y);
#pragma unroll
                    for (int kt = 0; kt < 4; ++kt) { const f32x4 pc = *(const LAS f32x4*)(L + PCO + (ch * 64 + 16 * kt + 4 * g) * 4);
                        const s16x4 bb = lds_tr(L + BBAR + (16 * ch + 4 * g + q4) * TST + (16 * kt + 4 * p4) * 2), kb = lds_tr(L + KBAR + (16 * ch + 4 * g + q4) * TST + (16 * kt + 4 * p4) * 2);
                        f32x4 sn = sT[kt] * pc; sn = MFMA16K(bb, saf, sn); sn = MFMA16K(kb, vf, sn); sT[kt] = sn; }
#pragma unroll
                    for (int r = 0; r < 4; ++r) *(LAS float*)(L + YR + (16 * ch + 4 * g + r) * FST + (16 * wave + lr) * 4) = y[r];
                }
            }
            }
        }
        LDS_BARRIER();
        { RW_LANES(); RW_PASS_E(SEQ - TC, ((SEQ - TC) >> 5) & 1); }
#undef RW_LOAD
#undef RW_LD1
#undef RW_LD0
#undef RW_SHIFT
#undef RW_LANES
#undef RW_SLOTS
#undef RW_PASS_E
    }
}

__device__ __forceinline__ void retention_mfma(const Frame& F, bf16* Q) {
    constexpr int KST = 528, VST = 272, SST = 528;
    constexpr int KOFF = 0, VOFF = 64 * KST, SOFF = VOFF + 64 * VST;
    LAS unsigned char* const L = F.lds;
    const int tid = F.tid, lane0 = F.lane, w = F.wave;
    const int it = w & 3, vh = w >> 2;
#define RT_LANES() int lane = lane0; asm volatile("" : "+v"(lane)); const int g = lane >> 4, lr = lane & 15, q4 = lr >> 2, p4 = lane & 3; (void)g; (void)lr; (void)q4; (void)p4
    const int lr0 = lane0 & 15;
    for (int item = F.bid; item < BATCH * 16; item += F.G) {
        const int b = item >> 4, h = (item >> 2) & 3, sl = item & 3;
        const float lg2 = log2f(1.f - exp2f(-5.f - (float)h));
        const float g64 = exp2f(64.f * lg2);
        const float vf0 = exp2f(-(float)((tid >> 4) + 1) * lg2), vf1 = exp2f(-(float)((tid >> 4) + 33) * lg2);
        const float ysc = exp2f((float)(16 * it + lr0 + 1) * lg2);
        const bf16* qg = Q + L1_QKH + (size_t)(b * 4 + h) * 2048 * 512;
        const bf16* kg = qg + 256;
        bf16* vg = Q + L1_VH + (size_t)((b * 4 + h) * 4 + sl) * 2048 * 128;
        f32x4 st[2][8];
#pragma unroll
        for (int a = 0; a < 2; ++a)
#pragma unroll
            for (int c = 0; c < 8; ++c) st[a][c] = (f32x4){0.f, 0.f, 0.f, 0.f};
        __syncthreads();
        for (int i = tid; i < 128 * SST / 16; i += NTHR) *(LAS v4u*)(L + SOFF + i * 16) = (v4u){0u, 0u, 0u, 0u};
        v4u kp[4], vp[2];
#define RET_LOAD(c) do { const size_t r0_ = (size_t)(64 * (c)); \
            _Pragma("unroll") for (int i_ = 0; i_ < 4; ++i_) { const int p_ = tid + NTHR * i_; kp[i_] = *(const v4u*)(kg + (r0_ + (p_ >> 5)) * 512 + (p_ & 31) * 8); } \
            _Pragma("unroll") for (int i_ = 0; i_ < 2; ++i_) { const int p_ = tid + NTHR * i_; vp[i_] = *(const v4u*)(vg + (r0_ + (p_ >> 4)) * 128 + (p_ & 15) * 8); } } while (0)
        RET_LOAD(0);
        bf16x8 qc[8];
#define RET_QLOAD(c_) do { RT_LANES(); _Pragma("unroll") for (int ks = 0; ks < 8; ++ks) qc[ks] = *(const bf16x8*)(qg + (size_t)(64 * (c_) + 16 * it + lr) * 512 + 32 * ks + 8 * g); } while (0)
        RET_QLOAD(0);
        for (int c = 0; c < SEQ / 64; ++c) {
#pragma unroll
            for (int i = 0; i < 4; ++i) { const int p = tid + NTHR * i; *(LAS v4u*)(L + KOFF + (p >> 5) * KST + (p & 31) * 16) = kp[i]; }
#pragma unroll
            for (int i = 0; i < 2; ++i) { const int p = tid + NTHR * i; const float f = i ? vf1 : vf0; const v4u x = vp[i]; v4u o;
                o.x = cvtpk(bflo(x.x) * f, bfhi(x.x) * f); o.y = cvtpk(bflo(x.y) * f, bfhi(x.y) * f); o.z = cvtpk(bflo(x.z) * f, bfhi(x.z) * f); o.w = cvtpk(bflo(x.w) * f, bfhi(x.w) * f);
                *(LAS v4u*)(L + VOFF + (p >> 4) * VST + (p & 15) * 16) = o; }
            LDS_BARRIER();
            if (c + 1 < SEQ / 64) RET_LOAD(c + 1);
            { RT_LANES();
#pragma unroll
            for (int s2 = 0; s2 < 2; ++s2) { bf16x8 ka[2];
#pragma unroll
                for (int dt = 0; dt < 2; ++dt) { const s16x4 lo = lds_tr(L + KOFF + (32 * s2 + 8 * g + q4) * KST + (32 * w + 16 * dt + 4 * p4) * 2), hi = lds_tr(L + KOFF + (32 * s2 + 8 * g + 4 + q4) * KST + (32 * w + 16 * dt + 4 * p4) * 2); ka[dt] = cat8(lo, hi); }
#pragma unroll
                for (int vq = 0; vq < 2; ++vq) { bf16x8 vb[4];
#pragma unroll
                    for (int v4 = 0; v4 < 4; ++v4) { const int vt = 4 * vq + v4; const s16x4 lo = lds_tr(L + VOFF + (32 * s2 + 8 * g + q4) * VST + (16 * vt + 4 * p4) * 2), hi = lds_tr(L + VOFF + (32 * s2 + 8 * g + 4 + q4) * VST + (16 * vt + 4 * p4) * 2); vb[v4] = cat8(lo, hi); }
                    __builtin_amdgcn_sched_barrier(0);
#pragma unroll
                    for (int v4 = 0; v4 < 4; ++v4) { st[0][4 * vq + v4] = MFMA16(ka[0], vb[v4], st[0][4 * vq + v4]); st[1][4 * vq + v4] = MFMA16(ka[1], vb[v4], st[1][4 * vq + v4]); }
                    __builtin_amdgcn_sched_barrier(0); } }
#pragma unroll
            for (int dt = 0; dt < 2; ++dt)
#pragma unroll
                for (int vt = 0; vt < 8; ++vt) st[dt][vt] = st[dt][vt] * g64;
            }
            __builtin_amdgcn_sched_barrier(0);
            { RT_LANES();
            f32x4 sacc[4];
#pragma unroll
            for (int jt = 0; jt < 4; ++jt) { sacc[jt] = (f32x4){0.f, 0.f, 0.f, 0.f};
                if (jt <= it) { bf16x8 kr[8];
#pragma unroll
                    for (int ks = 0; ks < 8; ++ks) kr[ks] = *(const LAS bf16x8*)(L + KOFF + (16 * jt + lr) * KST + (32 * ks + 8 * g) * 2);
                    __builtin_amdgcn_sched_barrier(0);
#pragma unroll
                    for (int ks = 0; ks < 8; ++ks) sacc[jt] = MFMA16(kr[ks], qc[ks], sacc[jt]);
                    if (jt == it) {
#pragma unroll
                        for (int r = 0; r < 4; ++r) sacc[jt][r] = (4 * g + r <= lr) ? sacc[jt][r] : 0.f; }
                    __builtin_amdgcn_sched_barrier(0);
                } }
            bf16x8 sf[2]; sf[0] = pack8(sacc[0], sacc[1]); sf[1] = pack8(sacc[2], sacc[3]); __builtin_amdgcn_sched_barrier(0);
#pragma unroll
            for (int x = 0; x < 4; ++x) { const int vt = 4 * vh + x; f32x4 y = (f32x4){0.f, 0.f, 0.f, 0.f};
#pragma unroll
                for (int kh = 0; kh < 2; ++kh) { bf16x8 sr[4];
#pragma unroll
                    for (int k4 = 0; k4 < 4; ++k4) sr[k4] = *(const LAS bf16x8*)(L + SOFF + (16 * vt + lr) * SST + (32 * (4 * kh + k4) + 8 * g) * 2);
                    __builtin_amdgcn_sched_barrier(0);
#pragma unroll
                    for (int k4 = 0; k4 < 4; ++k4) y = MFMA16(sr[k4], qc[4 * kh + k4], y);
                    __builtin_amdgcn_sched_barrier(0); }
#pragma unroll
                for (int s2 = 0; s2 < 2; ++s2) if (2 * s2 <= it) {
                    const s16x4 lo = lds_tr(L + VOFF + (32 * s2 + 4 * g + q4) * VST + (16 * vt + 4 * p4) * 2), hi = lds_tr(L + VOFF + (32 * s2 + 16 + 4 * g + q4) * VST + (16 * vt + 4 * p4) * 2);
                    y = MFMA16(cat8(lo, hi), sf[s2], y); }
                v2u o; o.x = cvtpk(y[0] * ysc, y[1] * ysc); o.y = cvtpk(y[2] * ysc, y[3] * ysc);
                *(v2u*)(vg + (size_t)(64 * c + 16 * it + lr) * 128 + 16 * vt + 4 * g) = o; __builtin_amdgcn_sched_barrier(0); }
            }
            if (c + 1 < SEQ / 64) RET_QLOAD(c + 1);
            LDS_BARRIER();
            { RT_LANES();
#pragma unroll
            for (int dt = 0; dt < 2; ++dt)
#pragma unroll
                for (int vt = 0; vt < 8; ++vt) { v2u o; o.x = cvtpk(st[dt][vt][0], st[dt][vt][1]); o.y = cvtpk(st[dt][vt][2], st[dt][vt][3]);
                    *(LAS v2u*)(L + SOFF + (16 * vt + lr) * SST + (32 * w + 16 * dt + 4 * g) * 2) = o; }
            }
        }
#undef RET_LOAD
#undef RET_QLOAD
#undef RT_LANES
    }
}

__device__ __forceinline__ void retention_norm(const Frame& F, bf16* Q) {
    const int gw = F.bid * NWAVES + F.wave, NGW = F.G * NWAVES, lane = F.lane;
    for (int it = gw; it < MTOK * 4; it += NGW) {
        const int row = it >> 2, h = it & 3, c8 = 8 * lane; const bf16* yp = Q + L1_VH + ((size_t)(((row >> 11) * 4 + h) * 4 + (c8 >> 7)) * 2048 + (row & 2047)) * 128 + (c8 & 127); bf16* gp = Q + L1_GB + (size_t)row * 2048 + h * 512 + c8;
        const v4u w = *(const v4u*)yp; const v4u gq = *(const v4u*)gp;
        float v[8] = {bflo(w.x), bfhi(w.x), bflo(w.y), bfhi(w.y), bflo(w.z), bfhi(w.z), bflo(w.w), bfhi(w.w)};
        const float g[8] = {bflo(gq.x), bfhi(gq.x), bflo(gq.y), bfhi(gq.y), bflo(gq.z), bfhi(gq.z), bflo(gq.w), bfhi(gq.w)};
        float s = 0.f;
#pragma unroll
        for (int j = 0; j < 8; ++j) s += v[j];
        const float mean = wave_sum(s) * (1.f / 512.f); float s2 = 0.f;
#pragma unroll
        for (int j = 0; j < 8; ++j) { v[j] -= mean; s2 += v[j] * v[j]; }
        const float r = 1.f / sqrtf(wave_sum(s2) * (1.f / 512.f) + LN_EPS);
        float o[8];
#pragma unroll
        for (int j = 0; j < 8; ++j) o[j] = silu_f(g[j]) * v[j] * r;
        v4u ow; ow.x = pk2(o[0], o[1]); ow.y = pk2(o[2], o[3]); ow.z = pk2(o[4], o[5]); ow.w = pk2(o[6], o[7]);
        *(v4u*)gp = ow;
    }
}

__device__ __forceinline__ int pad256(int n) { return (n + 255) & ~255; }
__device__ __forceinline__ void moe_slots(const Frame& F, const unsigned* cnt, const int* tok_e, const float* tok_p, const int* tok_pos, int* rowtok, int* rowdst, float* rowp) {
    const int gt = F.bid * NTHR + F.tid, NGT = F.G * NTHR;
    for (int row = gt; row < MTOK; row += NGT) {
        const int e01 = tok_e[row], e0 = e01 & 255, e1 = e01 >> 8; const float p0 = tok_p[row];
        int base0 = 0, base1 = 0;
#pragma unroll
        for (int e = 0; e < 8; ++e) { const int pc = pad256((int)cnt[e]); if (e < e0) base0 += pc; if (e < e1) base1 += pc; }
        const int s0 = base0 + tok_pos[2 * row], s1 = base1 + tok_pos[2 * row + 1];
        rowtok[s0] = row; rowdst[s0] = row; rowp[s0] = p0;
        rowtok[s1] = row; rowdst[s1] = MTOK + row; rowp[s1] = 1.f - p0;
    }
    for (int it = gt; it < 8 * 256; it += NGT) {
        const int e = it >> 8, i = it & 255;
        int base = 0;
#pragma unroll
        for (int q = 0; q < 8; ++q) if (q < e) base += pad256((int)cnt[q]);
        const int n = (int)cnt[e];
        if (n + i < pad256(n)) { const int s = base + n + i; rowtok[s] = 0; rowdst[s] = -1; rowp[s] = 0.f; }
    }
}
struct MoeOrder {
    int npan, nN, G, c; const char* W; size_t estride, tstepB; const int* rows; const LAS int* pexp; int p0;
    __device__ bool next(int i, pg8::Unit& u) const {
        const int nwg = npan * nN; const long L = (long)i * G + c; if (L >= nwg) return false;
        int wgid = (int)L; { const int q = nwg / pg8::NXCD, r = nwg % pg8::NXCD, xcd = wgid % pg8::NXCD, off = wgid / pg8::NXCD; wgid = (xcd < r ? xcd * (q + 1) : r * (q + 1) + (xcd - r) * q) + off; }
        const int nig = pg8::WGM * nN, gid = wgid / nig, fm = gid * pg8::WGM, gsz = (npan - fm) < pg8::WGM ? (npan - fm) : pg8::WGM;
        u.pm = fm + ((wgid % nig) % gsz); u.pn = (wgid % nig) / gsz; return true; }
    __device__ __forceinline__ const char* b_base(const pg8::Unit& u) const { const int e = __builtin_amdgcn_readfirstlane(pexp[p0 + u.pm]); return W + (size_t)e * estride + (size_t)u.pn * tstepB; }
    __device__ __forceinline__ const int* a_rows(const pg8::Unit& u) const { return rows + (p0 + u.pm) * 256; }
};
__device__ __forceinline__ int moe_panels(const unsigned* cnt, LAS int* pexp, int tid) {
    int pb[9]; pb[0] = 0;
#pragma unroll
    for (int e = 0; e < 8; ++e) pb[e + 1] = pb[e] + pad256((int)cnt[e]) / 256;
    if (tid < MOE_SLOTS / 256) { int e = 0;
#pragma unroll
        for (int q = 1; q < 8; ++q) e += (tid >= pb[q]) ? 1 : 0;
        pexp[tid] = e; }
    __syncthreads();
    return pb[8];
}

__global__ void __launch_bounds__(NTHR, 2) fwd_kernel(Args args) {
    extern __shared__ __attribute__((aligned(16))) unsigned char lds_raw[];
    Frame F;
    F.lds = (LAS unsigned char*)lds_raw;
    F.tid = threadIdx.x; F.lane = F.tid & 63; F.wave = __builtin_amdgcn_readfirstlane(F.tid >> 6); F.G = gridDim.x; F.bid = blockIdx.x;
    typedef const unsigned char __attribute__((address_space(4))) kseg_t;
    kseg_t* kp0 = (kseg_t*)__builtin_amdgcn_kernarg_segment_ptr();
#define KARG(T, off) (*(T const __attribute__((address_space(4)))*)(kp + (off)))
#define PHASE_ENTER { int l_; asm volatile("v_mbcnt_lo_u32_b32 %0, -1, 0\n\tv_mbcnt_hi_u32_b32 %0, -1, %0" : "=v"(l_)); F.lane = l_; F.tid = F.wave * 64 + l_; } kseg_t* kp = kp0; asm volatile("" : "+s"(kp)); unsigned char* const ws = KARG(unsigned char*, 38 * 8 + 8); gu32* const ctl = (gu32*)(ws + WS_CTL); (void)ctl
#define INP(i) KARG(const float*, 8 * (i))
#define OUTP KARG(float*, 38 * 8)
#define WSP(T, off) ((T*)(ws + (off)))
    int lo, hi;
    { kseg_t* kp = kp0; lo = KARG(int, 38 * 8 + 16); hi = KARG(int, 38 * 8 + 20); }
    volatile LAS unsigned* MISC = (volatile LAS unsigned*)(F.lds + MISC_OFF);
    for (int u = F.tid; u < (LDS_BYTES - RING_BYTES) / 4; u += NTHR) ((LAS unsigned*)(F.lds + RING_BYTES))[u] = 0u;
    __syncthreads();
    const bool multi = (hi - lo) > 1;
    XcdBarrier bar; bar.x = 0; bar.st = nullptr;
    { PHASE_ENTER; bar.bar = (unsigned*)(ctl + CW_BAR); if (multi) bar = xcd_barrier_post((unsigned*)(ctl + CW_BAR), MISC + 8); }
#ifndef PH_MASK
#define PH_MASK 0xFFFFFFu
#endif
#define IN(k) (((PH_MASK >> (k)) & 1u) && lo <= (k) && (k) < hi)
#define SEAM(k) do { if (IN(k) && IN((k) + 1)) xcd_barrier(bar); } while (0)
#define W0IN WSP(bf16, WS_W0IN)
#define W0OUT WSP(bf16, WS_W0OUT)
#define W0GU WSP(bf16, WS_W0GU)
#define W0D WSP(bf16, WS_W0D)
#define W1IN WSP(bf16, WS_W1IN)
#define W1OUT WSP(bf16, WS_W1OUT)
#define XB WSP(bf16, WS_XB)
#define P WSP(bf16, WS_P)
#define X1 WSP(float, WS_X1)
#define HID WSP(bf16, WS_HID)
#define HB WSP(bf16, WS_H)
#define MIX ((bf16*)OUTP)
#define OUT OUTP
#define MOEGU ((bf16*)OUTP)
#define MOED WSP(bf16, WS_MOED)
#define Y0 WSP(bf16, WS_Y0)
#define Y1 WSP(bf16, WS_Y1)
#define MHID WSP(bf16, WS_MHID)
#define TOK_E WSP(int, WS_TAB + TAB_E)
#define TOK_P WSP(float, WS_TAB + TAB_P)
#define TOK_POS WSP(int, WS_TAB + TAB_POS)
#define ROWTOK WSP(int, WS_TAB + TAB_ROWTOK)
#define ROWDST WSP(int, WS_TAB + TAB_ROWDST)
#define ROWP WSP(float, WS_TAB + TAB_ROWP)
#define CNT ((unsigned*)(ctl + CW_CNT))
#define CSTAB WSP(float, WS_CS)
#define XA WSP(bf16, WS_H)
#define BCA WSP(bf16, WS_XB)
#define SMSB WSP(bf16, WS_XB + 32 * MiB)
    const int gw = F.bid * NWAVES + F.wave, NGW = F.G * NWAVES;
    LAS float* const scr = (LAS float*)(F.lds + F.wave * 16384);

    if (IN(0)) { PHASE_ENTER;
        transpose_job<1>(INP(I_EV_WIN), nullptr, 5936, 1024, W0IN, 6144, scr, gw, NGW, F.lane);
        transpose_job<0>(INP(I_EV_WOUT), nullptr, 1024, 2048, W0OUT, 1024, scr, gw, NGW, F.lane);
        transpose_job<2>(INP(I_FFN_WG), INP(I_FFN_WU), 3584, 1024, W0GU, 7168, scr, gw, NGW, F.lane);
        transpose_job<0>(INP(I_FFN_WD), nullptr, 1024, 3584, W0D, 1024, scr, gw, NGW, F.lane);
        transpose_job<0>(INP(I_OD_WIN), nullptr, 6144, 1024, W1IN, 6144, scr, gw, NGW, F.lane);
        transpose_job<0>(INP(I_OD_WOUT), nullptr, 1024, 2048, W1OUT, 1024, scr, gw, NGW, F.lane);
        const float* x = INP(I_X);
        for (size_t i = (size_t)(F.bid * NTHR + F.tid) * 8; i < (size_t)MTOK * DM; i += (size_t)F.G * NTHR * 8) {
            const f32x4 a = __builtin_nontemporal_load((const f32x4*)(x + i)), b = __builtin_nontemporal_load((const f32x4*)(x + i + 4));
            v4u o; o.x = pk2(a.x, a.y); o.y = pk2(a.z, a.w); o.z = pk2(b.x, b.y); o.w = pk2(b.z, b.w); *(v4u*)(XB + i) = o; }
    }
    SEAM(0);
    if (IN(1)) { PHASE_ENTER; pg8::StaticOrder S; S.init(MTOK, PW, F.G, F.bid, W0IN, 1024); pg8::EpiRoute0 E{P, L0_XBC, L0_RKVH, L0_SMB};
        pg8::gemm_phase<pg8::EpiRoute0, pg8::StaticOrder, true, false>(F.lds, XB, 1024, 1024, 1024, S, E); }
    SEAM(1);
    if (IN(2)) { PHASE_ENTER; conv_prepass(F, P, INP(I_CONVW), INP(I_CONVB), XA, BCA); small_prepass(F, P + L0_SMB, INP(I_MU), SMSB); }
    SEAM(2);
    if (IN(3)) { PHASE_ENTER;
        ssd_mfma(F, P, XA, BCA, INP(I_DTB), INP(I_ALOG), INP(I_DSKIP), MIX);
        __syncthreads();
        RwkvW W{INP(I_MU), INP(I_W0), INP(I_WUP), INP(I_A0), INP(I_AUP), INP(I_GUP), INP(I_KK), INP(I_KA), INP(I_RK), INP(I_RLNW), INP(I_RLNB)};
        rwkv_items(F, P, SMSB, W, MIX);
    }
    SEAM(3);
    if (IN(4)) { PHASE_ENTER; ssd_norm(F, MIX, INP(I_MNORM)); }
    SEAM(4);
    if (IN(5)) { PHASE_ENTER; pg8::StaticOrder S; S.init(MTOK, 1024, F.G, F.bid, W0OUT, 2048); pg8::EpiStore E{HB, 1024};
        pg8::gemm_phase<pg8::EpiStore, pg8::StaticOrder, true, false>(F.lds, MIX, 2048, 2048, 2048, S, E); }
    SEAM(5);
    if (IN(6)) { PHASE_ENTER; ln_rows<false, false>(F, INP(I_X), nullptr, HB, nullptr, INP(I_EV_LN1G), INP(I_EV_LN1B), nullptr, XB, 0, MTOK, nullptr, nullptr, nullptr, nullptr, nullptr); }
    SEAM(6);
    if (IN(7)) { PHASE_ENTER; pg8::StaticOrder S; S.init(MTOK, 2 * DFF, F.G, F.bid, W0GU, 1024); pg8::EpiSwiGLU E{HID, DFF};
        pg8::gemm_phase<pg8::EpiSwiGLU, pg8::StaticOrder, true, false>(F.lds, XB, 1024, 1024, 1024, S, E); }
    SEAM(7);
    if (IN(8)) { PHASE_ENTER; pg8::StaticOrder S; S.init(MTOK, 1024, F.G, F.bid, W0D, DFF); pg8::EpiStore E{HB, 1024};
        pg8::gemm_phase<pg8::EpiStore, pg8::StaticOrder, true, false>(F.lds, HID, DFF, DFF, DFF, S, E); }
    SEAM(8);
    if (IN(9)) { PHASE_ENTER; ln_rows<false, false>(F, nullptr, XB, HB, nullptr, INP(I_EV_LN2G), INP(I_EV_LN2B), nullptr, XB, 0, MTOK, nullptr, nullptr, nullptr, nullptr, nullptr); }
    SEAM(9);
    if (IN(10)) { PHASE_ENTER; pg8::StaticOrder S; S.init(MTOK, PW, F.G, F.bid, W1IN, 1024); pg8::EpiRoute1 E{P, L1_VH, L1_GB, (const int*)INP(I_POS)};
        pg8::gemm_phase<pg8::EpiRoute1, pg8::StaticOrder, true, false>(F.lds, XB, 1024, 1024, 1024, S, E); }
    SEAM(10);
    if (IN(11)) { PHASE_ENTER; retention_mfma(F, P); }
    SEAM(11);
    if (IN(12)) { PHASE_ENTER; retention_norm(F, P); }
    SEAM(12);
    if (IN(13)) { PHASE_ENTER; pg8::StaticOrder S; S.init(MTOK, 1024, F.G, F.bid, W1OUT, 2048); pg8::EpiStore E{HB, 1024};
        pg8::gemm_phase<pg8::EpiStore, pg8::StaticOrder, true, false>(F.lds, P + L1_GB, 2048, 2048, 2048, S, E); }
    SEAM(13);
    if (IN(14)) { PHASE_ENTER; ln_rows<true, false>(F, nullptr, XB, HB, nullptr, INP(I_OD_LN1G), INP(I_OD_LN1B), nullptr, XB, 0, MTOK, INP(I_ROUTER), CNT, TOK_E, TOK_P, TOK_POS); }
    SEAM(14);
    if (IN(15)) { PHASE_ENTER;
        for (int e = 0; e < NEXP; ++e) transpose_job<0>(INP(I_MOE_WD) + (size_t)e * DFF * 1024, nullptr, 1024, DFF, MOED + (size_t)e * 1024 * DFF, 1024, scr, gw, NGW, F.lane);
        for (int e = NEXP - 1; e >= 0; --e)
            transpose_job<2>(INP(I_MOE_WG) + (size_t)e * 1024 * DFF, INP(I_MOE_WU) + (size_t)e * 1024 * DFF, DFF, 1024, MOEGU + (size_t)e * 7168 * 1024, 7168, scr, gw, NGW, F.lane);
        moe_slots(F, CNT, TOK_E, TOK_P, TOK_POS, ROWTOK, ROWDST, ROWP);
    }
    SEAM(15);
#pragma unroll
    for (int part = 0; part < 2; ++part) {
        const int pa = 16 + 2 * part;
        if (IN(pa)) { PHASE_ENTER;
            LAS int* pexp = (LAS int*)(F.lds + PEXP_OFF);
            const int ptot = moe_panels(CNT, pexp, F.tid); const int p0 = part ? MOE_P1 : 0, np = part ? ptot - MOE_P1 : (ptot < MOE_P1 ? ptot : MOE_P1);
            MoeOrder S{np, 28, F.G, F.bid, (const char*)MOEGU, (size_t)7168 * 1024 * 2, (size_t)256 * 1024 * 2, ROWTOK, pexp, p0};
            pg8::EpiSwiGLU E{MHID, DFF};
            pg8::gemm_phase<pg8::EpiSwiGLU, MoeOrder, true, true>(F.lds, XB, 1024, 1024, 1024, S, E);
        }
        SEAM(pa);
        if (IN(pa + 1)) { PHASE_ENTER;
            LAS int* pexp = (LAS int*)(F.lds + PEXP_OFF);
            const int ptot = moe_panels(CNT, pexp, F.tid); const int p0 = part ? MOE_P1 : 0, np = part ? ptot - MOE_P1 : (ptot < MOE_P1 ? ptot : MOE_P1);
            MoeOrder S{np, 4, F.G, F.bid, (const char*)MOED, (size_t)1024 * DFF * 2, (size_t)256 * DFF * 2, nullptr, pexp, p0};
            pg8::EpiMoeOut E{Y0, Y1, 1024, MTOK, ROWDST + p0 * 256, ROWP + p0 * 256};
            pg8::gemm_phase<pg8::EpiMoeOut, MoeOrder, true, false>(F.lds, MHID, DFF, DFF, DFF, S, E);
        }
        SEAM(pa + 1);
    }
    if (IN(20)) { PHASE_ENTER; ln_rows<false, true>(F, nullptr, XB, Y0, Y1, INP(I_OD_LN2G), INP(I_OD_LN2B), OUT, nullptr, 0, MTOK, nullptr, nullptr, nullptr, nullptr, nullptr); }
#undef IN
#undef SEAM
#undef INP
#undef P
}
constexpr int N_PHASES = 21;

extern "C" void kernel_launch(void* const* d_in, const int* in_sizes, int n_in, void* d_out, int out_size, void* d_ws, size_t ws_size, hipStream_t stream) {
    static int grid = 0;
    if (grid == 0) {
        if (n_in != 38 || out_size != MTOK * DM || ws_size < WS_END) { fprintf(stderr, "kernel_launch: unexpected shapes (n_in %d out %d ws %zu)\n", n_in, out_size, ws_size); grid = -1; return; }
        int dev = 0, cus = 0;
        if (hipGetDevice(&dev) != hipSuccess || hipDeviceGetAttribute(&cus, hipDeviceAttributeMultiprocessorCount, dev) != hipSuccess) { grid = -1; return; }
        if (hipFuncSetAttribute((const void*)fwd_kernel, hipFuncAttributeMaxDynamicSharedMemorySize, LDS_BYTES) != hipSuccess) { grid = -1; return; }
        int per_cu = 0;
        (void)hipOccupancyMaxActiveBlocksPerMultiprocessor(&per_cu, (const void*)fwd_kernel, NTHR, LDS_BYTES);
        (void)hipGetLastError();
        grid = cus;
    }
    if (grid < 0) return;
    (void)hipMemsetAsync((char*)d_ws + WS_CTL, 0, CTL_ZERO_BYTES, stream);
    Args a{};
    for (int i = 0; i < 38; ++i) a.in[i] = d_in[i];
    a.out = (float*)d_out; a.ws = (unsigned char*)d_ws;
#if MK_ONE_LAUNCH
    a.ph_lo = 0; a.ph_hi = N_PHASES;
    hipLaunchKernelGGL(fwd_kernel, dim3(grid), dim3(NTHR), LDS_BYTES, stream, a);
#else
    for (int p = 0; p < N_PHASES; ++p) { a.ph_lo = p; a.ph_hi = p + 1; hipLaunchKernelGGL(fwd_kernel, dim3(grid), dim3(NTHR), LDS_BYTES, stream, a); }
#endif
}
```

```cpp
#include <hip/hip_runtime.h>
#include <cstdio>
#include <cstdint>

#ifndef MK_ONE_LAUNCH
#define MK_ONE_LAUNCH 1
#endif

namespace pg8 {
#define PG8_LAS __attribute__((address_space(3)))
typedef unsigned short bf16_t;
typedef short bf16x8 __attribute__((ext_vector_type(8)));
typedef float f32x4 __attribute__((ext_vector_type(4)));
typedef unsigned u32x4 __attribute__((ext_vector_type(4)));
constexpr int BM = 256, BK = 64, HALF = 128, HTB = HALF * BK * 2, STAGE_BYTES = 8 * HTB, NXCD = 8, WGM = 8;

__host__ __device__ __forceinline__ int lds_byte(int r, int c) { const int st = (r >> 4) * 2 + (c >> 5), rr = r & 15, cc = c & 31, ob = rr * 64 + cc * 2; return st * 1024 + (ob ^ (((ob >> 9) & 1) << 5)); }
__host__ __device__ __forceinline__ void stage_rc(int b, int& R, int& C) { const int st = b / 1024, sb = b % 1024, swz = sb ^ (((sb >> 9) & 1) << 5); R = (st >> 1) * 16 + swz / 64; C = (st & 1) * 32 + (swz % 64) / 2; }
__host__ __device__ __forceinline__ int perm32(int rho) { const int n = rho >> 4, i = rho & 15; return 8 * (i >> 2) + 4 * n + (i & 3); }

struct Unit { int pm, pn; };
typedef int i32x8 __attribute__((ext_vector_type(8)));
typedef int i32x4v __attribute__((ext_vector_type(4)));
typedef unsigned u32x2 __attribute__((ext_vector_type(2)));
__device__ __forceinline__ i32x8 cat16(bf16x8 lo, bf16x8 hi) { const i32x4v a = __builtin_bit_cast(i32x4v, lo), b = __builtin_bit_cast(i32x4v, hi); return (i32x8){a[0], a[1], a[2], a[3], b[0], b[1], b[2], b[3]}; }
__device__ __forceinline__ unsigned pk_i8x4(float a, float b, float c, float d) {
    const float M = 12582912.f;
    const unsigned qa = __builtin_bit_cast(unsigned, __builtin_amdgcn_fmed3f(a + M, M - 127.f, M + 127.f)), qb = __builtin_bit_cast(unsigned, __builtin_amdgcn_fmed3f(b + M, M - 127.f, M + 127.f));
    const unsigned qc = __builtin_bit_cast(unsigned, __builtin_amdgcn_fmed3f(c + M, M - 127.f, M + 127.f)), qd = __builtin_bit_cast(unsigned, __builtin_amdgcn_fmed3f(d + M, M - 127.f, M + 127.f));
    return __builtin_amdgcn_perm(__builtin_amdgcn_perm(qd, qc, 0x0C0C0400u), __builtin_amdgcn_perm(qb, qa, 0x0C0C0400u), 0x05040100u); }
__device__ __forceinline__ float i2f(float accbits) { return (float)__builtin_bit_cast(int, accbits); }

struct StaticOrder {
    int nM, nN, nwg, G, c; const char* Bt; size_t tstepB;
    __device__ void init(int M, int N, int G_, int c_, const bf16_t* Bt_, int ldb) { nM = M / BM; nN = N / BM; nwg = nM * nN; G = G_; c = c_; Bt = (const char*)Bt_; tstepB = (size_t)BM * ldb * 2; }
    __device__ bool next(int i, Unit& u) const {
        const long L = (long)i * G + c; if (L >= nwg) return false;
        int wgid = (int)L; { const int q = nwg / NXCD, r = nwg % NXCD, xcd = wgid % NXCD, off = wgid / NXCD; wgid = (xcd < r ? xcd * (q + 1) : r * (q + 1) + (xcd - r) * q) + off; }
        const int nig = WGM * nN, gid = wgid / nig, fm = gid * WGM, gsz = (nM - fm) < WGM ? (nM - fm) : WGM;
        u.pm = fm + ((wgid % nig) % gsz); u.pn = (wgid % nig) / gsz; return true;
    }
    __device__ __forceinline__ const char* b_base(const Unit& u) const { return Bt + (size_t)u.pn * tstepB; }
    __device__ __forceinline__ const int* a_rows(const Unit&) const { return nullptr; }
};

__device__ __forceinline__ unsigned cvt_pk_bf16(float lo, float hi) { unsigned r; asm volatile("v_cvt_pk_bf16_f32 %0, %1, %2" : "=v"(r) : "v"(lo), "v"(hi)); return r; }
__device__ __forceinline__ float silu_f(float x) { return x * __builtin_amdgcn_rcpf(1.0f + __expf(-x)); }

struct EpiStore {
    static constexpr bool PERM = true, AFTER_DRAIN = false, I2F = false;
    bf16_t* O; int ldc;
    __device__ __forceinline__ void operator()(const f32x4 (&acc)[2][2][4][2], const Unit& u, int wr, int wc, int fr, int fq) const {
        const int row0 = u.pm * BM + wr * 64 + fr, col0 = u.pn * BM + wc * 32 + 8 * fq;
#pragma unroll
        for (int ai = 0; ai < 2; ++ai)
#pragma unroll
            for (int m = 0; m < 4; ++m) { bf16_t* rowp = O + (size_t)(row0 + ai * HALF + m * 16) * ldc + col0;
#pragma unroll
                for (int bj = 0; bj < 2; ++bj) { const f32x4 v0 = acc[ai][bj][m][0], v1 = acc[ai][bj][m][1];
                    u32x4 w; w.x = cvt_pk_bf16(v0[0], v0[1]); w.y = cvt_pk_bf16(v0[2], v0[3]); w.z = cvt_pk_bf16(v1[0], v1[1]); w.w = cvt_pk_bf16(v1[2], v1[3]);
                    *(u32x4*)(rowp + bj * HALF) = w; } }
    }
};
struct EpiStoreRot {
    static constexpr bool PERM = true, AFTER_DRAIN = false, I2F = false;
    bf16_t* O; int ldc; const float* cs;
    __device__ __forceinline__ void operator()(const f32x4 (&acc)[2][2][4][2], const Unit& u, int wr, int wc, int fr, int fq) const {
        const int row0 = u.pm * BM + wr * 64 + fr, col0 = u.pn * BM + wc * 32 + 8 * fq;
        const bool rot = u.pn < 8; const float sc = u.pn >= 4 ? 0.0625f : 1.0f;
#pragma unroll
        for (int ai = 0; ai < 2; ++ai)
#pragma unroll
            for (int m = 0; m < 4; ++m) { const int row = row0 + ai * HALF + m * 16; bf16_t* rowp = O + (size_t)row * ldc + col0;
#pragma unroll
                for (int bj = 0; bj < 2; ++bj) { f32x4 v0 = acc[ai][bj][m][0], v1 = acc[ai][bj][m][1];
                    if (rot) { const int i0 = ((col0 + bj * HALF) & 255) >> 1; const float* cp = cs + ((size_t)row * 128 + i0) * 2;
                        const f32x4 c01 = *(const f32x4*)cp, c23 = *(const f32x4*)(cp + 4);
                        const f32x4 r0 = (f32x4){v0[0] * c01[0] - v0[1] * c01[1], v0[1] * c01[0] + v0[0] * c01[1], v0[2] * c01[2] - v0[3] * c01[3], v0[3] * c01[2] + v0[2] * c01[3]};
                        const f32x4 r1 = (f32x4){v1[0] * c23[0] - v1[1] * c23[1], v1[1] * c23[0] + v1[0] * c23[1], v1[2] * c23[2] - v1[3] * c23[3], v1[3] * c23[2] + v1[2] * c23[3]};
                        v0 = r0 * sc; v1 = r1 * sc; }
                    u32x4 w; w.x = cvt_pk_bf16(v0[0], v0[1]); w.y = cvt_pk_bf16(v0[2], v0[3]); w.z = cvt_pk_bf16(v1[0], v1[1]); w.w = cvt_pk_bf16(v1[2], v1[3]);
                    *(u32x4*)(rowp + bj * HALF) = w; } }
    }
};
struct EpiRoute0 {
    static constexpr bool PERM = true, AFTER_DRAIN = false, I2F = false;
    bf16_t* base; size_t o_xbc, o_rkvh, o_smb;
    __device__ __forceinline__ void operator()(const f32x4 (&acc)[2][2][4][2], const Unit& u, int wr, int wc, int fr, int fq) const {
        const int row0 = u.pm * BM + wr * 64 + fr, col0 = u.pn * BM + wc * 32 + 8 * fq, pn = u.pn;
#pragma unroll
        for (int ai = 0; ai < 2; ++ai)
#pragma unroll
            for (int m = 0; m < 4; ++m) { const int row = row0 + ai * HALF + m * 16, b = row >> 11, t = row & 2047;
#pragma unroll
                for (int bj = 0; bj < 2; ++bj) { const int col = col0 + bj * HALF; bf16_t* dst; bool ok = true;
                    if (pn < 4) dst = base + ((size_t)(b * 16 + (col >> 6)) * 2048 + t) * 64 + (col & 63);
                    else if (pn < 10) dst = base + o_xbc + (size_t)row * 1536 + (col - 1024);
                    else if (pn < 22) { const int cc = col - 2560; dst = base + o_rkvh + ((size_t)(b * 16 + ((cc & 1023) >> 6)) * 2048 + t) * 192 + (cc >> 10) * 64 + (cc & 63); }
                    else { const int cc = col - 5632; ok = cc < 320; dst = base + o_smb + (size_t)row * 320 + cc; }
                    const f32x4 v0 = acc[ai][bj][m][0], v1 = acc[ai][bj][m][1];
                    u32x4 w; w.x = cvt_pk_bf16(v0[0], v0[1]); w.y = cvt_pk_bf16(v0[2], v0[3]); w.z = cvt_pk_bf16(v1[0], v1[1]); w.w = cvt_pk_bf16(v1[2], v1[3]);
                    if (ok) *(u32x4*)dst = w; } }
    }
};
struct EpiRoute1 {
    static constexpr bool PERM = true, AFTER_DRAIN = false, I2F = true;
    bf16_t* base; size_t o_vh, o_gb; const int* pos; float isc; int pn0;
    __device__ __forceinline__ void operator()(const f32x4 (&acc)[2][2][4][2], const Unit& u, int wr, int wc, int fr, int fq) const {
        const int pn = u.pn + pn0, row0 = u.pm * BM + wr * 64 + fr, col0 = pn * BM + wc * 32 + 8 * fq;
        const bool rot = pn < 8; const float sc = pn >= 4 ? 0.0625f : 1.0f;
        float frq[2][4];
#pragma unroll
        for (int bj = 0; bj < 2; ++bj)
#pragma unroll
            for (int q = 0; q < 4; ++q) frq[bj][q] = __builtin_amdgcn_exp2f((float)((((col0 + bj * HALF) & 255) >> 1) + q) * (-13.287712379549449f / 127.0f)) * 0.15915494309189535f;
#pragma unroll
        for (int ai = 0; ai < 2; ++ai)
#pragma unroll
            for (int m = 0; m < 4; ++m) { const int row = row0 + ai * HALF + m * 16, b = row >> 11, t = row & 2047; const float ps = rot ? (float)pos[row] : 0.f;
#pragma unroll
                for (int bj = 0; bj < 2; ++bj) { const int col = col0 + bj * HALF; f32x4 v0 = acc[ai][bj][m][0], v1 = acc[ai][bj][m][1]; bf16_t* dst;
                    if (rot) { const int cc = col & 1023;
                        float cs_[8];
#pragma unroll
                        for (int q = 0; q < 4; ++q) { const float rev = __builtin_amdgcn_fractf(ps * frq[bj][q]); cs_[2 * q] = __builtin_amdgcn_cosf(rev); cs_[2 * q + 1] = __builtin_amdgcn_sinf(rev); }
                        const f32x4 c01 = (f32x4){cs_[0], cs_[1], cs_[2], cs_[3]}, c23 = (f32x4){cs_[4], cs_[5], cs_[6], cs_[7]};
                        const f32x4 r0 = (f32x4){v0[0] * c01[0] - v0[1] * c01[1], v0[1] * c01[0] + v0[0] * c01[1], v0[2] * c01[2] - v0[3] * c01[3], v0[3] * c01[2] + v0[2] * c01[3]};
                        const f32x4 r1 = (f32x4){v1[0] * c23[0] - v1[1] * c23[1], v1[1] * c23[0] + v1[0] * c23[1], v1[2] * c23[2] - v1[3] * c23[3], v1[3] * c23[2] + v1[2] * c23[3]};
                        v0 = r0 * sc; v1 = r1 * sc;
                        dst = base + ((size_t)(b * 4 + (cc >> 8)) * 2048 + t) * 512 + (pn >> 2) * 256 + (cc & 255); }
                    else if (pn < 16) { const int cc = col - 2048; dst = base + o_vh + ((size_t)((b * 4 + (cc >> 9)) * 4 + ((cc & 511) >> 7)) * 2048 + t) * 128 + (cc & 127); }
                    else dst = base + o_gb + (size_t)row * 2048 + (col - 4096);
                    u32x4 w; w.x = cvt_pk_bf16(v0[0], v0[1]); w.y = cvt_pk_bf16(v0[2], v0[3]); w.z = cvt_pk_bf16(v1[0], v1[1]); w.w = cvt_pk_bf16(v1[2], v1[3]);
                    *(u32x4*)dst = w; } }
    }
};
struct EpiSwiGLU {
    static constexpr bool PERM = true, AFTER_DRAIN = false, I2F = false;
    bf16_t* H; int ldc;
    __device__ __forceinline__ void operator()(const f32x4 (&acc)[2][2][4][2], const Unit& u, int wr, int wc, int fr, int fq) const {
        const int row0 = u.pm * BM + wr * 64 + fr, col0 = u.pn * HALF + wc * 32 + 8 * fq;
#pragma unroll
        for (int ai = 0; ai < 2; ++ai)
#pragma unroll
            for (int m = 0; m < 4; ++m) { bf16_t* rowp = H + (size_t)(row0 + ai * HALF + m * 16) * ldc + col0;
                float o[8];
#pragma unroll
                for (int n = 0; n < 2; ++n)
#pragma unroll
                    for (int j = 0; j < 4; ++j) o[n * 4 + j] = silu_f(acc[ai][0][m][n][j]) * acc[ai][1][m][n][j];
                u32x4 w; w.x = cvt_pk_bf16(o[0], o[1]); w.y = cvt_pk_bf16(o[2], o[3]); w.z = cvt_pk_bf16(o[4], o[5]); w.w = cvt_pk_bf16(o[6], o[7]);
                __builtin_nontemporal_store(w, (u32x4*)rowp); }
    }
};
struct EpiStoreRS {
    static constexpr bool PERM = true, AFTER_DRAIN = false, I2F = false;
    bf16_t* O; int ldc; const float* rsc; float wsc;
    __device__ __forceinline__ void operator()(const f32x4 (&acc)[2][2][4][2], const Unit& u, int wr, int wc, int fr, int fq) const {
        const int row0 = u.pm * BM + wr * 64 + fr, col0 = u.pn * BM + wc * 32 + 8 * fq;
#pragma unroll
        for (int ai = 0; ai < 2; ++ai)
#pragma unroll
            for (int m = 0; m < 4; ++m) { const int row = row0 + ai * HALF + m * 16; bf16_t* rowp = O + (size_t)row * ldc + col0; const float sc = rsc[row] * wsc;
#pragma unroll
                for (int bj = 0; bj < 2; ++bj) { const f32x4 v0 = acc[ai][bj][m][0], v1 = acc[ai][bj][m][1];
                    u32x4 w; w.x = cvt_pk_bf16(i2f(v0[0]) * sc, i2f(v0[1]) * sc); w.y = cvt_pk_bf16(i2f(v0[2]) * sc, i2f(v0[3]) * sc); w.z = cvt_pk_bf16(i2f(v1[0]) * sc, i2f(v1[1]) * sc); w.w = cvt_pk_bf16(i2f(v1[2]) * sc, i2f(v1[3]) * sc);
                    *(u32x4*)(rowp + bj * HALF) = w; }
                asm volatile("" ::: "memory"); }
    }
};
struct EpiStoreI8 {
    static constexpr bool PERM = true, AFTER_DRAIN = false, I2F = false;
    bf16_t* O; int ldc; float sc;
    __device__ __forceinline__ void operator()(const f32x4 (&acc)[2][2][4][2], const Unit& u, int wr, int wc, int fr, int fq) const {
        const int row0 = u.pm * BM + wr * 64 + fr, col0 = u.pn * BM + wc * 32 + 8 * fq;
#pragma unroll
        for (int ai = 0; ai < 2; ++ai)
#pragma unroll
            for (int m = 0; m < 4; ++m) { bf16_t* rowp = O + (size_t)(row0 + ai * HALF + m * 16) * ldc + col0;
#pragma unroll
                for (int bj = 0; bj < 2; ++bj) { const f32x4 v0 = acc[ai][bj][m][0], v1 = acc[ai][bj][m][1];
                    u32x4 w; w.x = cvt_pk_bf16(i2f(v0[0]) * sc, i2f(v0[1]) * sc); w.y = cvt_pk_bf16(i2f(v0[2]) * sc, i2f(v0[3]) * sc); w.z = cvt_pk_bf16(i2f(v1[0]) * sc, i2f(v1[1]) * sc); w.w = cvt_pk_bf16(i2f(v1[2]) * sc, i2f(v1[3]) * sc);
                    *(u32x4*)(rowp + bj * HALF) = w; } }
    }
};
struct EpiSwiGLU8 {
    static constexpr bool PERM = true, AFTER_DRAIN = false, I2F = false;
    unsigned char* H; int ldc; float isc, hsc;
    __device__ __forceinline__ void operator()(const f32x4 (&acc)[2][2][4][2], const Unit& u, int wr, int wc, int fr, int fq) const {
        const int row0 = u.pm * BM + wr * 64 + fr, col0 = u.pn * HALF + wc * 32 + 8 * fq;
        const float nl2 = -1.4426950408889634f * isc, C = isc * isc * hsc, MAGIC = 12582912.f;
#pragma unroll
        for (int ai = 0; ai < 2; ++ai)
#pragma unroll
            for (int m = 0; m < 4; ++m) { unsigned char* rowp = H + (size_t)(row0 + ai * HALF + m * 16) * ldc + col0;
                unsigned wq[2];
#pragma unroll
                for (int n = 0; n < 2; ++n) {
                    const f32x4 cg = __builtin_convertvector(__builtin_bit_cast(i32x4v, acc[ai][0][m][n]), f32x4), cu = __builtin_convertvector(__builtin_bit_cast(i32x4v, acc[ai][1][m][n]), f32x4);
                    const f32x4 ea = cg * nl2;
                    f32x4 d = (f32x4){__builtin_amdgcn_exp2f(ea[0]), __builtin_amdgcn_exp2f(ea[1]), __builtin_amdgcn_exp2f(ea[2]), __builtin_amdgcn_exp2f(ea[3])} + 1.f;
                    const f32x4 r = (f32x4){__builtin_amdgcn_rcpf(d[0]), __builtin_amdgcn_rcpf(d[1]), __builtin_amdgcn_rcpf(d[2]), __builtin_amdgcn_rcpf(d[3])};
                    f32x4 t = (cg * cu) * r;
                    t = t * C + MAGIC;
                    const unsigned q0 = __builtin_bit_cast(unsigned, __builtin_amdgcn_fmed3f(t[0], MAGIC - 127.f, MAGIC + 127.f)), q1 = __builtin_bit_cast(unsigned, __builtin_amdgcn_fmed3f(t[1], MAGIC - 127.f, MAGIC + 127.f));
                    const unsigned q2 = __builtin_bit_cast(unsigned, __builtin_amdgcn_fmed3f(t[2], MAGIC - 127.f, MAGIC + 127.f)), q3 = __builtin_bit_cast(unsigned, __builtin_amdgcn_fmed3f(t[3], MAGIC - 127.f, MAGIC + 127.f));
                    wq[n] = __builtin_amdgcn_perm(__builtin_amdgcn_perm(q3, q2, 0x0C0C0400u), __builtin_amdgcn_perm(q1, q0, 0x0C0C0400u), 0x05040100u);
                }
                u32x2 w; w.x = wq[0]; w.y = wq[1];
                *(u32x2*)rowp = w; }
    }
};
struct EpiMoeOut {
    static constexpr bool PERM = true, AFTER_DRAIN = false, I2F = false;
    bf16_t* Y0; bf16_t* Y1; int ldc; int nhalf; const int* rowdst; const float* rowp; float osc; bool i8;
    __device__ __forceinline__ void operator()(const f32x4 (&acc)[2][2][4][2], const Unit& u, int wr, int wc, int fr, int fq) const {
        const int row0 = u.pm * BM + wr * 64 + fr, col0 = u.pn * BM + wc * 32 + 8 * fq;
#pragma unroll
        for (int ai = 0; ai < 2; ++ai)
#pragma unroll
            for (int m = 0; m < 4; ++m) { const int slot = row0 + ai * HALF + m * 16; const int dst = rowdst[slot]; const float p = rowp[slot] * osc;
                if (dst >= 0) { bf16_t* rowpt = (dst >= nhalf ? Y1 + (size_t)(dst - nhalf) * ldc : Y0 + (size_t)dst * ldc) + col0;
#pragma unroll
                    for (int bj = 0; bj < 2; ++bj) { f32x4 v0 = acc[ai][bj][m][0], v1 = acc[ai][bj][m][1];
                        if (i8) { v0 = (f32x4){i2f(v0[0]), i2f(v0[1]), i2f(v0[2]), i2f(v0[3])}; v1 = (f32x4){i2f(v1[0]), i2f(v1[1]), i2f(v1[2]), i2f(v1[3])}; }
                        v0 = v0 * p; v1 = v1 * p;
                        u32x4 w; w.x = cvt_pk_bf16(v0[0], v0[1]); w.y = cvt_pk_bf16(v0[2], v0[3]); w.z = cvt_pk_bf16(v1[0], v1[1]); w.w = cvt_pk_bf16(v1[2], v1[3]);
                        *(u32x4*)(rowpt + bj * HALF) = w; } }
                asm volatile("" ::: "memory"); }
    }
};

template <class Epi, class Sched, bool ALIGN_EPI, bool GATHER, bool FP8 = false>
__device__ __forceinline__ void gemm_phase(PG8_LAS unsigned char* lds, const bf16_t* Abase, int lda, int ldb, int K, const Sched& S, const Epi& E) {
    const int tid = threadIdx.x, wid = __builtin_amdgcn_readfirstlane(tid >> 6), lane = tid & 63, wr = wid >> 2, wc = wid & 3, fr = lane & 15, fq = lane >> 4;
    constexpr int ESZ = FP8 ? 1 : 2;
    const int nt = K * ESZ / (BK * 2);
    int RA[2], CA[2]; unsigned voffB[2];
#pragma unroll
    for (int i = 0; i < 2; ++i) { int R, C; stage_rc(tid * 16 + i * 8192, R, C); const int Rb = Epi::PERM ? ((R & ~31) + perm32(R & 31)) : R;
        RA[i] = R; CA[i] = C; voffB[i] = (unsigned)(Rb * ldb * ESZ + C * 2); }
    const size_t kstep = (size_t)(BK * 2);
    const size_t hstepB = (size_t)HALF * ldb * ESZ;
    const size_t tstepA = (size_t)BM * lda * ESZ;
    const unsigned ldsw = (unsigned)wid * 1024u;
    const int aoff = lds_byte(wr * 64 + fr, fq * 8), boff = lds_byte(wc * 32 + fr, fq * 8);
#define PG8_SA(b, h) (((b) * 2 + (h)) * HTB)
#define PG8_SB(b, h) ((4 + (b) * 2 + (h)) * HTB)
#define PG8_STAGE(bufoff, gbase, voff) do { _Pragma("unroll") for (int _i = 0; _i < 2; ++_i) \
        __builtin_amdgcn_global_load_lds((const unsigned*)((const char*)(gbase) + (voff)[_i]), (PG8_LAS unsigned*)(lds + (bufoff) + ldsw + _i * 8192), 16, 0, 0); } while (0)
#define PG8_LDA(dst, b, h) do { _Pragma("unroll") for (int m = 0; m < 4; ++m) _Pragma("unroll") for (int k = 0; k < 2; ++k) dst[m][k] = *(const PG8_LAS bf16x8*)(lds + PG8_SA(b, h) + aoff + m * 2048 + k * 1024); } while (0)
#define PG8_LDB(dst, b, h) do { _Pragma("unroll") for (int n = 0; n < 2; ++n) _Pragma("unroll") for (int k = 0; k < 2; ++k) dst[n][k] = *(const PG8_LAS bf16x8*)(lds + PG8_SB(b, h) + boff + n * 2048 + k * 1024); } while (0)
#define PG8_MMA(ai, bj, At, Bt) do { __builtin_amdgcn_s_setprio(1); _Pragma("unroll") for (int m = 0; m < 4; ++m) _Pragma("unroll") for (int n = 0; n < 2; ++n) { \
        if constexpr (FP8) { _Pragma("unroll") for (int k = 0; k < 2; ++k) acc[ai][bj][m][n] = __builtin_bit_cast(f32x4, __builtin_amdgcn_mfma_i32_16x16x64_i8(__builtin_bit_cast(i32x4v, Bt[n][k]), __builtin_bit_cast(i32x4v, At[m][k]), __builtin_bit_cast(i32x4v, acc[ai][bj][m][n]), 0, 0, 0)); } \
        else { _Pragma("unroll") for (int k = 0; k < 2; ++k) acc[ai][bj][m][n] = __builtin_amdgcn_mfma_f32_16x16x32_bf16(Bt[n][k], At[m][k], acc[ai][bj][m][n], 0, 0, 0); } } __builtin_amdgcn_s_setprio(0); } while (0)
#define PG8_WAIT_V(n) asm volatile("s_waitcnt vmcnt(" #n ")" ::: "memory")
#define PG8_WAIT_L(n) asm volatile("s_waitcnt lgkmcnt(" #n ")" ::: "memory")
#define PG8_BAR __builtin_amdgcn_s_barrier()
#define PG8_SCHED __builtin_amdgcn_sched_barrier(0)
    Unit cur, nxt; int ui = 0;
    if (!S.next(0, cur)) return;
    f32x4 acc[2][2][4][2];
#pragma unroll
    for (int a = 0; a < 2; ++a)
#pragma unroll
        for (int b = 0; b < 2; ++b)
#pragma unroll
            for (int m = 0; m < 4; ++m)
#pragma unroll
                for (int n = 0; n < 2; ++n) acc[a][b][m][n] = (f32x4){0.f, 0.f, 0.f, 0.f};
    bf16x8 At[4][2], B0[2][2], B1[2][2];
    unsigned vA[2][2];
    const char* cA; const char* cB = S.b_base(cur);
    PG8_LAS int* const rowslot = (PG8_LAS int*)(lds + STAGE_BYTES + 4096);
#define PG8_ROWS_DMA(slot, rows) do { if (wid < 4) __builtin_amdgcn_global_load_lds((const unsigned*)((rows) + tid), (PG8_LAS unsigned*)(rowslot + (slot) * 256 + wid * 64), 4, 0, 0); } while (0)
#define PG8_GOFF(dst, slot) do { _Pragma("unroll") for (int _h = 0; _h < 2; ++_h) _Pragma("unroll") for (int _i = 0; _i < 2; ++_i) dst[_h][_i] = (unsigned)(rowslot[(slot) * 256 + _h * HALF + RA[_i]] * lda * ESZ + CA[_i] * 2); } while (0)
    if constexpr (GATHER) { cA = (const char*)Abase; PG8_ROWS_DMA(0, S.a_rows(cur)); PG8_WAIT_V(0); PG8_BAR; PG8_GOFF(vA, 0); }
    else { cA = (const char*)Abase + (size_t)cur.pm * tstepA;
#pragma unroll
        for (int h = 0; h < 2; ++h)
#pragma unroll
            for (int i = 0; i < 2; ++i) vA[h][i] = (unsigned)((h * HALF + RA[i]) * lda * ESZ + CA[i] * 2);
    }
    PG8_STAGE(PG8_SB(0, 0), cB, voffB); PG8_STAGE(PG8_SB(0, 1), cB + hstepB, voffB); PG8_STAGE(PG8_SA(0, 0), cA, vA[0]); PG8_STAGE(PG8_SA(0, 1), cA, vA[1]);
    if (wr == 1) PG8_BAR;
    PG8_WAIT_V(2); PG8_BAR;
    PG8_STAGE(PG8_SB(1, 0), cB + kstep, voffB); PG8_STAGE(PG8_SA(1, 0), cA + kstep, vA[0]); PG8_STAGE(PG8_SB(1, 1), cB + hstepB + kstep, voffB);
    PG8_WAIT_V(6); PG8_BAR;
    for (;;) {
        const bool has_next = S.next(ui + 1, nxt);
        const char* nA; const char* nB = has_next ? S.b_base(nxt) : cB;
        if constexpr (GATHER) { nA = cA; if (has_next) PG8_ROWS_DMA((ui + 1) & 1, S.a_rows(nxt)); }
        else nA = has_next ? (const char*)Abase + (size_t)nxt.pm * tstepA : cA;
#pragma nounroll
        for (int t = 0; t < nt; t += 2) {
            const bool last = (t == nt - 2);
            const char* a1 = cA + (size_t)(t + 1) * kstep;
            const char* a2 = last ? nA : cA + (size_t)(t + 2) * kstep; const char* b2 = last ? nB : cB + (size_t)(t + 2) * kstep;
            const char* a3 = a2 + kstep; const char* b3 = b2 + kstep;
            unsigned v2[2][2];
            if constexpr (GATHER) { if (last && has_next) PG8_GOFF(v2, (ui + 1) & 1); else PG8_GOFF(v2, ui & 1); PG8_GOFF(vA, ui & 1); }
            else {
#pragma unroll
                for (int h = 0; h < 2; ++h)
#pragma unroll
                    for (int i = 0; i < 2; ++i) v2[h][i] = vA[h][i];
            }
            PG8_LDB(B0, 0, 0); PG8_LDB(B1, 0, 1); PG8_SCHED; PG8_LDA(At, 0, 0); PG8_STAGE(PG8_SA(1, 1), a1, vA[1]);
            PG8_WAIT_V(8); PG8_WAIT_L(0); PG8_BAR; PG8_MMA(0, 0, At, B0); PG8_MMA(0, 1, At, B1); PG8_BAR; PG8_SCHED;
            PG8_LDA(At, 0, 1); PG8_STAGE(PG8_SB(0, 0), b2, voffB); PG8_STAGE(PG8_SB(0, 1), b2 + hstepB, voffB); PG8_STAGE(PG8_SA(0, 0), a2, v2[0]);
            PG8_WAIT_V(8); PG8_WAIT_L(0); PG8_BAR; PG8_MMA(1, 0, At, B0); PG8_MMA(1, 1, At, B1); PG8_BAR; PG8_SCHED;
            PG8_LDB(B0, 1, 0); PG8_LDB(B1, 1, 1); PG8_SCHED; PG8_LDA(At, 1, 0); PG8_STAGE(PG8_SA(0, 1), a2, v2[1]);
            PG8_WAIT_V(8); PG8_WAIT_L(0); PG8_BAR; PG8_MMA(0, 0, At, B0); PG8_MMA(0, 1, At, B1); PG8_BAR; PG8_SCHED;
            PG8_LDA(At, 1, 1); PG8_STAGE(PG8_SB(1, 0), b3, voffB); PG8_STAGE(PG8_SB(1, 1), b3 + hstepB, voffB); PG8_STAGE(PG8_SA(1, 0), a3, v2[0]);
            PG8_WAIT_V(8); PG8_WAIT_L(0); PG8_BAR; PG8_MMA(1, 0, At, B0); PG8_MMA(1, 1, At, B1); PG8_BAR; PG8_SCHED;
        }
        if constexpr (ALIGN_EPI) { if (wr == 0) PG8_BAR; }
        if constexpr (FP8 && Epi::I2F) {
#pragma unroll
            for (int a = 0; a < 2; ++a)
#pragma unroll
                for (int b = 0; b < 2; ++b)
#pragma unroll
                    for (int m = 0; m < 4; ++m)
#pragma unroll
                        for (int n = 0; n < 2; ++n) { const i32x4v q = __builtin_bit_cast(i32x4v, acc[a][b][m][n]); acc[a][b][m][n] = (f32x4){(float)q[0], (float)q[1], (float)q[2], (float)q[3]} * E.isc; } }
        E(acc, cur, wr, wc, fr, fq);
        if (!has_next) break;
#pragma unroll
        for (int a = 0; a < 2; ++a)
#pragma unroll
            for (int b = 0; b < 2; ++b)
#pragma unroll
                for (int m = 0; m < 4; ++m)
#pragma unroll
                    for (int n = 0; n < 2; ++n) acc[a][b][m][n] = (f32x4){0.f, 0.f, 0.f, 0.f};
        cur = nxt; cA = nA; cB = nB; ++ui;
        if constexpr (ALIGN_EPI) { if (wr == 1) PG8_BAR; }
    }
    PG8_WAIT_V(0);
    if constexpr (!ALIGN_EPI) { if (wr == 0) PG8_BAR; }
    PG8_BAR;
#undef PG8_SA
#undef PG8_SB
#undef PG8_STAGE
#undef PG8_LDA
#undef PG8_LDB
#undef PG8_MMA
#undef PG8_WAIT_V
#undef PG8_WAIT_L
#undef PG8_BAR
#undef PG8_SCHED
#undef PG8_ROWS_DMA
#undef PG8_GOFF
}
}

constexpr int NWAVES = 8, NTHR = 512;
constexpr int BATCH = 16, SEQ = 2048, DM = 1024, MTOK = BATCH * SEQ;
constexpr int PW = 6144;
constexpr int DFF = 3584, NEXP = 8;
constexpr float WO_SC = 2600.f;
constexpr float XQ_SC = 28.f, WGU_SC = 900.f, HQ_SC = 16.f, WD_SC = 3400.f;
constexpr int MOE_PARTS = 1;
constexpr int MOE_P1 = MOE_PARTS == 1 ? 272 : 128, MOE_ROWS = (MTOK * 2 / 256 - MOE_P1 + NEXP) * 256, MOE_SLOTS = MTOK * 2 + NEXP * 256;
constexpr float ALPHA = 1.4142135623730951f;
constexpr float LN_EPS = 1e-5f;
constexpr int PC_Z = 0, PC_XBC = 1024, PC_RKV = 2560, PC_SM = 5632, PC_DT = 5920;
constexpr size_t L0_ZH = 0, L0_XBC = (size_t)MTOK * 1024, L0_RKVH = (size_t)MTOK * 2560, L0_SMB = (size_t)MTOK * 5632;
constexpr size_t L1_QKH = 0, L1_VH = (size_t)MTOK * 2048, L1_GB = (size_t)MTOK * 4096;

constexpr size_t MiB = 1u << 20;
constexpr size_t WS_CTL = 0, CTL_ZERO_BYTES = 1 * MiB;
constexpr size_t WS_W0IN = 1 * MiB, WS_W0OUT = 13 * MiB, WS_W0GU = 17 * MiB, WS_W0D = 31 * MiB, WS_W1IN = 38 * MiB, WS_W1OUT = 50 * MiB;
constexpr size_t WS_XB = 54 * MiB;
constexpr size_t WS_P = 118 * MiB;
constexpr size_t WS_X1 = 118 * MiB;
constexpr size_t WS_HID = 246 * MiB;
constexpr size_t WS_H = 502 * MiB;
constexpr size_t WS_MOED = 118 * MiB;
constexpr size_t WS_Y0 = 174 * MiB, WS_Y1 = 238 * MiB, WS_MHID = 302 * MiB;
constexpr size_t WS_CS = 1 * MiB;
constexpr size_t WS_TAB = 34 * MiB;
constexpr size_t TAB_E = 0, TAB_P = 128 * 1024, TAB_POS = 256 * 1024, TAB_ROWTOK = 512 * 1024, TAB_ROWDST = 1024 * 1024, TAB_ROWP = 1536 * 1024;
constexpr size_t WS_X2Q = 1 * MiB;
constexpr size_t WS_XQ = 1 * MiB;
constexpr size_t WS_XQ_OLD = 422 * MiB;
constexpr size_t WS_END = 566 * MiB;
constexpr int CW_TMO = 0, CW_BAR = 4096, CW_CNT = 8192;

constexpr int RING_BYTES = 131072, MISC_OFF = RING_BYTES + 320, LCNT_OFF = RING_BYTES + 512, PEXP_OFF = RING_BYTES + 1024, LDS_BYTES = 147456;

#define GAS __attribute__((address_space(1)))
#define LAS __attribute__((address_space(3)))
typedef unsigned short bf16;
typedef unsigned v4u __attribute__((ext_vector_type(4)));
typedef unsigned v2u __attribute__((ext_vector_type(2)));
typedef float f32x4 __attribute__((ext_vector_type(4)));
typedef GAS unsigned gu32;
#define RLX_AGENT __ATOMIC_RELAXED, __HIP_MEMORY_SCOPE_AGENT
#define LDS_WAIT() asm volatile("s_waitcnt lgkmcnt(0)" ::: "memory")
__device__ __forceinline__ unsigned f2bf(float f) { unsigned u = __builtin_bit_cast(unsigned, f); return (u + 0x7fffu + ((u >> 16) & 1u)) >> 16; }
__device__ __forceinline__ unsigned pk2(float lo, float hi) { typedef float f2_ __attribute__((ext_vector_type(2))); typedef __bf16 b2_ __attribute__((ext_vector_type(2))); const f2_ v = {lo, hi}; return __builtin_bit_cast(unsigned, __builtin_convertvector(v, b2_)); }
__device__ __forceinline__ float bf2f(bf16 v) { return __builtin_bit_cast(float, (unsigned)v << 16); }
__device__ __forceinline__ float bflo(unsigned w) { return __builtin_bit_cast(float, w << 16); }
__device__ __forceinline__ float bfhi(unsigned w) { return __builtin_bit_cast(float, w & 0xffff0000u); }
__device__ __forceinline__ float sigmoid_f(float x) { return 1.0f / (1.0f + __expf(-x)); }
__device__ __forceinline__ float silu_f(float x) { return x * __builtin_amdgcn_rcpf(1.0f + __expf(-x)); }
__device__ __forceinline__ float softplus_f(float x) { return x > 20.f ? x : log1pf(__expf(x)); }
__device__ __forceinline__ float wave_sum(float v) {
    v += __builtin_bit_cast(float, __builtin_amdgcn_update_dpp(0, __builtin_bit_cast(int, v), 0x128, 0xf, 0xf, true));
    v += __builtin_bit_cast(float, __builtin_amdgcn_update_dpp(0, __builtin_bit_cast(int, v), 0x124, 0xf, 0xf, true));
    v += __builtin_bit_cast(float, __builtin_amdgcn_update_dpp(0, __builtin_bit_cast(int, v), 0x122, 0xf, 0xf, true));
    v += __builtin_bit_cast(float, __builtin_amdgcn_update_dpp(0, __builtin_bit_cast(int, v), 0x121, 0xf, 0xf, true));
    const float r0 = __builtin_bit_cast(float, __builtin_amdgcn_readlane(__builtin_bit_cast(int, v), 0)), r1 = __builtin_bit_cast(float, __builtin_amdgcn_readlane(__builtin_bit_cast(int, v), 16));
    const float r2 = __builtin_bit_cast(float, __builtin_amdgcn_readlane(__builtin_bit_cast(int, v), 32)), r3 = __builtin_bit_cast(float, __builtin_amdgcn_readlane(__builtin_bit_cast(int, v), 48));
    return (r0 + r1) + (r2 + r3);
}

#define LDS_BARRIER() asm volatile("s_waitcnt lgkmcnt(0)\n\ts_barrier" ::: "memory")
#define XB_TMO      128
#define XB_XCNT(j)  (256  + 64 * (j))
#define XB_XSUB(j)  (1280 + 64 * (j))
#define XB_XGEN(j)  (2304 + 64 * (j))
#define XB_TOP      3328
#define XB_TOPGEN   3392
#define XCD_BAR_WORDS 3456
#define XB_SPIN_CAP (1u << 18)
__device__ __forceinline__ unsigned xb_ld(unsigned* p)              { return __hip_atomic_load(p, __ATOMIC_RELAXED, __HIP_MEMORY_SCOPE_AGENT); }
__device__ __forceinline__ unsigned xb_add(unsigned* p, unsigned v) { return __hip_atomic_fetch_add(p, v, __ATOMIC_RELAXED, __HIP_MEMORY_SCOPE_AGENT); }
__device__ __forceinline__ unsigned xb_xcc_id() { return (unsigned)__builtin_amdgcn_s_getreg((3 << 11) | 20) & 0xFu; }
#define XB_SPIN(cond, bar) do { unsigned _sp = 0; while (cond) { __builtin_amdgcn_s_sleep(1); \
    if ((++_sp & 255u) == 0u) { if (xb_ld(&(bar)[XB_TMO])) break; if (_sp > XB_SPIN_CAP) { atomicAdd(&(bar)[XB_TMO], 1u); break; } } } } while (0)
struct XcdBarrier { unsigned* bar; unsigned x; volatile LAS unsigned* st; };
__device__ __forceinline__ XcdBarrier xcd_barrier_post(unsigned* bar, volatile LAS unsigned* st) {
    XcdBarrier b; b.bar = bar; b.x = xb_xcc_id(); b.st = st;
    if (threadIdx.x == 0) (void)xb_add(&bar[XB_XCNT(b.x)], 1u);
    return b;
}
__device__ __forceinline__ void xcd_barrier_complete(unsigned* bar, unsigned x, unsigned& nloc, unsigned& nx) {
    const unsigned G = gridDim.x * gridDim.y * gridDim.z;
    unsigned sum, cnt, mine, sp = 0u;
    for (;;) {
        sum = 0u; cnt = 0u; mine = 0u;
#pragma unroll
        for (unsigned j = 0; j < 16; ++j) { const unsigned c = xb_ld(&bar[XB_XCNT(j)]); sum += c; cnt += (c > 0u) ? 1u : 0u; mine = (j == x) ? c : mine; }
        if (sum == G) break;
        __builtin_amdgcn_s_sleep(1);
        if ((++sp & 255u) == 0u) { if (xb_ld(&bar[XB_TMO])) break; if (sp > XB_SPIN_CAP) { atomicAdd(&bar[XB_TMO], 1u); break; } }
    }
    nloc = mine > 0u ? mine : 1u; nx = cnt > 0u ? cnt : 1u;
}
__device__ __forceinline__ void xcd_barrier(const XcdBarrier& b) {
    asm volatile("s_waitcnt vmcnt(0)" ::: "memory");
    __syncthreads();
    if (threadIdx.x == 0) {
        unsigned* bar = b.bar;
        __builtin_amdgcn_s_waitcnt(0);
        unsigned nloc = b.st[0], nx = b.st[1];
        if (nloc == 0u) { xcd_barrier_complete(bar, b.x, nloc, nx); b.st[0] = nloc; b.st[1] = nx; }
        const unsigned old = xb_add(&bar[XB_XSUB(b.x)], 1u);
        const unsigned gen = old / nloc;
        if (old + 1u == (gen + 1u) * nloc) {
            __builtin_amdgcn_fence(__ATOMIC_RELEASE, "agent");
            asm volatile("s_waitcnt vmcnt(0)" ::: "memory");
            const unsigned og = xb_add(&bar[XB_TOP], 1u);
            const unsigned tg = og / nx;
            if (og + 1u == (tg + 1u) * nx) xb_add(&bar[XB_TOPGEN], 1u);
            else XB_SPIN(xb_ld(&bar[XB_TOPGEN]) == tg, bar);
            __builtin_amdgcn_fence(__ATOMIC_ACQUIRE, "agent");
            xb_add(&bar[XB_XGEN(b.x)], 1u);
            asm volatile("s_waitcnt vmcnt(0)" ::: "memory");
        } else {
            XB_SPIN(xb_ld(&bar[XB_XGEN(b.x)]) == gen, bar);
            __builtin_amdgcn_fence(__ATOMIC_ACQUIRE, "agent");
            asm volatile("s_waitcnt vmcnt(0)" ::: "memory");
        }
    }
    __syncthreads();
}

struct Args { const void* in[38]; float* out; unsigned char* ws; int ph_lo, ph_hi; };
enum { I_X = 0, I_POS, I_EV_WIN, I_CONVW, I_CONVB, I_DTB, I_ALOG, I_DSKIP, I_MNORM, I_MU, I_W0, I_WUP, I_A0, I_AUP, I_GUP, I_KK, I_KA, I_RK, I_RLNW, I_RLNB, I_EV_WOUT,
       I_EV_LN1G, I_EV_LN1B, I_FFN_WG, I_FFN_WU, I_FFN_WD, I_EV_LN2G, I_EV_LN2B, I_OD_WIN, I_OD_WOUT, I_OD_LN1G, I_OD_LN1B, I_ROUTER, I_MOE_WG, I_MOE_WU, I_MOE_WD, I_OD_LN2G, I_OD_LN2B };

struct Frame {
    LAS unsigned char* lds;
    int tid, lane, wave, G, bid;
};

template <int TYPE>
__device__ __forceinline__ void transpose_job(const float* W, const float* W2, int ldw, int K, bf16* WT, int nrows, LAS float* scr_f, int gw, int NGW, int lane) {
    LAS unsigned char* scr = (LAS unsigned char*)scr_f;
    const int nblk = nrows / 64, nitems = (K / 64) * nblk;
    const int l16 = lane & 15, lq = lane >> 4;
    for (int item = gw; item < nitems; item += NGW) {
        const int kb = item / nblk, nb = item % nblk, k0 = 64 * kb, n0 = 64 * nb;
        const int np = n0 + 4 * l16;
        const float* src = W; int col = np;
        if (TYPE == 1) { if (np < 2560) col = np; else if (np < 5920) col = np + 16; else if (np < 5936) col = 2560 + (np - 5920); else col = -1; }
        if (TYPE == 2) { const int pn = np >> 8, j = np & 255; if (j < 128) col = 128 * pn + j; else { src = W2; col = 128 * pn + j - 128; } }
#pragma unroll
        for (int i = 0; i < 8; ++i) { const int kk = 8 * i + 2 * lq;
            f32x4 va = (f32x4){0.f, 0.f, 0.f, 0.f}, vb = va;
            if (col >= 0) { va = __builtin_nontemporal_load((const f32x4*)(src + (size_t)(k0 + kk) * ldw + col)); vb = __builtin_nontemporal_load((const f32x4*)(src + (size_t)(k0 + kk + 1) * ldw + col)); }
#pragma unroll
            for (int j = 0; j < 4; ++j) *(LAS unsigned*)(scr + (4 * l16 + j) * 136 + kk * 2) = pk2(va[j], vb[j]); }
        LDS_WAIT(); asm volatile("" ::: "memory");
#pragma unroll
        for (int j = 0; j < 8; ++j) { const int ch = lane + 64 * j, n = ch >> 3, kc = ch & 7;
            const v2u lo = *(const LAS v2u*)(scr + n * 136 + kc * 16), hi = *(const LAS v2u*)(scr + n * 136 + kc * 16 + 8);
            *(v4u*)(WT + (size_t)(n0 + n) * K + k0 + 8 * kc) = (v4u){lo.x, lo.y, hi.x, hi.y}; }
        LDS_WAIT(); asm volatile("" ::: "memory");
    }
}

template <int TYPE>
__device__ __forceinline__ void transpose_job8(const float* W, const float* W2, int ldw, int K, unsigned char* WT, int nrows, float sc, LAS float* scr_f, int gw, int NGW, int lane) {
    LAS unsigned char* scr = (LAS unsigned char*)scr_f;
    const int nblk = nrows / 64, nitems = (K / 64) * nblk;
    const int l16 = lane & 15, lq = lane >> 4;
    for (int item = gw; item < nitems; item += NGW) {
        const int kb = item / nblk, nb = item % nblk, k0 = 64 * kb, n0 = 64 * nb;
        const int np = n0 + 4 * l16;
        const float* src = W; int col = np;
        if (TYPE == 2) { const int pn = np >> 8, j = np & 255; if (j < 128) col = 128 * pn + j; else { src = W2; col = 128 * pn + j - 128; } }
#pragma unroll
        for (int i = 0; i < 4; ++i) { const int kk = 16 * i + 4 * lq;
            const f32x4 v0 = __builtin_nontemporal_load((const f32x4*)(src + (size_t)(k0 + kk) * ldw + col)), v1 = __builtin_nontemporal_load((const f32x4*)(src + (size_t)(k0 + kk + 1) * ldw + col));
            const f32x4 v2 = __builtin_nontemporal_load((const f32x4*)(src + (size_t)(k0 + kk + 2) * ldw + col)), v3 = __builtin_nontemporal_load((const f32x4*)(src + (size_t)(k0 + kk + 3) * ldw + col));
#pragma unroll
            for (int j = 0; j < 4; ++j) *(LAS unsigned*)(scr + (4 * l16 + j) * 72 + kk) = pg8::pk_i8x4(v0[j] * sc, v1[j] * sc, v2[j] * sc, v3[j] * sc); }
        LDS_WAIT(); asm volatile("" ::: "memory");
#pragma unroll
        for (int j = 0; j < 4; ++j) { const int ch = lane + 64 * j, n = ch >> 2, kc = ch & 3;
            const v2u lo = *(const LAS v2u*)(scr + n * 72 + kc * 16), hi = *(const LAS v2u*)(scr + n * 72 + kc * 16 + 8);
            *(v4u*)(WT + (size_t)(n0 + n) * K + k0 + 16 * kc) = (v4u){lo.x, lo.y, hi.x, hi.y}; }
        LDS_WAIT(); asm volatile("" ::: "memory");
    }
}

template <bool ROUTER, bool MOE_COMBINE, bool CSTAB = false>
__device__ __forceinline__ void ln_rows(const Frame& F, const float* xi, const bf16* xib, const bf16* hb, const bf16* hb2, const float* gam, const float* bet, float* xo, bf16* xbo,
                                        int row_lo, int row_hi, const float* wr, unsigned* cnt, int* tok_e, float* tok_p, int* tok_pos, const int* positions = nullptr, float* cstab = nullptr, unsigned char* xq = nullptr, float xqs = 1.f) {
    const int gw = F.bid * NWAVES + F.wave, NGW = F.G * NWAVES, lane = F.lane;
    float invf0 = 0.f, invf1 = 0.f;
    if (CSTAB) { invf0 = (float)pow(10000.0, -(double)lane / 127.0); invf1 = (float)pow(10000.0, -(double)(lane + 64) / 127.0); }
    f32x4 gv[4], bv[4];
    if (!ROUTER) {
#pragma unroll
        for (int j = 0; j < 4; ++j) { gv[j] = *(const f32x4*)(gam + 4 * lane + 256 * j); bv[j] = *(const f32x4*)(bet + 4 * lane + 256 * j); } }
    float mylg[8] = {0.f, 0.f, 0.f, 0.f, 0.f, 0.f, 0.f, 0.f};
    f32x4 rw0[16], rw1[16];
    if (ROUTER) {
#pragma unroll
        for (int j = 0; j < 4; ++j)
#pragma unroll
            for (int q = 0; q < 4; ++q) { const int c = 4 * lane + 256 * j + q; rw0[4 * j + q] = *(const f32x4*)(wr + c * 8); rw1[4 * j + q] = *(const f32x4*)(wr + c * 8 + 4); }
    }
    struct LnRaw { f32x4 xf[4]; v2u xb[4], h[4], h2[4]; };
#define LN_LOAD(R, rowv) do { _Pragma("unroll") for (int j = 0; j < 4; ++j) { \
        if (xi) R.xf[j] = __builtin_nontemporal_load((const f32x4*)(xi + (size_t)(rowv) * DM + 4 * lane + 256 * j)); else R.xb[j] = *(const v2u*)(xib + (size_t)(rowv) * DM + 4 * lane + 256 * j); \
        const size_t hrow_ = MOE_COMBINE ? (size_t)((rowv) - row_lo) : (size_t)(rowv); R.h[j] = *(const v2u*)(hb + hrow_ * DM + 4 * lane + 256 * j); \
        if (MOE_COMBINE) R.h2[j] = *(const v2u*)(hb2 + hrow_ * DM + 4 * lane + 256 * j); } } while (0)
    LnRaw cur;
    if (row_lo + gw < row_hi) LN_LOAD(cur, row_lo + gw);
    for (int row = row_lo + gw; row < row_hi; row += NGW) {
        LnRaw nxt = cur;
        if (row + NGW < row_hi) LN_LOAD(nxt, row + NGW);
        asm volatile("" ::: "memory");
        f32x4 v[4]; float s = 0.f;
#pragma unroll
        for (int j = 0; j < 4; ++j) {
            f32x4 x;
            if (xi) x = cur.xf[j];
            else { const v2u xw = cur.xb[j]; x = (f32x4){bflo(xw.x), bfhi(xw.x), bflo(xw.y), bfhi(xw.y)}; }
            const v2u hw = cur.h[j];
            f32x4 h = (f32x4){bflo(hw.x), bfhi(hw.x), bflo(hw.y), bfhi(hw.y)};
            if (MOE_COMBINE) { const v2u h2 = cur.h2[j]; h += (f32x4){bflo(h2.x), bfhi(h2.x), bflo(h2.y), bfhi(h2.y)}; }
            v[j] = x * ALPHA + h; s += (v[j].x + v[j].y) + (v[j].z + v[j].w);
        }
        cur = nxt;
        const float mean = wave_sum(s) * (1.f / DM); float s2 = 0.f;
#pragma unroll
        for (int j = 0; j < 4; ++j) { v[j] = v[j] - mean; s2 += (v[j].x * v[j].x + v[j].y * v[j].y) + (v[j].z * v[j].z + v[j].w * v[j].w); }
        const float rstd = 1.f / sqrtf(wave_sum(s2) * (1.f / DM) + LN_EPS);
#pragma unroll
        for (int j = 0; j < 4; ++j) { const f32x4 g_ = ROUTER ? *(const f32x4*)(gam + 4 * lane + 256 * j) : gv[j], b_ = ROUTER ? *(const f32x4*)(bet + 4 * lane + 256 * j) : bv[j]; v[j] = v[j] * rstd * g_ + b_;
            if (xo) *(f32x4*)(xo + (size_t)row * DM + 4 * lane + 256 * j) = v[j];
            if (xbo) { v2u w; w.x = pk2(v[j].x, v[j].y); w.y = pk2(v[j].z, v[j].w); *(v2u*)(xbo + (size_t)row * DM + 4 * lane + 256 * j) = w; }
            if (!MOE_COMBINE && xq) *(unsigned*)(xq + (size_t)row * DM + 4 * lane + 256 * j) = pg8::pk_i8x4(v[j].x * xqs, v[j].y * xqs, v[j].z * xqs, v[j].w * xqs); }
        if (CSTAB) { const float pos = (float)positions[row]; float sn, cs_; typedef float f32x2v __attribute__((ext_vector_type(2)));
            sincosf(pos * invf0, &sn, &cs_); *(f32x2v*)(cstab + ((size_t)row * 128 + lane) * 2) = (f32x2v){cs_, sn};
            sincosf(pos * invf1, &sn, &cs_); *(f32x2v*)(cstab + ((size_t)row * 128 + lane + 64) * 2) = (f32x2v){cs_, sn}; }
        if (ROUTER) {
            float lg[8];
#pragma unroll
            for (int e = 0; e < 8; ++e) lg[e] = 0.f;
#pragma unroll
            for (int j = 0; j < 4; ++j)
#pragma unroll
                for (int q = 0; q < 4; ++q) { const f32x4 w0 = rw0[4 * j + q], w1 = rw1[4 * j + q]; const float xv = v[j][q];
                    lg[0] += xv * w0.x; lg[1] += xv * w0.y; lg[2] += xv * w0.z; lg[3] += xv * w0.w; lg[4] += xv * w1.x; lg[5] += xv * w1.y; lg[6] += xv * w1.z; lg[7] += xv * w1.w; }
            {
                float a4[4];
#pragma unroll
                for (int e = 0; e < 4; ++e) { const float mine = (lane & 32) ? lg[4 + e] : lg[e], send = (lane & 32) ? lg[e] : lg[4 + e]; a4[e] = mine + __shfl_xor(send, 32); }
                float a2[2];
#pragma unroll
                for (int e = 0; e < 2; ++e) { const float mine = (lane & 16) ? a4[2 + e] : a4[e], send = (lane & 16) ? a4[e] : a4[2 + e]; a2[e] = mine + __shfl_xor(send, 16); }
#define LN_DPPF(v_, c_) __builtin_bit_cast(float, __builtin_amdgcn_update_dpp(0, __builtin_bit_cast(int, v_), c_, 0xf, 0xf, true))
                float a1; { const float mine = (lane & 8) ? a2[1] : a2[0], send = (lane & 8) ? a2[0] : a2[1]; a1 = mine + LN_DPPF(send, 0x128); }
                a1 += LN_DPPF(a1, 0xB1); a1 += LN_DPPF(a1, 0x4E); a1 += LN_DPPF(a1, 0x141);
#pragma unroll
                for (int e = 0; e < 8; ++e) lg[e] = __builtin_bit_cast(float, __builtin_amdgcn_readlane(__builtin_bit_cast(int, a1), ((e >> 2) & 1) * 32 + ((e >> 1) & 1) * 16 + (e & 1) * 8));
#undef LN_DPPF
            }
            const int it_ = (row - row_lo - gw) / NGW;
#pragma unroll
            for (int e = 0; e < 8; ++e) mylg[e] = (lane == it_) ? lg[e] : mylg[e];
        }
    }
    if (ROUTER) {
        LAS unsigned* lc = (LAS unsigned*)(F.lds + LCNT_OFF);
        const int row = row_lo + gw + lane * NGW; const bool act = row < row_hi;
        int i0 = 0, i1 = -1, pos0 = 0, pos1 = 0;
        if (act) { float v0 = mylg[0];
#pragma unroll
            for (int e = 1; e < 8; ++e) if (mylg[e] > v0) { v0 = mylg[e]; i0 = e; }
            float v1 = -3.0e38f;
#pragma unroll
            for (int e = 0; e < 8; ++e) if (e != i0 && mylg[e] > v1) { v1 = mylg[e]; i1 = e; }
            pos0 = (int)__hip_atomic_fetch_add(lc + i0, 1u, __ATOMIC_RELAXED, __HIP_MEMORY_SCOPE_WORKGROUP); pos1 = (int)__hip_atomic_fetch_add(lc + i1, 1u, __ATOMIC_RELAXED, __HIP_MEMORY_SCOPE_WORKGROUP);
            tok_e[row] = i0 | (i1 << 8); tok_p[row] = 1.f / (1.f + __expf(v1 - v0)); }
        __syncthreads();
        if (F.tid < 8) lc[16 + F.tid] = __hip_atomic_fetch_add(cnt + F.tid, lc[F.tid], RLX_AGENT);
        __syncthreads();
        if (act) { tok_pos[2 * row] = pos0 + (int)lc[16 + i0]; tok_pos[2 * row + 1] = pos1 + (int)lc[16 + i1]; }
    }
}

typedef short bf16x8 __attribute__((ext_vector_type(8)));
typedef short s16x4 __attribute__((ext_vector_type(4)));
typedef __attribute__((address_space(3))) const unsigned char* lds_cptr;
__device__ __forceinline__ s16x4 lds_tr(lds_cptr p) { return __builtin_bit_cast(s16x4, __builtin_amdgcn_ds_read_tr16_b64_v4i16((LAS s16x4*)p)); }
__device__ __forceinline__ bf16x8 cat8(s16x4 lo, s16x4 hi) { return (bf16x8){lo[0], lo[1], lo[2], lo[3], hi[0], hi[1], hi[2], hi[3]}; }
typedef float f32x2_t __attribute__((ext_vector_type(2))); typedef __bf16 bf16x2_t __attribute__((ext_vector_type(2)));
__device__ __forceinline__ unsigned cvtpk(float lo, float hi) { f32x2_t v = {lo, hi}; bf16x2_t b = __builtin_convertvector(v, bf16x2_t); return __builtin_bit_cast(unsigned, b); }
__device__ __forceinline__ bf16x8 pack8(f32x4 a, f32x4 b) { v4u w; w.x = cvtpk(a[0], a[1]); w.y = cvtpk(a[2], a[3]); w.z = cvtpk(b[0], b[1]); w.w = cvtpk(b[2], b[3]); return __builtin_bit_cast(bf16x8, w); }
#define MFMA16(a, b, c) __builtin_amdgcn_mfma_f32_16x16x32_bf16(a, b, c, 0, 0, 0)
__device__ __forceinline__ void conv_prepass(const Frame& F, const bf16* P, const float* convw, const float* convb, bf16* XA, bf16* BCA) {
    constexpr int CR = 16;
    const int gt = F.bid * NTHR + F.tid, NGT = F.G * NTHR;
    for (int task = gt; task < (MTOK / CR) * 192; task += NGT) {
        const int cg = task % 192, rb = task / 192, ch = cg * 8, row0 = rb * CR, t0 = row0 & (SEQ - 1);
        f32x2_t wk[4][4], bias[4], x0[4], x1[4], x2[4];
#pragma unroll
        for (int k = 0; k < 4; ++k) { const f32x4 a = *(const f32x4*)(convw + k * 1536 + ch), b = *(const f32x4*)(convw + k * 1536 + ch + 4);
            wk[k][0] = (f32x2_t){a[0], a[1]}; wk[k][1] = (f32x2_t){a[2], a[3]}; wk[k][2] = (f32x2_t){b[0], b[1]}; wk[k][3] = (f32x2_t){b[2], b[3]}; }
        { const f32x4 a = *(const f32x4*)(convb + ch), b = *(const f32x4*)(convb + ch + 4);
            bias[0] = (f32x2_t){a[0], a[1]}; bias[1] = (f32x2_t){a[2], a[3]}; bias[2] = (f32x2_t){b[0], b[1]}; bias[3] = (f32x2_t){b[2], b[3]}; }
        const bf16* src = P + L0_XBC + (size_t)row0 * 1536 + ch; const int bb_ = row0 >> 11;
#define CONV_UNPK(dst, r_) do { dst[0] = (f32x2_t){bflo(r_.x), bfhi(r_.x)}; dst[1] = (f32x2_t){bflo(r_.y), bfhi(r_.y)}; dst[2] = (f32x2_t){bflo(r_.z), bfhi(r_.z)}; dst[3] = (f32x2_t){bflo(r_.w), bfhi(r_.w)}; } while (0)
        if (t0 > 0) { const v4u a_ = *(const v4u*)(src - 3 * 1536), b_ = *(const v4u*)(src - 2 * 1536), c_ = *(const v4u*)(src - 1536); CONV_UNPK(x0, a_); CONV_UNPK(x1, b_); CONV_UNPK(x2, c_); }
        else {
#pragma unroll
            for (int j = 0; j < 4; ++j) { x0[j] = (f32x2_t){0.f, 0.f}; x1[j] = x0[j]; x2[j] = x0[j]; } }
        const int cc_ = ch - 1024;
        bf16* dst = ch < 1024 ? XA + ((size_t)(bb_ * 16 + (ch >> 6)) * 2048 + t0) * 64 + (ch & 63) : BCA + ((size_t)(bb_ * 2 + ((cc_ & 255) >> 7)) * 2048 + t0) * 256 + (cc_ >> 8) * 128 + (cc_ & 127);
        const int dpitch = ch < 1024 ? 64 : 256;
        v4u raw[CR];
#pragma unroll
        for (int r = 0; r < CR; ++r) raw[r] = *(const v4u*)(src + (size_t)r * 1536);
        asm volatile("" ::: "memory");
#pragma unroll
        for (int r = 0; r < CR; ++r) {
            f32x2_t cur[4]; { const v4u r_ = raw[r]; CONV_UNPK(cur, r_); }
            unsigned ow[4];
#pragma unroll
            for (int j = 0; j < 4; ++j) { const f32x2_t a = bias[j] + wk[0][j] * x0[j] + wk[1][j] * x1[j] + wk[2][j] * x2[j] + wk[3][j] * cur[j];
                const f32x2_t ea = a * -1.4426950408889634f; const f32x2_t d = (f32x2_t){__builtin_amdgcn_exp2f(ea[0]), __builtin_amdgcn_exp2f(ea[1])} + 1.f;
                const f32x2_t o = a * (f32x2_t){__builtin_amdgcn_rcpf(d[0]), __builtin_amdgcn_rcpf(d[1])};
                ow[j] = cvtpk(o[0], o[1]); x0[j] = x1[j]; x1[j] = x2[j]; x2[j] = cur[j]; }
            *(v4u*)(dst + (size_t)r * dpitch) = (v4u){ow[0], ow[1], ow[2], ow[3]};
        }
#undef CONV_UNPK
    }
}

__device__ __forceinline__ void small_prepass(const Frame& F, const bf16* SMBp, const float* mu, bf16* SMS) {
    const int gt = F.bid * NTHR + F.tid, NGT = F.G * NTHR;
    for (int idx = gt; idx < MTOK * 36; idx += NGT) {
        const int row = idx / 36, j = idx % 36; const bf16* src = SMBp + (size_t)row * 320 + j * 8;
        const v4u cw = *(const v4u*)src; const v4u pw = (row & (SEQ - 1)) ? *(const v4u*)(src - 320) : (v4u){0u, 0u, 0u, 0u};
        const f32x4 m0 = *(const f32x4*)(mu + 3072 + j * 8), m1 = *(const f32x4*)(mu + 3072 + j * 8 + 4);
        const float c_[8] = {bflo(cw.x), bfhi(cw.x), bflo(cw.y), bfhi(cw.y), bflo(cw.z), bfhi(cw.z), bflo(cw.w), bfhi(cw.w)};
        const float p_[8] = {bflo(pw.x), bfhi(pw.x), bflo(pw.y), bfhi(pw.y), bflo(pw.z), bfhi(pw.z), bflo(pw.w), bfhi(pw.w)};
        float v[8];
#pragma unroll
        for (int q = 0; q < 8; ++q) { const float x = c_[q] + (p_[q] - c_[q]) * (q < 4 ? m0[q & 3] : m1[q & 3]);
            v[q] = j < 8 ? 1.f - 2.f * __builtin_amdgcn_rcpf(1.f + __expf(2.f * x)) : (j < 16 ? x : __builtin_amdgcn_rcpf(1.f + __expf(-x))); }
        v4u o; o.x = pk2(v[0], v[1]); o.y = pk2(v[2], v[3]); o.z = pk2(v[4], v[5]); o.w = pk2(v[6], v[7]);
        *(v4u*)(SMS + (size_t)row * 320 + j * 8) = o;
    }
}

__device__ __forceinline__ float wave_scan_incl(float v, int lane) {
    (void)lane;
#define WS_DPP(ctrl, rmask) __builtin_bit_cast(float, __builtin_amdgcn_update_dpp(0, __builtin_bit_cast(int, v), ctrl, rmask, 0xf, true))
    v += WS_DPP(0x111, 0xf); v += WS_DPP(0x112, 0xf); v += WS_DPP(0x114, 0xf); v += WS_DPP(0x118, 0xf);
    v += WS_DPP(0x142, 0xa); v += WS_DPP(0x143, 0xc);
#undef WS_DPP
    return v;
}
__device__ __forceinline__ void ssd_mfma(const Frame& F, const bf16* P, const bf16* XA, const bf16* BCA, const float* dtb, const float* alog, const float* dskip, bf16* mix) {
    constexpr int XST = 144, BST = 272;
    constexpr int XOFF = 0, XWOFF = 128 * XST, BOFF = 2 * 128 * XST, COFF = BOFF + 128 * BST, SOFF = COFF + 128 * BST, DTOFF = SOFF + 64 * BST, ACSOFF = DTOFF + 512;
    static_assert(ACSOFF + 512 <= RING_BYTES, "SSD LDS map");
    LAS unsigned char* const L = F.lds;
    LAS float* const DT = (LAS float*)(L + DTOFF); LAS float* const ACS = (LAS float*)(L + ACSOFF);
    const int tid = F.tid, lane = F.lane, w = F.wave, g = lane >> 4, lr = lane & 15, q4 = lr >> 2, p4 = lane & 3;
    for (int item = F.bid; item < BATCH * 16; item += F.G) {
        const int b = item >> 4, h = item & 15, grp = h >> 3;
        const float A_h = -__expf(alog[h]), dtbias = dtb[h], dsk = dskip[h];
        const bf16* xg = XA + (size_t)(b * 16 + h) * 2048 * 64;
        const bf16* bg = BCA + (size_t)(b * 2 + grp) * 2048 * 256;
        const bf16* cg = bg + 128;
        const bf16* dg = P + L0_SMB + (size_t)(b * SEQ) * 320 + 288 + h;
        const bf16* zg = P + L0_ZH + (size_t)(b * 16 + h) * 2048 * 64;
        bf16* og = mix + (size_t)(b * SEQ) * 2048 + h * 64;
        f32x4 stT[4];
#pragma unroll
        for (int pt = 0; pt < 4; ++pt) stT[pt] = (f32x4){0.f, 0.f, 0.f, 0.f};
        __syncthreads();
        for (int i = tid; i < 64 * BST / 16; i += NTHR) *(LAS v4u*)(L + SOFF + i * 16) = (v4u){0u, 0u, 0u, 0u};
        v4u xp[2], bp[4], cp[4]; float raw0 = 0.f, raw1 = 0.f;
#define SSD_LOAD(c) do { const size_t r0_ = (size_t)(128 * (c)); \
            _Pragma("unroll") for (int i_ = 0; i_ < 2; ++i_) { const int p_ = tid + NTHR * i_; xp[i_] = *(const v4u*)(xg + (r0_ + (p_ >> 3)) * 64 + (p_ & 7) * 8); } \
            _Pragma("unroll") for (int i_ = 0; i_ < 4; ++i_) { const int p_ = tid + NTHR * i_; bp[i_] = *(const v4u*)(bg + (r0_ + (p_ >> 4)) * 256 + (p_ & 15) * 8); cp[i_] = *(const v4u*)(cg + (r0_ + (p_ >> 4)) * 256 + (p_ & 15) * 8); } \
            if (w < 2) { raw0 = bf2f(dg[(r0_ + lane) * 320]); raw1 = bf2f(dg[(r0_ + 64 + lane) * 320]); } } while (0)
        SSD_LOAD(0);
        for (int c = 0; c < SEQ / 128; ++c) {
#pragma unroll
            for (int i = 0; i < 2; ++i) { const int p = tid + NTHR * i; *(LAS v4u*)(L + XOFF + (p >> 3) * XST + (p & 7) * 16) = xp[i]; }
#pragma unroll
            for (int i = 0; i < 4; ++i) { const int p = tid + NTHR * i; *(LAS v4u*)(L + BOFF + (p >> 4) * BST + (p & 15) * 16) = bp[i]; *(LAS v4u*)(L + COFF + (p >> 4) * BST + (p & 15) * 16) = cp[i]; }
            if (w < 2) {
                const float d0 = softplus_f(raw0 + dtbias), d1 = softplus_f(raw1 + dtbias);
                const float s0 = wave_scan_incl(d0 * A_h, lane); const float tot0 = __builtin_bit_cast(float, __builtin_amdgcn_readlane(__builtin_bit_cast(int, s0), 63)); const float s1 = wave_scan_incl(d1 * A_h, lane) + tot0;
                if (w == 0) { DT[lane] = d0; ACS[lane] = s0; } else { DT[64 + lane] = d1; ACS[64 + lane] = s1; }
            }
            __syncthreads();
            const float acs_end = ACS[127];
#pragma unroll
            for (int i = 0; i < 2; ++i) { const int p = tid + NTHR * i, j = p >> 3; const float f = __expf(acs_end - ACS[j]) * DT[j]; const v4u x = xp[i]; v4u o;
                o.x = cvtpk(bflo(x.x) * f, bfhi(x.x) * f); o.y = cvtpk(bflo(x.y) * f, bfhi(x.y) * f); o.z = cvtpk(bflo(x.z) * f, bfhi(x.z) * f); o.w = cvtpk(bflo(x.w) * f, bfhi(x.w) * f);
                *(LAS v4u*)(L + XWOFF + j * XST + (p & 7) * 16) = o; }
            if (c + 1 < SEQ / 128) SSD_LOAD(c + 1);
            bf16x8 cf[4];
#pragma unroll
            for (int ks = 0; ks < 4; ++ks) cf[ks] = *(const LAS bf16x8*)(L + COFF + (16 * w + lr) * BST + (32 * ks + 8 * g) * 2);
            const float acs_i = ACS[16 * w + lr];
            bf16x8 mf[4];
#pragma unroll
            for (int s2 = 0; s2 < 4; ++s2) { f32x4 mm[2];
#pragma unroll
                for (int e = 0; e < 2; ++e) { const int jt = 2 * s2 + e; mm[e] = (f32x4){0.f, 0.f, 0.f, 0.f};
                    if (jt <= w) {
#pragma unroll
                        for (int ks = 0; ks < 4; ++ks) { const bf16x8 a = *(const LAS bf16x8*)(L + BOFF + (16 * jt + lr) * BST + (32 * ks + 8 * g) * 2); mm[e] = MFMA16(a, cf[ks], mm[e]); }
                        const f32x4 aj = *(const LAS f32x4*)(ACS + 16 * jt + 4 * g), dj = *(const LAS f32x4*)(DT + 16 * jt + 4 * g);
#pragma unroll
                        for (int r = 0; r < 4; ++r) { const float v = mm[e][r] * __expf(acs_i - aj[r]) * dj[r]; mm[e][r] = (jt < w || 4 * g + r <= lr) ? v : 0.f; }
                    } }
                mf[s2] = pack8(mm[0], mm[1]); }
            __builtin_amdgcn_sched_barrier(0);
            const float e_i = __expf(acs_i);
#pragma unroll
            for (int pt = 0; pt < 4; ++pt) { f32x4 y = (f32x4){0.f, 0.f, 0.f, 0.f};
#pragma unroll
                for (int ks = 0; ks < 4; ++ks) { const bf16x8 a = *(const LAS bf16x8*)(L + SOFF + (16 * pt + lr) * BST + (32 * ks + 8 * g) * 2); y = MFMA16(a, cf[ks], y); }
                y = y * e_i;
#pragma unroll
                for (int s2 = 0; s2 < 4; ++s2) if (2 * s2 <= w) {
                    const s16x4 lo = lds_tr(L + XOFF + (32 * s2 + 4 * g + q4) * XST + (16 * pt + 4 * p4) * 2), hi = lds_tr(L + XOFF + (32 * s2 + 16 + 4 * g + q4) * XST + (16 * pt + 4 * p4) * 2);
                    y = MFMA16(cat8(lo, hi), mf[s2], y); }
                const int tok = 128 * c + 16 * w + lr, p0 = 16 * pt + 4 * g;
                const v2u xw = *(const LAS v2u*)(L + XOFF + (16 * w + lr) * XST + p0 * 2); const v2u zw = *(const v2u*)(zg + (size_t)tok * 64 + p0);
                const float o0 = (y[0] + dsk * bflo(xw.x)) * silu_f(bflo(zw.x)), o1 = (y[1] + dsk * bfhi(xw.x)) * silu_f(bfhi(zw.x)), o2 = (y[2] + dsk * bflo(xw.y)) * silu_f(bflo(zw.y)), o3 = (y[3] + dsk * bfhi(xw.y)) * silu_f(bfhi(zw.y));
                v2u o; o.x = cvtpk(o0, o1); o.y = cvtpk(o2, o3); *(v2u*)(og + (size_t)tok * 2048 + p0) = o; }
            __syncthreads();
            { const float e_end = __expf(acs_end);
#pragma unroll
              for (int pt = 0; pt < 4; ++pt) stT[pt] = stT[pt] * e_end; }
#pragma unroll
            for (int s2 = 0; s2 < 4; ++s2) {
                const s16x4 lo = lds_tr(L + BOFF + (32 * s2 + 8 * g + q4) * BST + (16 * w + 4 * p4) * 2), hi = lds_tr(L + BOFF + (32 * s2 + 8 * g + 4 + q4) * BST + (16 * w + 4 * p4) * 2); const bf16x8 a = cat8(lo, hi);
#pragma unroll
                for (int pt = 0; pt < 4; ++pt) { const s16x4 xl = lds_tr(L + XWOFF + (32 * s2 + 8 * g + q4) * XST + (16 * pt + 4 * p4) * 2), xh = lds_tr(L + XWOFF + (32 * s2 + 8 * g + 4 + q4) * XST + (16 * pt + 4 * p4) * 2);
                    stT[pt] = MFMA16(a, cat8(xl, xh), stT[pt]); } }
#pragma unroll
            for (int pt = 0; pt < 4; ++pt) { v2u o; o.x = cvtpk(stT[pt][0], stT[pt][1]); o.y = cvtpk(stT[pt][2], stT[pt][3]); *(LAS v2u*)(L + SOFF + (16 * pt + lr) * BST + (16 * w + 4 * g) * 2) = o; }
            __syncthreads();
        }
#undef SSD_LOAD
    }
}

__device__ __forceinline__ void ssd_norm(const Frame& F, bf16* mix, const float* mnorm) {
    const int gw = F.bid * NWAVES + F.wave, NGW = F.G * NWAVES, lane = F.lane;
    v4u wn = (v4u){0u, 0u, 0u, 0u};
    if (gw < MTOK * 2) wn = *(const v4u*)(mix + (size_t)(gw >> 1) * 2048 + (gw & 1) * 512 + 8 * lane);
    for (int it = gw; it < MTOK * 2; it += NGW) {
        const int row = it >> 1, g = it & 1; bf16* p = mix + (size_t)row * 2048 + g * 512 + 8 * lane;
        const v4u w = wn;
        if (it + NGW < MTOK * 2) wn = *(const v4u*)(mix + (size_t)((it + NGW) >> 1) * 2048 + ((it + NGW) & 1) * 512 + 8 * lane);
        asm volatile("" ::: "memory");
        float v[8] = {bflo(w.x), bfhi(w.x), bflo(w.y), bfhi(w.y), bflo(w.z), bfhi(w.z), bflo(w.w), bfhi(w.w)};
        float s = 0.f;
#pragma unroll
        for (int j = 0; j < 8; ++j) s += v[j] * v[j];
        const float r = 1.f / sqrtf(wave_sum(s) * (1.f / 512.f) + LN_EPS);
        const f32x4 m0 = *(const f32x4*)(mnorm + g * 512 + 8 * lane), m1 = *(const f32x4*)(mnorm + g * 512 + 8 * lane + 4);
        v4u o; o.x = pk2(v[0] * r * m0.x, v[1] * r * m0.y); o.y = pk2(v[2] * r * m0.z, v[3] * r * m0.w); o.z = pk2(v[4] * r * m1.x, v[5] * r * m1.y); o.w = pk2(v[6] * r * m1.z, v[7] * r * m1.w);
        *(v4u*)p = o;
    }
}

struct RwkvW { const float *mu, *w0, *wup, *a0, *aup, *gup, *kk, *ka, *rk, *rlnw, *rlnb; };
typedef float f32x2 __attribute__((ext_vector_type(2)));
#define MFMA16K(a, b, c) __builtin_amdgcn_mfma_f32_16x16x32_bf16(cat8(a, (s16x4){0, 0, 0, 0}), cat8(b, (s16x4){0, 0, 0, 0}), c, 0, 0, 0)
__device__ __forceinline__ s16x4 pack4(f32x4 a) { v2u w; w.x = cvtpk(a[0], a[1]); w.y = cvtpk(a[2], a[3]); return __builtin_bit_cast(s16x4, w); }
__device__ __forceinline__ float fast_sigmoid(float x) { return __builtin_amdgcn_rcpf(1.f + __expf(-x)); }
__device__ __forceinline__ float fast_tanh(float x) { return 1.f - 2.f * __builtin_amdgcn_rcpf(1.f + __expf(2.f * x)); }
__device__ __forceinline__ bf16x8 pack8f(const float* v) { v4u w; w.x = cvtpk(v[0], v[1]); w.y = cvtpk(v[2], v[3]); w.z = cvtpk(v[4], v[5]); w.w = cvtpk(v[6], v[7]); return __builtin_bit_cast(bf16x8, w); }
__device__ __forceinline__ void rwkv_items(const Frame& F, const bf16* P, const bf16* SMS, const RwkvW W, bf16* mix) {
    constexpr int TC = 32, TST = 144, GST = 336, FST = 272, FSZ = TC * FST;
    constexpr int RS = 0, KS = FSZ, VB = 2 * FSZ, OPS = VB + 2 * TC * TST;
    constexpr int AT = OPS, RT = OPS + 4608, BH = OPS + 9216, KH = OPS + 13824, BBAR = OPS + 18432, KBAR = OPS + 23040;
    constexpr int TWD = OPS, SAD = OPS + 4608, SGD = OPS + 9216;
    constexpr int LW = OPS + 27648, ICL = LW + FSZ, GT = ICL + FSZ, AAF = GT + FSZ, SM = AAF + FSZ, MABF = SM + 4096, PCO = MABF + 2048, BON = PCO + 512, N2 = BON + 1024, YR = N2 + 128, MU = YR + FSZ;
    static_assert(SGD + TC * GST <= LW && MU + 1920 <= RING_BYTES, "RWKV LDS map");
    LAS unsigned char* const L = F.lds;
    const int tid0 = F.tid, wave = F.wave;
#define RW_LANES() int tid = tid0; asm volatile("" : "+v"(tid)); const int lane = tid & 63, g = lane >> 4, lr = lane & 15, q4 = lr >> 2, p4 = lane & 3; (void)g; (void)lr; (void)q4; (void)p4
    for (int item = F.bid; item < BATCH * 16; item += F.G) {
        RW_LANES();
        const int b = item >> 4, h = item & 15, hc = h * 64 + lane;
        const bf16* Pr = P + L0_RKVH + (size_t)(b * 16 + h) * 2048 * 192;
        const bf16* Ps = SMS + (size_t)(b * SEQ) * 320;
        const int ct = wave & 3, c0 = h * 64 + 16 * ct + 4 * g;
        __syncthreads();
        if (tid < 480) { const int pc = tid >> 3, q = tid & 7; *(LAS float*)(L + MU + tid * 4) = W.mu[pc < 24 ? (pc >> 3) * 1024 + h * 64 + (pc & 7) * 8 + q : 3072 + (pc - 24) * 8 + q]; }
        bf16x8 wf[5];
        if (wave < 4) {
#pragma unroll
            for (int ks = 0; ks < 2; ++ks) { float t0_[8], t1_[8];
#pragma unroll
                for (int jj = 0; jj < 8; ++jj) { const size_t o = (size_t)(32 * ks + 8 * g + jj) * 1024 + h * 64 + 16 * ct + lr; t0_[jj] = W.wup[o]; t1_[jj] = W.aup[o]; }
                wf[ks] = pack8f(t0_); wf[2 + ks] = pack8f(t1_); asm volatile("" ::: "memory"); }
            wf[4] = wf[0];
        } else {
#pragma unroll
            for (int ks = 0; ks < 5; ++ks) { float t0_[8];
#pragma unroll
                for (int jj = 0; jj < 8; ++jj) t0_[jj] = W.gup[(size_t)(32 * ks + 8 * g + jj) * 1024 + h * 64 + 16 * ct + lr];
                wf[ks] = pack8f(t0_); asm volatile("" ::: "memory"); }
        }
        const float rlw = W.rlnw[hc], rlb = W.rlnb[hc];
        const f32x4 w0v = *(const f32x4*)(W.w0 + c0), a0v = *(const f32x4*)(W.a0 + c0), kk4 = *(const f32x4*)(W.kk + c0), ka4 = *(const f32x4*)(W.ka + c0), rk4 = *(const f32x4*)(W.rk + c0);
        const f32x4 kkp0 = *(const f32x4*)(W.kk + h * 64 + (tid & 7) * 8), kkp1 = *(const f32x4*)(W.kk + h * 64 + (tid & 7) * 8 + 4);
        f32x4 sT[4];
#pragma unroll
        for (int kt = 0; kt < 4; ++kt) sT[kt] = (f32x4){0.f, 0.f, 0.f, 0.f};
        v4u cur[4], prv[4];
#define RW_SLOTS() const int u8 = tid & 255, tt1 = u8 >> 3, pc1 = u8 & 7, ix2 = 256 + tid, tt2g = ix2 / 20, pc2g = ix2 % 20, tt3 = tid / 20, pc3 = tid % 20; \
        const int mu0 = tid & 15, mu1 = wave < 4 ? 16 + pc1 : 24 + pc1, mu2 = wave < 4 ? 32 + pc1 : 40 + pc2g, mu3 = 40 + pc3, ttb2 = wave < 4 ? tt1 : tt2g; \
        const int off0 = ((tid >> 3) & 1) * 64 + (tid & 7) * 8, off1 = wave < 4 ? 128 + pc1 * 8 : pc1 * 8, off2 = wave < 4 ? 64 + pc1 * 8 : 128 + pc2g * 8, off3 = 128 + pc3 * 8; (void)mu0; (void)mu1; (void)mu2; (void)mu3
#define RW_LD1(i_, tt_, base_, pitch_, off_) do { const int t_ = t0n_ + (tt_); cur[i_] = *(const v4u*)((base_) + (unsigned)(t_ * (pitch_) + (off_))); prv[i_] = t_ > 0 ? *(const v4u*)((base_) + (unsigned)((t_ - 1) * (pitch_) + (off_))) : (v4u){0u, 0u, 0u, 0u}; } while (0)
#define RW_LD0(i_, tt_, off_) do { cur[i_] = *(const v4u*)(Ps + (unsigned)((t0n_ + (tt_)) * 320 + (off_))); } while (0)
#define RW_LOAD(t0_) do { RW_LANES(); RW_SLOTS(); const int t0n_ = (t0_); RW_LD1(0, tid >> 4, Pr, 192, off0); if (wave < 4) RW_LD1(1, tt1, Pr, 192, off1); else RW_LD0(1, tt1, off1); if (wave < 6) RW_LD0(2, ttb2, off2); RW_LD0(3, tt3, off3); } while (0)
#define RW_SHIFT(v_, i_, mu_) do { const f32x4 m0_ = *(const LAS f32x4*)(L + MU + (mu_) * 32), m1_ = *(const LAS f32x4*)(L + MU + (mu_) * 32 + 16); const v4u cw_ = cur[i_], pw_ = prv[i_]; \
            const float c_[8] = {bflo(cw_.x), bfhi(cw_.x), bflo(cw_.y), bfhi(cw_.y), bflo(cw_.z), bfhi(cw_.z), bflo(cw_.w), bfhi(cw_.w)}; \
            const float p_[8] = {bflo(pw_.x), bfhi(pw_.x), bflo(pw_.y), bfhi(pw_.y), bflo(pw_.z), bfhi(pw_.z), bflo(pw_.w), bfhi(pw_.w)}; \
            _Pragma("unroll") for (int q_ = 0; q_ < 8; ++q_) v_[q_] = c_[q_] + (p_[q_] - c_[q_]) * (q_ < 4 ? m0_[q_ & 3] : m1_[q_ & 3]); } while (0)
#define RW_PASS_E(te_, par_) do { _Pragma("unroll") for (int rep = 0; rep < TC / NWAVES; ++rep) { const int tt = wave + NWAVES * rep, o = tt * FST + lane * 4; const unsigned row = (unsigned)(b * SEQ + (te_) + tt);     \
                const float y = *(LAS float*)(L + YR + o); const float mu = wave_sum(y) * (1.f / 64.f); const float d = y - mu; const float var = wave_sum(d * d) * (1.f / 64.f); \
                const float yn = d * __builtin_amdgcn_rsqf(var + 64e-5f) * rlw + rlb; \
                const LAS float* bp_ = (const LAS float*)(L + BON + (par_) * 512 + tt * 4); const float bonus = ((bp_[0] + bp_[32]) + (bp_[64] + bp_[96])) * bf2f(*(LAS bf16*)(L + VB + (par_) * TC * TST + tt * TST + lane * 2)); \
                mix[row * 2048u + 1024u + (unsigned)hc] = (bf16)f2bf((yn + bonus) * *(LAS float*)(L + GT + o)); } } while (0)
        RW_LOAD(0);
        for (int t0 = 0; t0 < SEQ; t0 += TC) {
            const int par = (t0 >> 5) & 1;
            LDS_BARRIER();
            { RW_LANES(); RW_SLOTS();
            { float v[8]; RW_SHIFT(v, 0, mu0); const int base = ((tid & 8) ? KS : RS) + (tid >> 4) * FST + (tid & 7) * 32;
              *(LAS f32x4*)(L + base) = (f32x4){v[0], v[1], v[2], v[3]}; *(LAS f32x4*)(L + base + 16) = (f32x4){v[4], v[5], v[6], v[7]};
              float n2 = 0.f;
#pragma unroll
              for (int q = 0; q < 8; ++q) { const float x = v[q] * (q < 4 ? kkp0[q & 3] : kkp1[q & 3]); n2 += x * x; }
#define RW_DPPF(v_, c_) __builtin_bit_cast(float, __builtin_amdgcn_update_dpp(0, __builtin_bit_cast(int, v_), c_, 0xf, 0xf, true))
              n2 += RW_DPPF(n2, 0xB1); n2 += RW_DPPF(n2, 0x4E); n2 += RW_DPPF(n2, 0x141);
#undef RW_DPPF
              if ((tid & 15) == 8) *(LAS float*)(L + N2 + (tid >> 4) * 4) = n2; }
            if (wave < 4) { float v[8]; RW_SHIFT(v, 1, mu1); *(LAS bf16x8*)(L + VB + par * TC * TST + tt1 * TST + pc1 * 16) = pack8f(v); }
            else *(LAS v4u*)(L + TWD + tt1 * TST + pc1 * 16) = cur[1];
            if (wave < 4) *(LAS v4u*)(L + SAD + tt1 * TST + pc1 * 16) = cur[2];
            else if (wave < 6) *(LAS v4u*)(L + SGD + tt2g * GST + pc2g * 16) = cur[2];
            *(LAS v4u*)(L + SGD + tt3 * GST + pc3 * 16) = cur[3];
            if (t0 > 0) RW_PASS_E(t0 - TC, par ^ 1);
            }
            LDS_BARRIER();
            if (t0 + TC < SEQ) RW_LOAD(t0 + TC);
            { RW_LANES();
#pragma unroll
            for (int tt2 = 0; tt2 < 2; ++tt2) {
                if (wave < 4) { f32x4 dw = (f32x4){0.f, 0.f, 0.f, 0.f}, da = (f32x4){0.f, 0.f, 0.f, 0.f};
#pragma unroll
                    for (int ks = 0; ks < 2; ++ks) {
                        const bf16x8 bw = *(const LAS bf16x8*)(L + TWD + (16 * tt2 + lr) * TST + (32 * ks + 8 * g) * 2), ba = *(const LAS bf16x8*)(L + SAD + (16 * tt2 + lr) * TST + (32 * ks + 8 * g) * 2);
                        dw = MFMA16(wf[ks], bw, dw); da = MFMA16(wf[2 + ks], ba, da); }
                    const int o = (16 * tt2 + lr) * FST + (16 * ct + 4 * g) * 4;
                    const f32x4 kv = *(const LAS f32x4*)(L + KS + o), rv = *(const LAS f32x4*)(L + RS + o);
                    const float inv = fminf(__builtin_amdgcn_rsqf(*(const LAS float*)(L + N2 + (16 * tt2 + lr) * 4)), 1e12f);
                    f32x4 lw, kp, av, bv; float bon = 0.f;
#pragma unroll
                    for (int r = 0; r < 4; ++r) { lw[r] = -0.6065306597126334f * fast_sigmoid(w0v[r] + dw[r]); const float icl = fast_sigmoid(a0v[r] + da[r]);
                        const float kkn = kv[r] * kk4[r] * inv; kp[r] = kv[r] * (1.f + (icl - 1.f) * ka4[r]); av[r] = -kkn; bv[r] = kkn * icl; bon += rv[r] * kp[r] * rk4[r]; }
                    *(LAS f32x4*)(L + LW + o) = lw; *(LAS f32x4*)(L + KS + o) = kp; *(LAS f32x4*)(L + AAF + o) = av; *(LAS f32x4*)(L + ICL + o) = bv;
                    bon += __shfl_xor(bon, 16); bon += __shfl_xor(bon, 32);
                    if (g == 0) *(LAS float*)(L + BON + par * 512 + ct * 128 + (16 * tt2 + lr) * 4) = bon;
                } else { f32x4 dg = (f32x4){0.f, 0.f, 0.f, 0.f};
#pragma unroll
                    for (int ks = 0; ks < 5; ++ks) { const bf16x8 bg = *(const LAS bf16x8*)(L + SGD + (16 * tt2 + lr) * GST + (32 * ks + 8 * g) * 2); dg = MFMA16(wf[ks], bg, dg); }
                    *(LAS f32x4*)(L + GT + (16 * tt2 + lr) * FST + (16 * ct + 4 * g) * 4) = dg; } }
            }
            LDS_BARRIER();
            { RW_LANES();
            { const int ch = tid >> 8, q = (tid >> 6) & 3, c = lane; float lp[16]; float run = 0.f;
#pragma unroll
              for (int t = 0; t < 16; ++t) { run += *(LAS float*)(L + LW + (16 * ch + t) * FST + c * 4); lp[t] = run; }
              const float lend = lp[15];
#pragma unroll
              for (int t = 0; t < 16; ++t) if ((t >> 2) == q) { const int tok = 16 * ch + t, o = tok * FST + c * 4, ob = tok * TST + c * 2;
                  const float av = *(LAS float*)(L + AAF + o), bv = *(LAS float*)(L + ICL + o), kp = *(LAS float*)(L + KS + o), rv = *(LAS float*)(L + RS + o);
                  const float em1 = t ? __expf(lp[t ? t - 1 : 0]) : 1.f, et = __expf(lp[t]), iet = __expf(-lp[t]), ee = __expf(lend - lp[t]);
                  *(LAS bf16*)(L + AT + ob) = (bf16)f2bf(av * em1); *(LAS bf16*)(L + RT + ob) = (bf16)f2bf(rv * et); *(LAS bf16*)(L + BH + ob) = (bf16)f2bf(bv * iet);
                  *(LAS bf16*)(L + KH + ob) = (bf16)f2bf(kp * iet); *(LAS bf16*)(L + BBAR + ob) = (bf16)f2bf(bv * ee); *(LAS bf16*)(L + KBAR + ob) = (bf16)f2bf(kp * ee); }
              if (q == 0) *(LAS float*)(L + PCO + (ch * 64 + c) * 4) = __expf(lend); }
            }
            LDS_BARRIER();
            { RW_LANES();
            { const int mi = wave & 3, ch = wave >> 2; const int lhs = (mi & 1) ? KH : BH, rhs = (mi & 2) ? RT : AT; f32x4 acc = (f32x4){0.f, 0.f, 0.f, 0.f};
#pragma unroll
              for (int ks = 0; ks < 2; ++ks) { const bf16x8 a_ = *(const LAS bf16x8*)(L + lhs + (16 * ch + lr) * TST + (32 * ks + 8 * g) * 2), b_ = *(const LAS bf16x8*)(L + rhs + (16 * ch + lr) * TST + (32 * ks + 8 * g) * 2);
                  acc = MFMA16(a_, b_, acc); }
#pragma unroll
              for (int r = 0; r < 4; ++r) { const int s_ = 4 * g + r; acc[r] = ((mi < 2) ? (s_ < lr) : (s_ <= lr)) ? acc[r] : 0.f; }
              if (mi != 0) *(LAS s16x4*)(L + SM + ch * 2048 + (mi - 1) * 512 + lr * 32 + 8 * g) = pack4(acc);
              else {
#pragma unroll
                  for (int r = 0; r < 4; ++r) *(LAS float*)(L + MABF + ch * 1024 + ((4 * g + r) * 16 + lr) * 4) = acc[r];
                  float m[16];
#pragma unroll
                  for (int s_ = 15; s_ >= 0; --s_) { float row[16];
#pragma unroll
                      for (int u4 = 0; u4 < 4; ++u4) { const f32x4 rv = *(const LAS f32x4*)(L + MABF + ch * 1024 + s_ * 64 + u4 * 16); row[4 * u4] = rv[0]; row[4 * u4 + 1] = rv[1]; row[4 * u4 + 2] = rv[2]; row[4 * u4 + 3] = rv[3]; }
                      float sum = (s_ == lr) ? 1.f : 0.f;
#pragma unroll
                      for (int u = s_ + 1; u < 16; ++u) sum += row[u] * m[u];
                      m[s_] = sum; asm volatile("" ::: "memory"); }
                  if (lane < 16) { *(LAS bf16x8*)(L + SM + ch * 2048 + 1536 + lr * 32) = pack8f(m); *(LAS bf16x8*)(L + SM + ch * 2048 + 1536 + lr * 32 + 16) = pack8f(m + 8); }
              } }
            }
            LDS_BARRIER();
            { RW_LANES();
            if (wave < 4) {
#pragma unroll 1
                for (int ch = 0; ch < 2; ++ch) {
                    const bf16x8 sf0 = pack8(sT[0], sT[1]), sf1 = pack8(sT[2], sT[3]);
                    const s16x4 vf = lds_tr(L + VB + par * TC * TST + (16 * ch + 4 * g + q4) * TST + (16 * wave + 4 * p4) * 2);
                    const int rowb = (16 * ch + lr) * TST, smb = SM + ch * 2048 + lr * 32 + 8 * g;
                    f32x4 x = (f32x4){0.f, 0.f, 0.f, 0.f}, y = (f32x4){0.f, 0.f, 0.f, 0.f};
                    x = MFMA16(cat8(*(const LAS s16x4*)(L + AT + rowb + (4 * g) * 2), *(const LAS s16x4*)(L + AT + rowb + (16 + 4 * g) * 2)), sf0, x);
                    x = MFMA16(cat8(*(const LAS s16x4*)(L + AT + rowb + (32 + 4 * g) * 2), *(const LAS s16x4*)(L + AT + rowb + (48 + 4 * g) * 2)), sf1, x);
                    x = MFMA16K(*(const LAS s16x4*)(L + smb), vf, x);
                    const s16x4 xf = pack4(x);
                    const f32x4 sa = MFMA16K(*(const LAS s16x4*)(L + smb + 1536), xf, ((f32x4){0.f, 0.f, 0.f, 0.f}));
                    const s16x4 saf = pack4(sa);
                    y = MFMA16(cat8(*(const LAS s16x4*)(L + RT + rowb + (4 * g) * 2), *(const LAS s16x4*)(L + RT + rowb + (16 + 4 * g) * 2)), sf0, y);
                    y = MFMA16(cat8(*(const LAS s16x4*)(L + RT + rowb + (32 + 4 * g) * 2), *(const LAS s16x4*)(L + RT + rowb + (48 + 4 * g) * 2)), sf1, y);
                    y = MFMA16K(*(const LAS s16x4*)(L + smb + 512), saf, y);
                    y = MFMA16K(*(const LAS s16x4*)(L + smb + 1024), vf, y);
#pragma unroll
                    for (int kt = 0; kt < 4; ++kt) { const f32x4 pc = *(const LAS f32x4*)(L + PCO + (ch * 64 + 16 * kt + 4 * g) * 4);
                        const s16x4 bb = lds_tr(L + BBAR + (16 * ch + 4 * g + q4) * TST + (16 * kt + 4 * p4) * 2), kb = lds_tr(L + KBAR + (16 * ch + 4 * g + q4) * TST + (16 * kt + 4 * p4) * 2);
                        f32x4 sn = sT[kt] * pc; sn = MFMA16K(bb, saf, sn); sn = MFMA16K(kb, vf, sn); sT[kt] = sn; }
#pragma unroll
                    for (int r = 0; r < 4; ++r) *(LAS float*)(L + YR + (16 * ch + 4 * g + r) * FST + (16 * wave + lr) * 4) = y[r];
                }
            }
            }
        }
        LDS_BARRIER();
        { RW_LANES(); RW_PASS_E(SEQ - TC, ((SEQ - TC) >> 5) & 1); }
#undef RW_LOAD
#undef RW_LD1
#undef RW_LD0
#undef RW_SHIFT
#undef RW_LANES
#undef RW_SLOTS
#undef RW_PASS_E
    }
}

__device__ __forceinline__ void retention_mfma(const Frame& F, bf16* Q) {
    constexpr int KST = 528, VST = 272, SST = 528;
    constexpr int KOFF = 0, VOFF = 64 * KST, SOFF = VOFF + 64 * VST;
    LAS unsigned char* const L = F.lds;
    const int tid = F.tid, lane0 = F.lane, w = F.wave;
    const int it = w & 3, vh = w >> 2;
#define RT_LANES() int lane = lane0; asm volatile("" : "+v"(lane)); const int g = lane >> 4, lr = lane & 15, q4 = lr >> 2, p4 = lane & 3; (void)g; (void)lr; (void)q4; (void)p4
    const int lr0 = lane0 & 15;
    for (int item = F.bid; item < BATCH * 16; item += F.G) {
        const int b = item >> 4, h = (item >> 2) & 3, sl = item & 3;
        const float lg2 = log2f(1.f - exp2f(-5.f - (float)h));
        const float g64 = exp2f(64.f * lg2);
        const float vf0 = exp2f(-(float)((tid >> 4) + 1) * lg2), vf1 = exp2f(-(float)((tid >> 4) + 33) * lg2);
        const float ysc = exp2f((float)(16 * it + lr0 + 1) * lg2);
        const bf16* qg = Q + L1_QKH + (size_t)(b * 4 + h) * 2048 * 512;
        const bf16* kg = qg + 256;
        bf16* vg = Q + L1_VH + (size_t)((b * 4 + h) * 4 + sl) * 2048 * 128;
        f32x4 st[2][8];
#pragma unroll
        for (int a = 0; a < 2; ++a)
#pragma unroll
            for (int c = 0; c < 8; ++c) st[a][c] = (f32x4){0.f, 0.f, 0.f, 0.f};
        __syncthreads();
        for (int i = tid; i < 128 * SST / 16; i += NTHR) *(LAS v4u*)(L + SOFF + i * 16) = (v4u){0u, 0u, 0u, 0u};
        v4u kp[4], vp[2];
#define RET_LOAD(c) do { const size_t r0_ = (size_t)(64 * (c)); \
            _Pragma("unroll") for (int i_ = 0; i_ < 4; ++i_) { const int p_ = tid + NTHR * i_; kp[i_] = *(const v4u*)(kg + (r0_ + (p_ >> 5)) * 512 + (p_ & 31) * 8); } \
            _Pragma("unroll") for (int i_ = 0; i_ < 2; ++i_) { const int p_ = tid + NTHR * i_; vp[i_] = *(const v4u*)(vg + (r0_ + (p_ >> 4)) * 128 + (p_ & 15) * 8); } } while (0)
        RET_LOAD(0);
        bf16x8 qc[8];
#define RET_QLOAD(c_) do { RT_LANES(); _Pragma("unroll") for (int ks = 0; ks < 8; ++ks) qc[ks] = *(const bf16x8*)(qg + (size_t)(64 * (c_) + 16 * it + lr) * 512 + 32 * ks + 8 * g); } while (0)
        RET_QLOAD(0);
        for (int c = 0; c < SEQ / 64; ++c) {
#pragma unroll
            for (int i = 0; i < 4; ++i) { const int p = tid + NTHR * i; *(LAS v4u*)(L + KOFF + (p >> 5) * KST + (p & 31) * 16) = kp[i]; }
#pragma unroll
            for (int i = 0; i < 2; ++i) { const int p = tid + NTHR * i; const float f = i ? vf1 : vf0; const v4u x = vp[i]; v4u o;
                o.x = cvtpk(bflo(x.x) * f, bfhi(x.x) * f); o.y = cvtpk(bflo(x.y) * f, bfhi(x.y) * f); o.z = cvtpk(bflo(x.z) * f, bfhi(x.z) * f); o.w = cvtpk(bflo(x.w) * f, bfhi(x.w) * f);
                *(LAS v4u*)(L + VOFF + (p >> 4) * VST + (p & 15) * 16) = o; }
            LDS_BARRIER();
            if (c + 1 < SEQ / 64) RET_LOAD(c + 1);
            { RT_LANES();
#pragma unroll
            for (int s2 = 0; s2 < 2; ++s2) { bf16x8 ka[2];
#pragma unroll
                for (int dt = 0; dt < 2; ++dt) { const s16x4 lo = lds_tr(L + KOFF + (32 * s2 + 8 * g + q4) * KST + (32 * w + 16 * dt + 4 * p4) * 2), hi = lds_tr(L + KOFF + (32 * s2 + 8 * g + 4 + q4) * KST + (32 * w + 16 * dt + 4 * p4) * 2); ka[dt] = cat8(lo, hi); }
#pragma unroll
                for (int vq = 0; vq < 2; ++vq) { bf16x8 vb[4];
#pragma unroll
                    for (int v4 = 0; v4 < 4; ++v4) { const int vt = 4 * vq + v4; const s16x4 lo = lds_tr(L + VOFF + (32 * s2 + 8 * g + q4) * VST + (16 * vt + 4 * p4) * 2), hi = lds_tr(L + VOFF + (32 * s2 + 8 * g + 4 + q4) * VST + (16 * vt + 4 * p4) * 2); vb[v4] = cat8(lo, hi); }
                    __builtin_amdgcn_sched_barrier(0);
#pragma unroll
                    for (int v4 = 0; v4 < 4; ++v4) { st[0][4 * vq + v4] = MFMA16(ka[0], vb[v4], st[0][4 * vq + v4]); st[1][4 * vq + v4] = MFMA16(ka[1], vb[v4], st[1][4 * vq + v4]); }
                    __builtin_amdgcn_sched_barrier(0); } }
#pragma unroll
            for (int dt = 0; dt < 2; ++dt)
#pragma unroll
                for (int vt = 0; vt < 8; ++vt) st[dt][vt] = st[dt][vt] * g64;
            }
            __builtin_amdgcn_sched_barrier(0);
            { RT_LANES();
            f32x4 sacc[4];
#pragma unroll
            for (int jt = 0; jt < 4; ++jt) { sacc[jt] = (f32x4){0.f, 0.f, 0.f, 0.f};
                if (jt <= it) { bf16x8 kr[8];
#pragma unroll
                    for (int ks = 0; ks < 8; ++ks) kr[ks] = *(const LAS bf16x8*)(L + KOFF + (16 * jt + lr) * KST + (32 * ks + 8 * g) * 2);
                    __builtin_amdgcn_sched_barrier(0);
#pragma unroll
                    for (int ks = 0; ks < 8; ++ks) sacc[jt] = MFMA16(kr[ks], qc[ks], sacc[jt]);
                    if (jt == it) {
#pragma unroll
                        for (int r = 0; r < 4; ++r) sacc[jt][r] = (4 * g + r <= lr) ? sacc[jt][r] : 0.f; }
                    __builtin_amdgcn_sched_barrier(0);
                } }
            bf16x8 sf[2]; sf[0] = pack8(sacc[0], sacc[1]); sf[1] = pack8(sacc[2], sacc[3]); __builtin_amdgcn_sched_barrier(0);
#pragma unroll
            for (int x = 0; x < 4; ++x) { const int vt = 4 * vh + x; f32x4 y = (f32x4){0.f, 0.f, 0.f, 0.f};
#pragma unroll
                for (int kh = 0; kh < 2; ++kh) { bf16x8 sr[4];
#pragma unroll
                    for (int k4 = 0; k4 < 4; ++k4) sr[k4] = *(const LAS bf16x8*)(L + SOFF + (16 * vt + lr) * SST + (32 * (4 * kh + k4) + 8 * g) * 2);
                    __builtin_amdgcn_sched_barrier(0);
#pragma unroll
                    for (int k4 = 0; k4 < 4; ++k4) y = MFMA16(sr[k4], qc[4 * kh + k4], y);
                    __builtin_amdgcn_sched_barrier(0); }
#pragma unroll
                for (int s2 = 0; s2 < 2; ++s2) if (2 * s2 <= it) {
                    const s16x4 lo = lds_tr(L + VOFF + (32 * s2 + 4 * g + q4) * VST + (16 * vt + 4 * p4) * 2), hi = lds_tr(L + VOFF + (32 * s2 + 16 + 4 * g + q4) * VST + (16 * vt + 4 * p4) * 2);
                    y = MFMA16(cat8(lo, hi), sf[s2], y); }
                v2u o; o.x = cvtpk(y[0] * ysc, y[1] * ysc); o.y = cvtpk(y[2] * ysc, y[3] * ysc);
                *(v2u*)(vg + (size_t)(64 * c + 16 * it + lr) * 128 + 16 * vt + 4 * g) = o; __builtin_amdgcn_sched_barrier(0); }
            }
            if (c + 1 < SEQ / 64) RET_QLOAD(c + 1);
            LDS_BARRIER();
            { RT_LANES();
#pragma unroll
            for (int dt = 0; dt < 2; ++dt)
#pragma unroll
                for (int vt = 0; vt < 8; ++vt) { v2u o; o.x = cvtpk(st[dt][vt][0], st[dt][vt][1]); o.y = cvtpk(st[dt][vt][2], st[dt][vt][3]);
                    *(LAS v2u*)(L + SOFF + (16 * vt + lr) * SST + (32 * w + 16 * dt + 4 * g) * 2) = o; }
            }
        }
#undef RET_LOAD
#undef RET_QLOAD
#undef RT_LANES
    }
}

__device__ __forceinline__ void retention_norm(const Frame& F, bf16* Q) {
    const int gw = F.bid * NWAVES + F.wave, NGW = F.G * NWAVES, lane = F.lane;
    for (int it = gw; it < MTOK * 4; it += NGW) {
        const int row = it >> 2, h = it & 3, c8 = 8 * lane; const bf16* yp = Q + L1_VH + ((size_t)(((row >> 11) * 4 + h) * 4 + (c8 >> 7)) * 2048 + (row & 2047)) * 128 + (c8 & 127); bf16* gp = Q + L1_GB + (size_t)row * 2048 + h * 512 + c8;
        const v4u w = *(const v4u*)yp; const v4u gq = *(const v4u*)gp;
        float v[8] = {bflo(w.x), bfhi(w.x), bflo(w.y), bfhi(w.y), bflo(w.z), bfhi(w.z), bflo(w.w), bfhi(w.w)};
        const float g[8] = {bflo(gq.x), bfhi(gq.x), bflo(gq.y), bfhi(gq.y), bflo(gq.z), bfhi(gq.z), bflo(gq.w), bfhi(gq.w)};
        float s = 0.f;
#pragma unroll
        for (int j = 0; j < 8; ++j) s += v[j];
        const float mean = wave_sum(s) * (1.f / 512.f); float s2 = 0.f;
#pragma unroll
        for (int j = 0; j < 8; ++j) { v[j] -= mean; s2 += v[j] * v[j]; }
        const float r = 1.f / sqrtf(wave_sum(s2) * (1.f / 512.f) + LN_EPS);
        float o[8];
#pragma unroll
        for (int j = 0; j < 8; ++j) o[j] = silu_f(g[j]) * v[j] * r;
        v4u ow; ow.x = pk2(o[0], o[1]); ow.y = pk2(o[2], o[3]); ow.z = pk2(o[4], o[5]); ow.w = pk2(o[6], o[7]);
        *(v4u*)gp = ow;
    }
}

__device__ __forceinline__ void retention_norm8(const Frame& F, const bf16* Q, unsigned char* gb8, float* rsc) {
    const int gw = F.bid * NWAVES + F.wave, NGW = F.G * NWAVES, lane = F.lane, c8 = 8 * lane;
    v4u cy[4], cg[4];
#define RN_LOAD(Y, G, rowv) do { _Pragma("unroll") for (int h = 0; h < 4; ++h) { \
        Y[h] = __builtin_nontemporal_load((const v4u*)(Q + L1_VH + ((size_t)((((rowv) >> 11) * 4 + h) * 4 + (c8 >> 7)) * 2048 + ((rowv) & 2047)) * 128 + (c8 & 127))); \
        G[h] = __builtin_nontemporal_load((const v4u*)(Q + L1_GB + (size_t)(rowv) * 2048 + h * 512 + c8)); } } while (0)
    if (gw < MTOK) RN_LOAD(cy, cg, gw);
    for (int row = gw; row < MTOK; row += NGW) {
        v4u ny[4], ng[4];
#pragma unroll
        for (int h = 0; h < 4; ++h) { ny[h] = cy[h]; ng[h] = cg[h]; }
        if (row + NGW < MTOK) RN_LOAD(ny, ng, row + NGW);
        asm volatile("" ::: "memory");
        float o[4][8]; float amax = 0.f;
#pragma unroll
        for (int h = 0; h < 4; ++h) {
            const v4u w = cy[h]; const v4u gq = cg[h];
            float v[8] = {bflo(w.x), bfhi(w.x), bflo(w.y), bfhi(w.y), bflo(w.z), bfhi(w.z), bflo(w.w), bfhi(w.w)};
            const float g[8] = {bflo(gq.x), bfhi(gq.x), bflo(gq.y), bfhi(gq.y), bflo(gq.z), bfhi(gq.z), bflo(gq.w), bfhi(gq.w)};
            float s = 0.f;
#pragma unroll
            for (int j = 0; j < 8; ++j) s += v[j];
            const float mean = wave_sum(s) * (1.f / 512.f); float s2 = 0.f;
#pragma unroll
            for (int j = 0; j < 8; ++j) { v[j] -= mean; s2 += v[j] * v[j]; }
            const float r = 1.f / sqrtf(wave_sum(s2) * (1.f / 512.f) + LN_EPS);
#pragma unroll
            for (int j = 0; j < 8; ++j) { o[h][j] = silu_f(g[j]) * v[j] * r; amax = fmaxf(amax, fabsf(o[h][j])); }
        }
        {
#define RN_DPPF(v_, c_) __builtin_bit_cast(float, __builtin_amdgcn_update_dpp(0, __builtin_bit_cast(int, v_), c_, 0xf, 0xf, true))
            amax = fmaxf(amax, RN_DPPF(amax, 0x128)); amax = fmaxf(amax, RN_DPPF(amax, 0x124)); amax = fmaxf(amax, RN_DPPF(amax, 0x122)); amax = fmaxf(amax, RN_DPPF(amax, 0x121));
#undef RN_DPPF
            const float r0 = __builtin_bit_cast(float, __builtin_amdgcn_readlane(__builtin_bit_cast(int, amax), 0)), r1 = __builtin_bit_cast(float, __builtin_amdgcn_readlane(__builtin_bit_cast(int, amax), 16));
            const float r2 = __builtin_bit_cast(float, __builtin_amdgcn_readlane(__builtin_bit_cast(int, amax), 32)), r3 = __builtin_bit_cast(float, __builtin_amdgcn_readlane(__builtin_bit_cast(int, amax), 48));
            amax = fmaxf(fmaxf(r0, r1), fmaxf(r2, r3)); }
        const float qs = amax > 0.f ? 127.f / amax : 0.f;
#pragma unroll
        for (int h = 0; h < 4; ++h) { v2u ow; ow.x = pg8::pk_i8x4(o[h][0] * qs, o[h][1] * qs, o[h][2] * qs, o[h][3] * qs); ow.y = pg8::pk_i8x4(o[h][4] * qs, o[h][5] * qs, o[h][6] * qs, o[h][7] * qs);
            *(v2u*)(gb8 + (size_t)row * 2048 + h * 512 + c8) = ow; }
        if (lane == 0) rsc[row] = amax * (1.f / 127.f);
#pragma unroll
        for (int h = 0; h < 4; ++h) { cy[h] = ny[h]; cg[h] = ng[h]; }
    }
#undef RN_LOAD
}

__device__ __forceinline__ int pad256(int n) { return (n + 255) & ~255; }
__device__ __forceinline__ void moe_slots(const Frame& F, const unsigned* cnt, const int* tok_e, const float* tok_p, const int* tok_pos, int* rowtok, int* rowdst, float* rowp) {
    const int gt = F.bid * NTHR + F.tid, NGT = F.G * NTHR;
    for (int row = gt; row < MTOK; row += NGT) {
        const int e01 = tok_e[row], e0 = e01 & 255, e1 = e01 >> 8; const float p0 = tok_p[row];
        int base0 = 0, base1 = 0;
#pragma unroll
        for (int e = 0; e < 8; ++e) { const int pc = pad256((int)cnt[e]); if (e < e0) base0 += pc; if (e < e1) base1 += pc; }
        const int s0 = base0 + tok_pos[2 * row], s1 = base1 + tok_pos[2 * row + 1];
        rowtok[s0] = row; rowdst[s0] = row; rowp[s0] = p0;
        rowtok[s1] = row; rowdst[s1] = MTOK + row; rowp[s1] = 1.f - p0;
    }
    for (int it = gt; it < 8 * 256; it += NGT) {
        const int e = it >> 8, i = it & 255;
        int base = 0;
#pragma unroll
        for (int q = 0; q < 8; ++q) if (q < e) base += pad256((int)cnt[q]);
        const int n = (int)cnt[e];
        if (n + i < pad256(n)) { const int s = base + n + i; rowtok[s] = 0; rowdst[s] = -1; rowp[s] = 0.f; }
    }
}
struct MoeOrder {
    int npan, nN, G, c; const char* W; size_t estride, tstepB; const int* rows; const LAS int* pexp; int p0;
    __device__ bool next(int i, pg8::Unit& u) const {
        const int nwg = npan * nN; const long L = (long)i * G + c; if (L >= nwg) return false;
        int wgid = (int)L; { const int q = nwg / pg8::NXCD, r = nwg % pg8::NXCD, xcd = wgid % pg8::NXCD, off = wgid / pg8::NXCD; wgid = (xcd < r ? xcd * (q + 1) : r * (q + 1) + (xcd - r) * q) + off; }
        const int nig = pg8::WGM * nN, gid = wgid / nig, fm = gid * pg8::WGM, gsz = (npan - fm) < pg8::WGM ? (npan - fm) : pg8::WGM;
        u.pm = fm + ((wgid % nig) % gsz); u.pn = (wgid % nig) / gsz; return true; }
    __device__ __forceinline__ const char* b_base(const pg8::Unit& u) const { const int e = __builtin_amdgcn_readfirstlane(pexp[p0 + u.pm]); return W + (size_t)e * estride + (size_t)u.pn * tstepB; }
    __device__ __forceinline__ const int* a_rows(const pg8::Unit& u) const { return rows + (p0 + u.pm) * 256; }
};
__device__ __forceinline__ int moe_panels(const unsigned* cnt, LAS int* pexp, int tid) {
    int pb[9]; pb[0] = 0;
#pragma unroll
    for (int e = 0; e < 8; ++e) pb[e + 1] = pb[e] + pad256((int)cnt[e]) / 256;
    if (tid < MOE_SLOTS / 256) { int e = 0;
#pragma unroll
        for (int q = 1; q < 8; ++q) e += (tid >= pb[q]) ? 1 : 0;
        pexp[tid] = e; }
    __syncthreads();
    return pb[8];
}

__global__ void __launch_bounds__(NTHR, 2) fwd_kernel(Args args) {
    extern __shared__ __attribute__((aligned(16))) unsigned char lds_raw[];
    Frame F;
    F.lds = (LAS unsigned char*)lds_raw;
    F.tid = threadIdx.x; F.lane = F.tid & 63; F.wave = __builtin_amdgcn_readfirstlane(F.tid >> 6); F.G = gridDim.x; F.bid = blockIdx.x;
    typedef const unsigned char __attribute__((address_space(4))) kseg_t;
    kseg_t* kp0 = (kseg_t*)__builtin_amdgcn_kernarg_segment_ptr();
#define KARG(T, off) (*(T const __attribute__((address_space(4)))*)(kp + (off)))
#define PHASE_ENTER { int l_; asm volatile("v_mbcnt_lo_u32_b32 %0, -1, 0\n\tv_mbcnt_hi_u32_b32 %0, -1, %0" : "=v"(l_)); F.lane = l_; F.tid = F.wave * 64 + l_; } kseg_t* kp = kp0; asm volatile("" : "+s"(kp)); unsigned char* const ws = KARG(unsigned char*, 38 * 8 + 8); gu32* const ctl = (gu32*)(ws + WS_CTL); (void)ctl
#define INP(i) KARG(const float*, 8 * (i))
#define OUTP KARG(float*, 38 * 8)
#define WSP(T, off) ((T*)(ws + (off)))
    int lo, hi;
    { kseg_t* kp = kp0; lo = KARG(int, 38 * 8 + 16); hi = KARG(int, 38 * 8 + 20); }
    volatile LAS unsigned* MISC = (volatile LAS unsigned*)(F.lds + MISC_OFF);
    for (int u = F.tid; u < (LDS_BYTES - RING_BYTES) / 4; u += NTHR) ((LAS unsigned*)(F.lds + RING_BYTES))[u] = 0u;
    __syncthreads();
    const bool multi = (hi - lo) > 1;
    XcdBarrier bar; bar.x = 0; bar.st = nullptr;
    { PHASE_ENTER; bar.bar = (unsigned*)(ctl + CW_BAR); if (multi) bar = xcd_barrier_post((unsigned*)(ctl + CW_BAR), MISC + 8); }
#ifndef PH_MASK
#define PH_MASK 0xFFFFFFu
#endif
#define IN(k) (((PH_MASK >> (k)) & 1u) && lo <= (k) && (k) < hi)
#define SEAM(k) do { if (IN(k) && IN((k) + 1)) xcd_barrier(bar); } while (0)
#define W0IN WSP(bf16, WS_W0IN)
#define W0OUT WSP(bf16, WS_W0OUT)
#define W0GU WSP(bf16, WS_W0GU)
#define W0D WSP(bf16, WS_W0D)
#define W1IN WSP(bf16, WS_W1IN)
#define W1OUT WSP(bf16, WS_W1OUT)
#define XB WSP(bf16, WS_XB)
#define P WSP(bf16, WS_P)
#define X1 WSP(float, WS_X1)
#define HID WSP(bf16, WS_HID)
#define HB WSP(bf16, WS_H)
#define MIX ((bf16*)OUTP)
#define OUT OUTP
#define MOEGU ((bf16*)OUTP)
#define MOED WSP(bf16, WS_MOED)
#define Y0 WSP(bf16, WS_Y0)
#define Y1 WSP(bf16, WS_Y1)
#define MHID WSP(bf16, WS_MHID)
#define TOK_E WSP(int, WS_TAB + TAB_E)
#define TOK_P WSP(float, WS_TAB + TAB_P)
#define TOK_POS WSP(int, WS_TAB + TAB_POS)
#define ROWTOK WSP(int, WS_TAB + TAB_ROWTOK)
#define ROWDST WSP(int, WS_TAB + TAB_ROWDST)
#define ROWP WSP(float, WS_TAB + TAB_ROWP)
#define CNT ((unsigned*)(ctl + CW_CNT))
#define CSTAB WSP(float, WS_CS)
#define XA WSP(bf16, WS_H)
#define BCA WSP(bf16, WS_XB)
#define SMSB WSP(bf16, WS_XB + 32 * MiB)
    const int gw = F.bid * NWAVES + F.wave, NGW = F.G * NWAVES;
    LAS float* const scr = (LAS float*)(F.lds + F.wave * 16384);

    if (IN(0)) { PHASE_ENTER;
        transpose_job<1>(INP(I_EV_WIN), nullptr, 5936, 1024, W0IN, 6144, scr, gw, NGW, F.lane);
        transpose_job<0>(INP(I_EV_WOUT), nullptr, 1024, 2048, W0OUT, 1024, scr, gw, NGW, F.lane);
        transpose_job8<2>(INP(I_FFN_WG), INP(I_FFN_WU), 3584, 1024, (unsigned char*)W0GU, 7168, WGU_SC, scr, gw, NGW, F.lane);
        transpose_job8<0>(INP(I_FFN_WD), nullptr, 1024, 3584, (unsigned char*)W0D, 1024, WD_SC, scr, gw, NGW, F.lane);
        transpose_job8<0>(INP(I_OD_WIN), nullptr, 6144, 1024, (unsigned char*)W1IN, 6144, WGU_SC, scr, gw, NGW, F.lane);
        transpose_job8<0>(INP(I_OD_WOUT), nullptr, 1024, 2048, (unsigned char*)W1OUT, 1024, WO_SC, scr, gw, NGW, F.lane);
        const float* x = INP(I_X);
        for (size_t i = (size_t)(F.bid * NTHR + F.tid) * 8; i < (size_t)MTOK * DM; i += (size_t)F.G * NTHR * 8) {
            const f32x4 a = __builtin_nontemporal_load((const f32x4*)(x + i)), b = __builtin_nontemporal_load((const f32x4*)(x + i + 4));
            v4u o; o.x = pk2(a.x, a.y); o.y = pk2(a.z, a.w); o.z = pk2(b.x, b.y); o.w = pk2(b.z, b.w); *(v4u*)(XB + i) = o; }
    }
    SEAM(0);
    if (IN(1)) { PHASE_ENTER; pg8::StaticOrder S; S.init(MTOK, PW, F.G, F.bid, W0IN, 1024); pg8::EpiRoute0 E{P, L0_XBC, L0_RKVH, L0_SMB};
        pg8::gemm_phase<pg8::EpiRoute0, pg8::StaticOrder, true, false>(F.lds, XB, 1024, 1024, 1024, S, E); }
    SEAM(1);
    if (IN(2)) { PHASE_ENTER; conv_prepass(F, P, INP(I_CONVW), INP(I_CONVB), XA, BCA); small_prepass(F, P + L0_SMB, INP(I_MU), SMSB); }
    SEAM(2);
    if (IN(3)) { PHASE_ENTER;
        ssd_mfma(F, P, XA, BCA, INP(I_DTB), INP(I_ALOG), INP(I_DSKIP), MIX);
        __syncthreads();
        RwkvW W{INP(I_MU), INP(I_W0), INP(I_WUP), INP(I_A0), INP(I_AUP), INP(I_GUP), INP(I_KK), INP(I_KA), INP(I_RK), INP(I_RLNW), INP(I_RLNB)};
        rwkv_items(F, P, SMSB, W, MIX);
    }
    SEAM(3);
    if (IN(4)) { PHASE_ENTER; ssd_norm(F, MIX, INP(I_MNORM)); }
    SEAM(4);
    if (IN(5)) { PHASE_ENTER; pg8::StaticOrder S; S.init(MTOK, 1024, F.G, F.bid, W0OUT, 2048); pg8::EpiStore E{HB, 1024};
        pg8::gemm_phase<pg8::EpiStore, pg8::StaticOrder, true, false>(F.lds, MIX, 2048, 2048, 2048, S, E); }
    SEAM(5);
    if (IN(6)) { PHASE_ENTER; ln_rows<false, false>(F, INP(I_X), nullptr, HB, nullptr, INP(I_EV_LN1G), INP(I_EV_LN1B), nullptr, XB, 0, MTOK, nullptr, nullptr, nullptr, nullptr, nullptr, nullptr, nullptr, WSP(unsigned char, WS_P), XQ_SC); }
    SEAM(6);
    if (IN(7)) { PHASE_ENTER; pg8::StaticOrder S; S.init(MTOK, 2 * DFF, F.G, F.bid, W0GU, 1024); S.tstepB = (size_t)256 * 1024; pg8::EpiSwiGLU8 E{(unsigned char*)HID, DFF, 1.f / (XQ_SC * WGU_SC), HQ_SC};
        pg8::gemm_phase<pg8::EpiSwiGLU8, pg8::StaticOrder, true, false, true>(F.lds, (const bf16*)WSP(unsigned char, WS_P), 1024, 1024, 1024, S, E); }
    SEAM(7);
    if (IN(8)) { PHASE_ENTER; pg8::StaticOrder S; S.init(MTOK, 1024, F.G, F.bid, W0D, DFF); S.tstepB = (size_t)256 * DFF; pg8::EpiStoreI8 E{HB, 1024, 1.f / (HQ_SC * WD_SC)};
        pg8::gemm_phase<pg8::EpiStoreI8, pg8::StaticOrder, true, false, true>(F.lds, HID, DFF, DFF, DFF, S, E); }
    SEAM(8);
    if (IN(9)) { PHASE_ENTER; ln_rows<false, false>(F, nullptr, XB, HB, nullptr, INP(I_EV_LN2G), INP(I_EV_LN2B), nullptr, XB, 0, MTOK, nullptr, nullptr, nullptr, nullptr, nullptr, nullptr, nullptr, WSP(unsigned char, WS_X2Q), XQ_SC); }
    SEAM(9);
    if (IN(10)) { PHASE_ENTER; pg8::StaticOrder S; S.init(MTOK, PW, F.G, F.bid, W1IN, 1024); S.tstepB = (size_t)256 * 1024; pg8::EpiRoute1 E{P, L1_VH, L1_GB, (const int*)INP(I_POS), 1.f / (XQ_SC * WGU_SC), 0};
        pg8::gemm_phase<pg8::EpiRoute1, pg8::StaticOrder, true, false, true>(F.lds, (const bf16*)WSP(unsigned char, WS_X2Q), 1024, 1024, 1024, S, E); }
    SEAM(10);
    if (IN(11)) { PHASE_ENTER; retention_mfma(F, P); }
    SEAM(11);
    if (IN(12)) { PHASE_ENTER; retention_norm8(F, P, WSP(unsigned char, WS_P), WSP(float, WS_P + 64 * MiB)); }
    SEAM(12);
    if (IN(13)) { PHASE_ENTER; pg8::StaticOrder S; S.init(MTOK, 1024, F.G, F.bid, W1OUT, 2048); S.tstepB = (size_t)256 * 2048; pg8::EpiStoreRS E{HB, 1024, WSP(float, WS_P + 64 * MiB), 1.f / WO_SC};
        pg8::gemm_phase<pg8::EpiStoreRS, pg8::StaticOrder, true, false, true>(F.lds, (const bf16*)WSP(unsigned char, WS_P), 2048, 2048, 2048, S, E); }
    SEAM(13);
    if (IN(14)) { PHASE_ENTER; ln_rows<true, false>(F, nullptr, XB, HB, nullptr, INP(I_OD_LN1G), INP(I_OD_LN1B), nullptr, XB, 0, MTOK, INP(I_ROUTER), CNT, TOK_E, TOK_P, TOK_POS, nullptr, nullptr, WSP(unsigned char, WS_XQ), XQ_SC); }
    SEAM(14);
    if (IN(15)) { PHASE_ENTER;
        for (int e = 0; e < NEXP; ++e) transpose_job8<0>(INP(I_MOE_WD) + (size_t)e * DFF * 1024, nullptr, 1024, DFF, (unsigned char*)MOED + (size_t)e * 1024 * DFF, 1024, WD_SC, scr, gw, NGW, F.lane);
        for (int e = NEXP - 1; e >= 0; --e)
            transpose_job8<2>(INP(I_MOE_WG) + (size_t)e * 1024 * DFF, INP(I_MOE_WU) + (size_t)e * 1024 * DFF, DFF, 1024, (unsigned char*)MOEGU + (size_t)e * 7168 * 1024, 7168, WGU_SC, scr, gw, NGW, F.lane);
        moe_slots(F, CNT, TOK_E, TOK_P, TOK_POS, ROWTOK, ROWDST, ROWP);
    }
    SEAM(15);
#pragma unroll
    for (int part = 0; part < MOE_PARTS; ++part) {
        const int pa = 16 + 2 * part;
        if (IN(pa)) { PHASE_ENTER;
            LAS int* pexp = (LAS int*)(F.lds + PEXP_OFF);
            const int ptot = moe_panels(CNT, pexp, F.tid); const int p0 = part ? MOE_P1 : 0, np = part ? ptot - MOE_P1 : (ptot < MOE_P1 ? ptot : MOE_P1);
            MoeOrder S{np, 28, F.G, F.bid, (const char*)MOEGU, (size_t)7168 * 1024, (size_t)256 * 1024, ROWTOK, pexp, p0};
            pg8::EpiSwiGLU8 E{(unsigned char*)MHID, DFF, 1.f / (XQ_SC * WGU_SC), HQ_SC};
            pg8::gemm_phase<pg8::EpiSwiGLU8, MoeOrder, true, true, true>(F.lds, (const bf16*)WSP(unsigned char, WS_XQ), 1024, 1024, 1024, S, E);
        }
        SEAM(pa);
        if (IN(pa + 1)) { PHASE_ENTER;
            LAS int* pexp = (LAS int*)(F.lds + PEXP_OFF);
            const int ptot = moe_panels(CNT, pexp, F.tid); const int p0 = part ? MOE_P1 : 0, np = part ? ptot - MOE_P1 : (ptot < MOE_P1 ? ptot : MOE_P1);
            MoeOrder S{np, 4, F.G, F.bid, (const char*)MOED, (size_t)1024 * DFF, (size_t)256 * DFF, nullptr, pexp, p0};
            pg8::EpiMoeOut E{Y0, Y1, 1024, MTOK, ROWDST + p0 * 256, ROWP + p0 * 256, 1.f / (HQ_SC * WD_SC), true};
            pg8::gemm_phase<pg8::EpiMoeOut, MoeOrder, true, false, true>(F.lds, MHID, DFF, DFF, DFF, S, E);
        }
        SEAM(pa + 1);
    }
    if (IN(16 + 2 * MOE_PARTS)) { PHASE_ENTER; ln_rows<false, true>(F, nullptr, XB, Y0, Y1, INP(I_OD_LN2G), INP(I_OD_LN2B), OUT, nullptr, 0, MTOK, nullptr, nullptr, nullptr, nullptr, nullptr); }
#undef IN
#undef SEAM
#undef INP
#undef P
}
constexpr int N_PHASES = 17 + 2 * MOE_PARTS;

extern "C" void kernel_launch(void* const* d_in, const int* in_sizes, int n_in, void* d_out, int out_size, void* d_ws, size_t ws_size, hipStream_t stream) {
    static int grid = 0;
    if (grid == 0) {
        if (n_in != 38 || out_size != MTOK * DM || ws_size < WS_END) { fprintf(stderr, "kernel_launch: unexpected shapes (n_in %d out %d ws %zu)\n", n_in, out_size, ws_size); grid = -1; return; }
        int dev = 0, cus = 0;
        if (hipGetDevice(&dev) != hipSuccess || hipDeviceGetAttribute(&cus, hipDeviceAttributeMultiprocessorCount, dev) != hipSuccess) { grid = -1; return; }
        if (hipFuncSetAttribute((const void*)fwd_kernel, hipFuncAttributeMaxDynamicSharedMemorySize, LDS_BYTES) != hipSuccess) { grid = -1; return; }
        int per_cu = 0;
        (void)hipOccupancyMaxActiveBlocksPerMultiprocessor(&per_cu, (const void*)fwd_kernel, NTHR, LDS_BYTES);
        (void)hipGetLastError();
        grid = cus;
    }
    if (grid < 0) return;
    (void)hipMemsetAsync((char*)d_ws + WS_CTL, 0, CTL_ZERO_BYTES, stream);
    Args a{};
    for (int i = 0; i < 38; ++i) a.in[i] = d_in[i];
    a.out = (float*)d_out; a.ws = (unsigned char*)d_ws;
#if MK_ONE_LAUNCH
    a.ph_lo = 0; a.ph_hi = N_PHASES;
    hipLaunchKernelGGL(fwd_kernel, dim3(grid), dim3(NTHR), LDS_BYTES, stream, a);
#else
    for (int p = 0; p < N_PHASES; ++p) { a.ph_lo = p; a.ph_hi = p + 1; hipLaunchKernelGGL(fwd_kernel, dim3(grid), dim3(NTHR), LDS_BYTES, stream, a); }
#endif
}
```
